# Optimizing an MI355X kernel written in HIP

```python
import jax, jax.numpy as jnp
from jax import lax
import numpy as np

D_MODEL = 1024
BATCH = 4
SEQ = 8192
DEPTH = 2

GRID_W = 64
CTX_LEN = 256
D_MIX = D_MODEL
SSD_WIDTH = D_MIX // 2
SSD_HEADDIM = 64
SSD_HEADS = SSD_WIDTH // SSD_HEADDIM
SSD_GROUPS = 2
HEADS_PER_GROUP = SSD_HEADS // SSD_GROUPS
SSD_STATE = 128
SSD_CONV = 3
SSD_CHUNK = 128
XBC_WIDTH = SSD_WIDTH + 2 * SSD_GROUPS * SSD_STATE
FNET_WIDTH = D_MIX // 4
FNET_GROUPS = 4
FNET_GDIM = FNET_WIDTH // FNET_GROUPS
POOL_WINDOWS = (2, 4, 8, 16)
POOL_WIDTH = D_MIX // 4
POOL_GDIM = POOL_WIDTH // len(POOL_WINDOWS)
D_FF = 256 * ((8 * D_MODEL // 3 + 255) // 256)
FFN_CONV = 3
OFF_Z = 0
OFF_XBC = OFF_Z + SSD_WIDTH
OFF_DT = OFF_XBC + XBC_WIDTH
OFF_FNET = OFF_DT + 2 * SSD_HEADS
OFF_POOL = OFF_FNET + FNET_WIDTH
N_IN = OFF_POOL + POOL_WIDTH
ALPHA = (2.0 * DEPTH) ** 0.25
BETA = (8.0 * DEPTH) ** -0.25
EPS = 1e-6

kernel_name = "hybrid_ssd_fourier_pool_convffn_prefix"


def layer_norm(x):
    xf = x.astype(jnp.float32)
    mu = jnp.mean(xf, -1, keepdims=True)
    var = jnp.mean(jnp.square(xf - mu), -1, keepdims=True)
    return ((xf - mu) * lax.rsqrt(var + EPS)).astype(x.dtype)


def ada(cvec, w, b):
    m = jax.nn.silu(cvec) @ w + b
    return [mi[:, None, :] for mi in jnp.split(m, 6, axis=-1)]


def modulate(x, shift, scale):
    return layer_norm(x) * (1 + scale) + shift


def post_norm(x, y, gate, g, b):
    return layer_norm(ALPHA * x + gate * y) * g + b


def dwconv1d(x, w, b):
    k = w.shape[0]
    left = (k - 1) // 2
    y = lax.conv_general_dilated(x, w[:, None, :], window_strides=(1,), padding=[(left, k - 1 - left)],
                                 dimension_numbers=("NWC", "WIO", "NWC"), feature_group_count=x.shape[-1])
    return y + b


def dwconv2d_grid(x, w, b):
    bsz, L, C = x.shape
    rows = L // GRID_W
    xg = x.reshape(bsz, rows, GRID_W, C)
    y = lax.conv_general_dilated(xg, w[:, :, None, :], window_strides=(1, 1), padding=[(1, 1), (1, 1)],
                                 dimension_numbers=("NHWC", "HWIO", "NHWC"), feature_group_count=C)
    return y.reshape(bsz, L, C) + b


def segsum(a):
    T = a.shape[-1]
    cs = jnp.cumsum(a, axis=-1)
    seg = cs[..., :, None] - cs[..., None, :]
    mask = jnp.tril(jnp.ones((T, T), dtype=bool))
    return jnp.where(mask, seg, -jnp.inf)


def ssd_chunked(X, dA, B, C, init_state):
    b, L, h, p = X.shape
    n = B.shape[-1]
    nc = L // SSD_CHUNK
    X = X.astype(jnp.float32).reshape(b, nc, SSD_CHUNK, h, p)
    B = B.astype(jnp.float32).reshape(b, nc, SSD_CHUNK, h, n)
    C = C.astype(jnp.float32).reshape(b, nc, SSD_CHUNK, h, n)
    A = dA.astype(jnp.float32).reshape(b, nc, SSD_CHUNK, h).transpose(0, 3, 1, 2)
    A_cs = jnp.cumsum(A, axis=-1)
    Lmat = jnp.exp(segsum(A))
    y_diag = jnp.einsum("bclhn,bcshn,bhcls,bcshp->bclhp", C, B, Lmat, X)
    decay_states = jnp.exp(A_cs[..., -1:] - A_cs)
    states = jnp.einsum("bclhn,bhcl,bclhp->bchpn", B, decay_states, X)
    states = jnp.concatenate([init_state[:, None].astype(jnp.float32), states], axis=1)
    chunk_decay = jnp.exp(segsum(jnp.pad(A_cs[..., -1], ((0, 0), (0, 0), (1, 0)))))
    new_states = jnp.einsum("bhzc,bchpn->bzhpn", chunk_decay, states)
    states, final_state = new_states[:, :-1], new_states[:, -1]
    y_off = jnp.einsum("bclhn,bchpn,bhcl->bclhp", C, states, jnp.exp(A_cs))
    return (y_diag + y_off).reshape(b, L, h, p), final_state


def ssd_final_state(X, dA, B):
    cs = jnp.cumsum(dA, axis=1)
    return jnp.einsum("blh,blhn,blhp->bhpn", jnp.exp(cs[:, -1:] - cs), B.astype(jnp.float32), X)


def rev(a):
    return jnp.flip(a, axis=1)


def ssd_prep(u, conv_w, conv_b, dt_bias, a_log):
    bsz, L, _ = u.shape
    xbc = jax.nn.silu(dwconv1d(u[..., OFF_XBC:OFF_DT], conv_w, conv_b))
    xs = xbc[..., :SSD_WIDTH].reshape(bsz, L, SSD_HEADS, SSD_HEADDIM)
    gn = SSD_GROUPS * SSD_STATE
    bm = xbc[..., SSD_WIDTH:SSD_WIDTH + gn].reshape(bsz, L, SSD_GROUPS, SSD_STATE)
    cm = xbc[..., SSD_WIDTH + gn:].reshape(bsz, L, SSD_GROUPS, SSD_STATE)
    bm = jnp.repeat(bm, HEADS_PER_GROUP, axis=2)
    cm = jnp.repeat(cm, HEADS_PER_GROUP, axis=2)
    dt_raw = u[..., OFF_DT:OFF_FNET].reshape(bsz, L, 2, SSD_HEADS)
    dt = jax.nn.softplus((dt_raw + dt_bias).astype(jnp.float32))
    dA = dt * (-jnp.exp(a_log.astype(jnp.float32)))
    return xs, bm, cm, dt, dA


def ssd_bidir(xs, bm, cm, dt, dA, init_f, init_b):
    x32 = xs.astype(jnp.float32)
    y_f, s_f = ssd_chunked(x32 * dt[:, :, 0, :, None], dA[:, :, 0], bm, cm, init_f)
    y_b, s_b = ssd_chunked(rev(x32 * dt[:, :, 1, :, None]), rev(dA[:, :, 1]), rev(bm), rev(cm), init_b)
    return y_f + rev(y_b), s_f, s_b


def ssd_gate_norm(y, xs, z, d_skip, norm_w):
    bsz, L = z.shape[:2]
    y = (y + xs.astype(jnp.float32) * d_skip.astype(jnp.float32)[:, None]).reshape(bsz, L, SSD_WIDTH)
    y = (y * jax.nn.silu(z.astype(jnp.float32))).reshape(bsz, L, SSD_GROUPS, SSD_WIDTH // SSD_GROUPS)
    y = (y * lax.rsqrt(jnp.mean(y * y, -1, keepdims=True) + EPS)).reshape(bsz, L, SSD_WIDTH)
    return (y * norm_w).astype(z.dtype)


def fourier_mix(f, w):
    bsz, L, _ = f.shape
    fg = f.astype(jnp.float32).reshape(bsz, L, FNET_GROUPS, FNET_GDIM)
    spec = jnp.fft.fft2(fg, axes=(1, 3), norm="ortho").real
    y = jnp.einsum("blgc,gcd->blgd", spec.astype(f.dtype), w)
    return y.reshape(bsz, L, FNET_WIDTH)


def pool_mix(p, w, scale):
    bsz, L, _ = p.shape
    pf = p.astype(jnp.float32)
    cs = jnp.pad(jnp.cumsum(pf, axis=1), ((0, 0), (1, 0), (0, 0)))
    pos = jnp.arange(L)
    outs = []
    for gi, win in enumerate(POOL_WINDOWS):
        left = win // 2
        right = win - 1 - left
        hi = jnp.minimum(pos + right + 1, L)
        lo = jnp.maximum(pos - left, 0)
        sl = slice(gi * POOL_GDIM, (gi + 1) * POOL_GDIM)
        csg = cs[..., sl]
        mean = (csg[:, hi] - csg[:, lo]) / (hi - lo).astype(jnp.float32)[None, :, None]
        outs.append(mean - pf[..., sl])
    pooled = jnp.stack(outs, axis=2).astype(p.dtype)
    y = jnp.einsum("blgc,gcd->blgd", pooled, w).reshape(bsz, L, POOL_WIDTH)
    return y * scale


def token_mixer(u, init_f, init_b, conv_w, conv_b, dt_bias, a_log, d_skip, norm_w, fnet_w, pool_w, pool_scale, w_out):
    xs, bm, cm, dt, dA = ssd_prep(u, conv_w, conv_b, dt_bias, a_log)
    y, s_f, s_b = ssd_bidir(xs, bm, cm, dt, dA, init_f, init_b)
    y_ssd = ssd_gate_norm(y, xs, u[..., OFF_Z:OFF_XBC], d_skip, norm_w)
    y_fnet = fourier_mix(u[..., OFF_FNET:OFF_POOL], fnet_w)
    y_pool = pool_mix(u[..., OFF_POOL:N_IN], pool_w, pool_scale)
    return jnp.concatenate([y_ssd, y_fnet, y_pool], axis=-1) @ w_out, s_f, s_b


def ctx_scan_states(u, conv_w, conv_b, dt_bias, a_log):
    xs, bm, _, dt, dA = ssd_prep(u, conv_w, conv_b, dt_bias, a_log)
    x32 = xs.astype(jnp.float32)
    s_f = ssd_final_state(x32 * dt[:, :, 0, :, None], dA[:, :, 0], bm)
    s_b = ssd_final_state(rev(x32 * dt[:, :, 1, :, None]), rev(dA[:, :, 1]), rev(bm))
    return s_f, s_b


def conv_ffn(h, w_up, conv_w, conv_b, w_down, grid):
    a = h @ w_up
    a = dwconv2d_grid(a, conv_w, conv_b) if grid else dwconv1d(a, conv_w[1], conv_b)
    val, gate = jnp.split(a, 2, axis=-1)
    return (jax.nn.gelu(gate) * val) @ w_down


def setup_inputs(seed: int = 0) -> dict:
    key = jax.random.key(seed)
    ks = jax.random.split(key, 25)
    f32 = jnp.float32

    def nrm(k, shape, s):
        return s * jax.random.normal(k, shape, f32)

    dt0 = jnp.exp(jax.random.uniform(ks[9], (DEPTH, 2, SSD_HEADS), f32, np.log(1e-3), np.log(1e-1)))
    return {
        "x": nrm(ks[0], (BATCH, SEQ, D_MODEL), 1.0),
        "c": nrm(ks[1], (BATCH, D_MODEL), 1.0),
        "ctx": nrm(ks[2], (BATCH, CTX_LEN, D_MODEL), 1.0),
        "c_ctx": nrm(ks[3], (D_MODEL,), 1.0),
        "w_ada": nrm(ks[4], (DEPTH, D_MODEL, 6 * D_MODEL), 0.5 * D_MODEL ** -0.5),
        "b_ada": nrm(ks[5], (DEPTH, 6 * D_MODEL), 0.02),
        "w_in": nrm(ks[6], (DEPTH, D_MODEL, N_IN), D_MODEL ** -0.5),
        "ssd_conv_w": nrm(ks[7], (DEPTH, SSD_CONV, XBC_WIDTH), SSD_CONV ** -0.5),
        "ssd_conv_b": nrm(ks[8], (DEPTH, XBC_WIDTH), 0.02),
        "ssd_dt_bias": dt0 + jnp.log(-jnp.expm1(-dt0)),
        "ssd_a_log": jnp.log(jax.random.uniform(ks[10], (DEPTH, 2, SSD_HEADS), f32, 1.0, 16.0)),
        "ssd_d": 1.0 + nrm(ks[11], (DEPTH, SSD_HEADS), 0.1),
        "ssd_norm_w": 1.0 + nrm(ks[12], (DEPTH, SSD_WIDTH), 0.1),
        "fnet_w": nrm(ks[13], (DEPTH, FNET_GROUPS, FNET_GDIM, FNET_GDIM), FNET_GDIM ** -0.5),
        "pool_w": nrm(ks[14], (DEPTH, len(POOL_WINDOWS), POOL_GDIM, POOL_GDIM), POOL_GDIM ** -0.5),
        "pool_scale": 1.0 + nrm(ks[15], (DEPTH, POOL_WIDTH), 0.1),
        "w_out": nrm(ks[16], (DEPTH, D_MIX, D_MODEL), BETA * D_MIX ** -0.5),
        "ln1_g": 1.0 + nrm(ks[17], (DEPTH, D_MODEL), 0.1),
        "ln1_b": nrm(ks[18], (DEPTH, D_MODEL), 0.02),
        "ffn_w_up": nrm(ks[19], (DEPTH, D_MODEL, 2 * D_FF), D_MODEL ** -0.5),
        "ffn_conv_w": nrm(ks[20], (DEPTH, FFN_CONV, FFN_CONV, 2 * D_FF), 1.0 / FFN_CONV),
        "ffn_conv_b": nrm(ks[21], (DEPTH, 2 * D_FF), 0.02),
        "ffn_w_down": nrm(ks[22], (DEPTH, D_FF, D_MODEL), BETA * D_FF ** -0.5),
        "ln2_g": 1.0 + nrm(ks[23], (DEPTH, D_MODEL), 0.1),
        "ln2_b": nrm(ks[24], (DEPTH, D_MODEL), 0.02),
    }


def reference(x, c, ctx, c_ctx, w_ada, b_ada, w_in, ssd_conv_w, ssd_conv_b, ssd_dt_bias, ssd_a_log, ssd_d,
              ssd_norm_w, fnet_w, pool_w, pool_scale, w_out, ln1_g, ln1_b, ffn_w_up, ffn_conv_w, ffn_conv_b,
              ffn_w_down, ln2_g, ln2_b):
    bsz = x.shape[0]
    zero_state = jnp.zeros((bsz, SSD_HEADS, SSD_HEADDIM, SSD_STATE), jnp.float32)
    for l in range(DEPTH):
        last = l == DEPTH - 1
        sh1, sc1, g1, sh2, sc2, g2 = ada(c, w_ada[l], b_ada[l])
        csh1, csc1, cg1, csh2, csc2, cg2 = ada(c_ctx[None, :], w_ada[l], b_ada[l])
        mixer_p = (ssd_conv_w[l], ssd_conv_b[l], ssd_dt_bias[l], ssd_a_log[l], ssd_d[l], ssd_norm_w[l],
                   fnet_w[l], pool_w[l], pool_scale[l], w_out[l])
        u_ctx = modulate(ctx, csh1, csc1) @ w_in[l]
        u_lat = modulate(x, sh1, sc1) @ w_in[l]
        if last:
            s_f, s_b = ctx_scan_states(u_ctx, ssd_conv_w[l], ssd_conv_b[l], ssd_dt_bias[l], ssd_a_log[l])
        else:
            mix_ctx, s_f, s_b = token_mixer(u_ctx, zero_state, zero_state, *mixer_p)
        mix_lat, _, _ = token_mixer(u_lat, s_f, s_b, *mixer_p)
        x = post_norm(x, mix_lat, g1, ln1_g[l], ln1_b[l])
        ffn_lat = conv_ffn(modulate(x, sh2, sc2), ffn_w_up[l], ffn_conv_w[l], ffn_conv_b[l], ffn_w_down[l], True)
        x = post_norm(x, ffn_lat, g2, ln2_g[l], ln2_b[l])
        if not last:
            ctx = post_norm(ctx, mix_ctx, cg1, ln1_g[l], ln1_b[l])
            ffn_ctx = conv_ffn(modulate(ctx, csh2, csc2), ffn_w_up[l], ffn_conv_w[l], ffn_conv_b[l], ffn_w_down[l], False)
            ctx = post_norm(ctx, ffn_ctx, cg2, ln2_g[l], ln2_b[l])
    return x
```

```cpp
#include <hip/hip_runtime.h>
#include <cstdio>
#include <cstdint>
namespace pg8 {
#define PG8_LAS __attribute__((address_space(3)))
typedef unsigned short bf16_t;
typedef short bf16x8 __attribute__((ext_vector_type(8)));
typedef float f32x4 __attribute__((ext_vector_type(4)));
typedef unsigned u32x4 __attribute__((ext_vector_type(4)));
constexpr int BM = 256, BK = 64, HALF = 128, HTB = HALF * BK * 2  , STAGE_BYTES = 8 * HTB, NXCD = 8, WGM = 8;

__host__ __device__ __forceinline__ int lds_byte(int r, int c) { const int st = (r >> 4) * 2 + (c >> 5), rr = r & 15, cc = c & 31, ob = rr * 64 + cc * 2; return st * 1024 + (ob ^ (((ob >> 9) & 1) << 5)); }
__host__ __device__ __forceinline__ void stage_rc(int b, int& R, int& C) { const int st = b / 1024, sb = b % 1024, swz = sb ^ (((sb >> 9) & 1) << 5); R = (st >> 1) * 16 + swz / 64; C = (st & 1) * 32 + (swz % 64) / 2; }
__host__ __device__ __forceinline__ int perm32(int rho) { const int n = rho >> 4, i = rho & 15; return 8 * (i >> 2) + 4 * n + (i & 3); }

struct Unit { int pm, pn; };
struct Gemm { const bf16_t* A; const bf16_t* Bt; int M, N, K; };

struct StaticOrder {
    int nM, nN, nwg, G, c;
    __host__ __device__ void init(int M, int N, int G_, int c_) { nM = M / BM; nN = N / BM; nwg = nM * nN; G = G_; c = c_; }
    __host__ __device__ bool next(int i, Unit& u) const {
        const long L = (long)i * G + c; if (L >= nwg) return false;
        int wgid = (int)L; { const int q = nwg / NXCD, r = nwg % NXCD, xcd = wgid % NXCD, off = wgid / NXCD; wgid = (xcd < r ? xcd * (q + 1) : r * (q + 1) + (xcd - r) * q) + off; }
        const int nig = WGM * nN, gid = wgid / nig, fm = gid * WGM, gsz = (nM - fm) < WGM ? (nM - fm) : WGM;
        u.pm = fm + ((wgid % nig) % gsz); u.pn = (wgid % nig) / gsz; return true;
    }
    __device__ __forceinline__ void a_ready(const Unit&) const {}
    __device__ __forceinline__ void done(const Unit&) const {}
};

__device__ __forceinline__ unsigned cvt_pk_bf16(float lo, float hi) { unsigned r; asm volatile("v_cvt_pk_bf16_f32 %0, %1, %2" : "=v"(r) : "v"(lo), "v"(hi)); return r; }
typedef float f32x2 __attribute__((ext_vector_type(2)));
__device__ __forceinline__ f32x2 gelu_pk(f32x2 v) {
    const f32x2 av = __builtin_elementwise_abs(v), d = av * 0.2316418882f + 1.0f;
    f32x2 t; t.x = __builtin_amdgcn_rcpf(d.x); t.y = __builtin_amdgcn_rcpf(d.y);
    f32x2 q = t * 0.5307027145f + (-0.7265760135f); q = q * t + 0.7107068705f; q = q * t + (-0.142248368f); q = q * t + 0.127414796f; q = q * t;
    const f32x2 s = (v * v) * (-0.72134752044f);
    f32x2 e; e.x = __builtin_amdgcn_exp2f(s.x); e.y = __builtin_amdgcn_exp2f(s.y);
    const f32x2 m = v * (q * e), r = v - m;
    f32x2 o; o.x = v.x < 0.f ? m.x : r.x; o.y = v.y < 0.f ? m.y : r.y; return o;
}

template <int ACT  > struct EpiBf16 {
    static constexpr bool PERM = true, AFTER_DRAIN = false; static_assert(ACT == 0 || ACT == 1, "EpiBf16: ACT is 0 (none) or 1 (gelu_pk)");
    bf16_t* O; int ldc; const float* bias; int split_cols; size_t split_stride; float scale0;
    __device__ __forceinline__ void operator()(const f32x4 (&acc)[2][2][4][2], const Unit& u, int wr, int wc, int fr, int fq) const {
        const int row0 = u.pm * BM + wr * 64 + fr; int colt = u.pn * BM; bf16_t* base = O;
        float sc = 1.f; if (split_cols) { const int t = colt / split_cols; base += (size_t)t * split_stride; colt -= t * split_cols; if (t == 0) sc = scale0; }
        const int col0 = colt + wc * 32 + 8 * fq, bcol0 = u.pn * BM + wc * 32 + 8 * fq;
        f32x4 bv[2][2];
#pragma unroll
        for (int bj = 0; bj < 2; ++bj)
#pragma unroll
            for (int n = 0; n < 2; ++n) bv[bj][n] = bias ? *(const f32x4*)(bias + bcol0 + bj * HALF + 4 * n) : (f32x4){0.f, 0.f, 0.f, 0.f};
#pragma unroll
        for (int ai = 0; ai < 2; ++ai)
#pragma unroll
            for (int m = 0; m < 4; ++m) { bf16_t* rowp = base + (size_t)(row0 + ai * HALF + m * 16) * ldc + col0;
#pragma unroll
                for (int bj = 0; bj < 2; ++bj) { f32x4 v0 = acc[ai][bj][m][0] + bv[bj][0], v1 = acc[ai][bj][m][1] + bv[bj][1];
                    if (ACT == 1) { f32x2 a = gelu_pk((f32x2){v0[0], v0[1]}), b = gelu_pk((f32x2){v0[2], v0[3]}), c = gelu_pk((f32x2){v1[0], v1[1]}), d = gelu_pk((f32x2){v1[2], v1[3]});
                        v0 = (f32x4){a.x, a.y, b.x, b.y}; v1 = (f32x4){c.x, c.y, d.x, d.y}; }
                    v0 = v0 * sc; v1 = v1 * sc; u32x4 w; w.x = cvt_pk_bf16(v0[0], v0[1]); w.y = cvt_pk_bf16(v0[2], v0[3]); w.z = cvt_pk_bf16(v1[0], v1[1]); w.w = cvt_pk_bf16(v1[2], v1[3]);
                    *(u32x4*)(rowp + bj * HALF) = w; } }
    }
};
template <class Epi, class Sched, bool ALIGN_EPI = false, bool SP2 = false>
__device__ __forceinline__ void gemm_phase(PG8_LAS unsigned char* lds, const Gemm g, const Sched& S, const Epi& E) {
    int tid_ = threadIdx.x; asm volatile("" : "+v"(tid_)); const int tid = tid_, wid = __builtin_amdgcn_readfirstlane(tid >> 6), lane = tid & 63, wr = wid >> 2, wc = wid & 3, fr = lane & 15, fq = lane >> 4;
    const int K = g.K, nt = K / BK;
    unsigned voffA[2], voffB[2];
#pragma unroll
    for (int i = 0; i < 2; ++i) { int R, C; stage_rc(tid * 16 + i * 8192, R, C); const int Rb = Epi::PERM ? ((R & ~31) + perm32(R & 31)) : R;
        voffA[i] = (unsigned)(R * K + C) * 2u; voffB[i] = (unsigned)(Rb * K + C) * 2u; }
    const size_t kstep = (size_t)(BK * 2);
    const size_t hstep = (size_t)HALF * K * 2;
    const size_t tstep = 2 * hstep;
    const unsigned ldsw = (unsigned)wid * 1024u;
    const int aoff = lds_byte(wr * 64 + fr, fq * 8), boff = lds_byte(wc * 32 + fr, fq * 8);
#define PG8_SA(b, h) (((b) * 2 + (h)) * HTB)
#define PG8_SB(b, h) ((4 + (b) * 2 + (h)) * HTB)
#define PG8_STAGE(bufoff, gbase, voff) do { _Pragma("unroll") for (int _i = 0; _i < 2; ++_i) \
        __builtin_amdgcn_global_load_lds((const unsigned*)((const char*)(gbase) + (voff)[_i]), (PG8_LAS unsigned*)(lds + (bufoff) + ldsw + _i * 8192), 16, 0, 0); } while (0)
#define PG8_LDA(dst, b, h) do { _Pragma("unroll") for (int m = 0; m < 4; ++m) _Pragma("unroll") for (int k = 0; k < 2; ++k) dst[m][k] = *(const PG8_LAS bf16x8*)(lds + PG8_SA(b, h) + aoff + m * 2048 + k * 1024); } while (0)
#define PG8_LDB(dst, b, h) do { _Pragma("unroll") for (int n = 0; n < 2; ++n) _Pragma("unroll") for (int k = 0; k < 2; ++k) dst[n][k] = *(const PG8_LAS bf16x8*)(lds + PG8_SB(b, h) + boff + n * 2048 + k * 1024); } while (0)
#define PG8_MMA(ai, bj, At, Bt) do { __builtin_amdgcn_s_setprio(1); _Pragma("unroll") for (int m = 0; m < 4; ++m) _Pragma("unroll") for (int n = 0; n < 2; ++n) _Pragma("unroll") for (int k = 0; k < 2; ++k) \
        acc[ai][bj][m][n] = __builtin_amdgcn_mfma_f32_16x16x32_bf16(Bt[n][k], At[m][k], acc[ai][bj][m][n], 0, 0, 0); __builtin_amdgcn_s_setprio(0); } while (0)
#define PG8_WAIT_V(n) asm volatile("s_waitcnt vmcnt(" #n ")" ::: "memory")
#define PG8_WAIT_L(n) asm volatile("s_waitcnt lgkmcnt(" #n ")" ::: "memory")
#define PG8_BAR __builtin_amdgcn_s_barrier()
#define PG8_SCHED __builtin_amdgcn_sched_barrier(0)
    Unit cur, nxt; int ui = 0;
    if (!S.next(0, cur)) return;
    f32x4 acc[2][2][4][2];
#pragma unroll
    for (int a = 0; a < 2; ++a)
#pragma unroll
        for (int b = 0; b < 2; ++b)
#pragma unroll
            for (int m = 0; m < 4; ++m)
#pragma unroll
                for (int n = 0; n < 2; ++n) acc[a][b][m][n] = (f32x4){0.f, 0.f, 0.f, 0.f};
    bf16x8 At[4][2], B0[2][2], B1[2][2];
    const char* cA = (const char*)g.A + (size_t)cur.pm * tstep; const char* cB = (const char*)g.Bt + (size_t)cur.pn * tstep;
    S.a_ready(cur);
    if constexpr (SP2) {
        PG8_STAGE(PG8_SB(0, 0), cB, voffB); PG8_STAGE(PG8_SB(0, 1), cB + hstep, voffB); PG8_STAGE(PG8_SA(0, 0), cA, voffA); PG8_STAGE(PG8_SA(0, 1), cA + hstep, voffA);
        if (wr == 1) PG8_BAR;
        PG8_WAIT_V(2); PG8_BAR;
        PG8_STAGE(PG8_SB(1, 0), cB + kstep, voffB); PG8_STAGE(PG8_SA(1, 0), cA + kstep, voffA); PG8_STAGE(PG8_SB(1, 1), cB + hstep + kstep, voffB);
        PG8_WAIT_V(6); PG8_BAR;
    } else {
        PG8_STAGE(PG8_SB(0, 0), cB, voffB); PG8_STAGE(PG8_SA(0, 0), cA, voffA); PG8_STAGE(PG8_SB(0, 1), cB + hstep, voffB); PG8_STAGE(PG8_SA(0, 1), cA + hstep, voffA);
        if (wr == 1) PG8_BAR;
        PG8_WAIT_V(4); PG8_BAR;
        PG8_STAGE(PG8_SB(1, 0), cB + kstep, voffB); PG8_STAGE(PG8_SA(1, 0), cA + kstep, voffA); PG8_STAGE(PG8_SB(1, 1), cB + hstep + kstep, voffB);
        PG8_WAIT_V(6); PG8_BAR;
    }
    for (;;) {
        const bool has_next = S.next(ui + 1, nxt);
        const char* nA = has_next ? (const char*)g.A + (size_t)nxt.pm * tstep : cA; const char* nB = has_next ? (const char*)g.Bt + (size_t)nxt.pn * tstep : cB;
        for (int t = 0; t < nt; t += 2) {
            const bool last = (t == nt - 2);
            const char* a1 = cA + (size_t)(t + 1) * kstep;
            const char* a2 = last ? nA : cA + (size_t)(t + 2) * kstep; const char* b2 = last ? nB : cB + (size_t)(t + 2) * kstep;
            const char* a3 = a2 + kstep; const char* b3 = b2 + kstep;
            if (last && has_next) S.a_ready(nxt);
            if constexpr (SP2) {
            PG8_LDB(B0, 0, 0); PG8_LDB(B1, 0, 1); PG8_SCHED; PG8_LDA(At, 0, 0); PG8_STAGE(PG8_SA(1, 1), a1 + hstep, voffA);
            PG8_WAIT_V(8); PG8_WAIT_L(0); PG8_BAR; PG8_MMA(0, 0, At, B0); PG8_MMA(0, 1, At, B1); PG8_BAR; PG8_SCHED;
            PG8_LDA(At, 0, 1); PG8_STAGE(PG8_SB(0, 0), b2, voffB); PG8_STAGE(PG8_SB(0, 1), b2 + hstep, voffB); PG8_STAGE(PG8_SA(0, 0), a2, voffA);
            PG8_WAIT_V(8); PG8_WAIT_L(0); PG8_BAR; PG8_MMA(1, 0, At, B0); PG8_MMA(1, 1, At, B1); PG8_BAR; PG8_SCHED;
            PG8_LDB(B0, 1, 0); PG8_LDB(B1, 1, 1); PG8_SCHED; PG8_LDA(At, 1, 0); PG8_STAGE(PG8_SA(0, 1), a2 + hstep, voffA);
            PG8_WAIT_V(8); PG8_WAIT_L(0); PG8_BAR; PG8_MMA(0, 0, At, B0); PG8_MMA(0, 1, At, B1); PG8_BAR; PG8_SCHED;
            PG8_LDA(At, 1, 1); PG8_STAGE(PG8_SB(1, 0), b3, voffB); PG8_STAGE(PG8_SB(1, 1), b3 + hstep, voffB); PG8_STAGE(PG8_SA(1, 0), a3, voffA);
            PG8_WAIT_V(8); PG8_WAIT_L(0); PG8_BAR; PG8_MMA(1, 0, At, B0); PG8_MMA(1, 1, At, B1); PG8_BAR; PG8_SCHED;
            } else {
            PG8_LDB(B0, 0, 0); PG8_SCHED; PG8_LDA(At, 0, 0); PG8_STAGE(PG8_SA(1, 1), a1 + hstep, voffA);
            PG8_WAIT_L(8); PG8_BAR; PG8_WAIT_L(0); PG8_MMA(0, 0, At, B0); PG8_BAR; PG8_SCHED;
            PG8_LDB(B1, 0, 1); PG8_STAGE(PG8_SB(0, 0), b2, voffB);
            PG8_BAR; PG8_WAIT_L(0); PG8_MMA(0, 1, At, B1); PG8_BAR;
            PG8_LDA(At, 0, 1); PG8_STAGE(PG8_SA(0, 0), a2, voffA);
            PG8_BAR; PG8_WAIT_L(0); PG8_MMA(1, 0, At, B0); PG8_BAR; PG8_SCHED;
            PG8_STAGE(PG8_SB(0, 1), b2 + hstep, voffB);
            PG8_WAIT_V(6); PG8_BAR; PG8_MMA(1, 1, At, B1); PG8_BAR;
            PG8_LDB(B0, 1, 0); PG8_SCHED; PG8_LDA(At, 1, 0); PG8_STAGE(PG8_SA(0, 1), a2 + hstep, voffA);
            PG8_WAIT_L(8); PG8_BAR; PG8_WAIT_L(0); PG8_MMA(0, 0, At, B0); PG8_BAR; PG8_SCHED;
            PG8_LDB(B1, 1, 1); PG8_STAGE(PG8_SB(1, 0), b3, voffB);
            PG8_BAR; PG8_WAIT_L(0); PG8_MMA(0, 1, At, B1); PG8_BAR;
            PG8_LDA(At, 1, 1); PG8_STAGE(PG8_SA(1, 0), a3, voffA);
            PG8_BAR; PG8_WAIT_L(0); PG8_MMA(1, 0, At, B0); PG8_BAR; PG8_SCHED;
            PG8_STAGE(PG8_SB(1, 1), b3 + hstep, voffB);
            PG8_WAIT_V(6); PG8_BAR; PG8_MMA(1, 1, At, B1); PG8_BAR;
            }
        }
        if constexpr (ALIGN_EPI) { if (wr == 0) PG8_BAR; }
        if constexpr (!Epi::AFTER_DRAIN) { E(acc, cur, wr, wc, fr, fq); S.done(cur); }
        if (!has_next) break;
#pragma unroll
        for (int a = 0; a < 2; ++a)
#pragma unroll
            for (int b = 0; b < 2; ++b)
#pragma unroll
                for (int m = 0; m < 4; ++m)
#pragma unroll
                    for (int n = 0; n < 2; ++n) acc[a][b][m][n] = (f32x4){0.f, 0.f, 0.f, 0.f};
        cur = nxt; cA = nA; cB = nB; ++ui;
        if constexpr (ALIGN_EPI) { if (wr == 1) PG8_BAR; }
    }
    PG8_WAIT_V(0);
    if constexpr (!ALIGN_EPI) { if (wr == 0) PG8_BAR; }
    PG8_BAR;
    if constexpr (Epi::AFTER_DRAIN) { E.fused(acc, cur, wr, wc, fr, fq, lds, wid, lane); S.done(cur); }
#undef PG8_SA
#undef PG8_SB
#undef PG8_STAGE
#undef PG8_LDA
#undef PG8_LDB
#undef PG8_MMA
#undef PG8_WAIT_V
#undef PG8_WAIT_L
#undef PG8_BAR
#undef PG8_SCHED
}
}
constexpr int NWAVES = 8, NTHR = 512;
constexpr int DM = 1024, NB = 4, SEQ = 8192, CTXL = 256;
constexpr int RL = NB * SEQ, RC = NB * CTXL, RT = RL + RC;
constexpr int NIN_SRC = 2064, NIN = 2304;
constexpr int UC_Z = 0, UC_XBC = 512, UC_P = 1536, UC_Q = 1792, UC_POOL = 2048;
constexpr int SRC_DT = 1536, SRC_FNET = 1552, SRC_POOL = 1808;
constexpr int DFF = 2816, NUP = 5632, NHALF = 1408;
constexpr float LN_EPS = 1e-6f, ALPHA = 1.41421356237f;
constexpr int NLAYER = 2;

constexpr size_t MiB = 1u << 20;
constexpr size_t WS_CTL = 0, CTL_ZERO_BYTES = 1 * MiB;
constexpr size_t WS_ADA = 1 * MiB;
constexpr size_t WS_F = 2 * MiB;
constexpr size_t WS_DTRAW = 3 * MiB;
constexpr size_t WS_WIN = 6 * MiB;
constexpr size_t WS_WOUT = 15 * MiB;
constexpr size_t WS_WUP = 19 * MiB;
constexpr size_t WS_WDOWN = 41 * MiB;
constexpr size_t WS_XCTX = 52 * MiB;
constexpr size_t WS_H = 56 * MiB;
constexpr size_t WS_SH = 122 * MiB;
constexpr size_t WS_U = WS_SH;
constexpr size_t WS_CONCAT = WS_SH + 149 * MiB;
constexpr size_t WS_XBC = WS_SH + 215 * MiB;
constexpr size_t WS_YF = WS_SH + 281 * MiB;
constexpr size_t WS_YFFT = WS_SH + 347 * MiB;
constexpr size_t WS_YB = WS_H;
constexpr size_t WS_MIX = WS_SH;
constexpr size_t WS_AH = WS_SH;
constexpr size_t WS_G = WS_SH + 182 * MiB;
constexpr size_t WS_FFNO = WS_SH;
constexpr size_t WS_END = 512 * MiB;
static_assert(WS_YFFT + 32 * MiB <= WS_END && WS_G + 182 * MiB <= WS_END, "ws map");
constexpr int CW_TMO = 0, CW_CODE = 1, CW_BAR = 4096;

constexpr int RING_BYTES = 131072, LDSCTL_OFF = RING_BYTES, MISC_OFF = LDSCTL_OFF + 320, LDS_BYTES = 147456;
#define GAS __attribute__((address_space(1)))
#define LAS __attribute__((address_space(3)))
typedef unsigned short bf16;
typedef unsigned v4u __attribute__((ext_vector_type(4)));
typedef float f32x4 __attribute__((ext_vector_type(4)));
typedef short bf16x8 __attribute__((ext_vector_type(8)));
typedef GAS unsigned gu32;
typedef GAS unsigned long long gu64;
#define RLX_AGENT __ATOMIC_RELAXED, __HIP_MEMORY_SCOPE_AGENT
#define LDS_WAIT() asm volatile("s_waitcnt lgkmcnt(0)" ::: "memory")
#define VM_WAIT() asm volatile("s_waitcnt vmcnt(0)" ::: "memory")
__device__ __forceinline__ unsigned long long rt() { return __builtin_amdgcn_s_memrealtime(); }
__device__ __forceinline__ unsigned f2bf(float f) { unsigned u = __builtin_bit_cast(unsigned, f); return (u + 0x7fffu + ((u >> 16) & 1u)) >> 16; }
__device__ __forceinline__ unsigned pk2(float lo, float hi) { return f2bf(lo) | (f2bf(hi) << 16); }

#define XB_TMO      128
#define XB_XCNT(j)  (256  + 64 * (j))
#define XB_XSUB(j)  (1280 + 64 * (j))
#define XB_XGEN(j)  (2304 + 64 * (j))
#define XB_TOP      3328
#define XB_TOPGEN   3392
#define XCD_BAR_WORDS 3456
#define XB_SPIN_CAP (1u << 18)

__device__ __forceinline__ unsigned xb_ld(unsigned* p)              { return __hip_atomic_load(p, __ATOMIC_RELAXED, __HIP_MEMORY_SCOPE_AGENT); }
__device__ __forceinline__ unsigned xb_add(unsigned* p, unsigned v) { return __hip_atomic_fetch_add(p, v, __ATOMIC_RELAXED, __HIP_MEMORY_SCOPE_AGENT); }
__device__ __forceinline__ unsigned xb_xcc_id() { return (unsigned)__builtin_amdgcn_s_getreg((3 << 11) | 20) & 0xFu; }
#define XB_SPIN(cond, bar) do { unsigned _sp = 0; while (cond) { __builtin_amdgcn_s_sleep(1); \
    if ((++_sp & 255u) == 0u) { if (xb_ld(&(bar)[XB_TMO])) break; if (_sp > XB_SPIN_CAP) { atomicAdd(&(bar)[XB_TMO], 1u); break; } } } } while (0)

struct XcdBarrier {
    unsigned* bar; unsigned x;
    volatile LAS unsigned* st;
};

__device__ __forceinline__ XcdBarrier xcd_barrier_post(unsigned* bar, volatile LAS unsigned* st) {
    XcdBarrier b; b.bar = bar; b.x = xb_xcc_id(); b.st = st;
    if (threadIdx.x == 0) (void)xb_add(&bar[XB_XCNT(b.x)], 1u);
    return b;
}
__device__ __forceinline__ void xcd_barrier_complete(unsigned* bar, unsigned x, unsigned& nloc, unsigned& nx) {
    const unsigned G = gridDim.x * gridDim.y * gridDim.z;
    unsigned sum, cnt, mine, sp = 0u;
    for (;;) {
        sum = 0u; cnt = 0u; mine = 0u;
#pragma unroll
        for (unsigned j = 0; j < 16; ++j) { const unsigned c = xb_ld(&bar[XB_XCNT(j)]); sum += c; cnt += (c > 0u) ? 1u : 0u; mine = (j == x) ? c : mine; }
        if (sum == G) break;
        __builtin_amdgcn_s_sleep(1);
        if ((++sp & 255u) == 0u) { if (xb_ld(&bar[XB_TMO])) break; if (sp > XB_SPIN_CAP) { atomicAdd(&bar[XB_TMO], 1u); break; } }
    }
    nloc = mine > 0u ? mine : 1u; nx = cnt > 0u ? cnt : 1u;
}

__device__ __forceinline__ void xcd_barrier(const XcdBarrier& b) {
    asm volatile("s_waitcnt vmcnt(0)" ::: "memory");
    __syncthreads();
    if (threadIdx.x == 0) {
        unsigned* bar = b.bar;
        __builtin_amdgcn_s_waitcnt(0);
        unsigned nloc = b.st[0], nx = b.st[1];
        if (nloc == 0u) { xcd_barrier_complete(bar, b.x, nloc, nx); b.st[0] = nloc; b.st[1] = nx; }
        const unsigned old = xb_add(&bar[XB_XSUB(b.x)], 1u);
        const unsigned gen = old / nloc;
        if (old + 1u == (gen + 1u) * nloc) {
            __builtin_amdgcn_fence(__ATOMIC_RELEASE, "agent");
            asm volatile("s_waitcnt vmcnt(0)" ::: "memory");
            const unsigned og = xb_add(&bar[XB_TOP], 1u);
            const unsigned tg = og / nx;
            if (og + 1u == (tg + 1u) * nx) xb_add(&bar[XB_TOPGEN], 1u);
            else XB_SPIN(xb_ld(&bar[XB_TOPGEN]) == tg, bar);
            __builtin_amdgcn_fence(__ATOMIC_ACQUIRE, "agent");
            xb_add(&bar[XB_XGEN(b.x)], 1u);
            asm volatile("s_waitcnt vmcnt(0)" ::: "memory");
        } else {
            XB_SPIN(xb_ld(&bar[XB_XGEN(b.x)]) == gen, bar);
            __builtin_amdgcn_fence(__ATOMIC_ACQUIRE, "agent");
            asm volatile("s_waitcnt vmcnt(0)" ::: "memory");
        }
    }
    __syncthreads();
}
typedef unsigned u32x2 __attribute__((ext_vector_type(2)));
__device__ __forceinline__ float bf2f(unsigned short b) { return __uint_as_float((unsigned)b << 16); }
__device__ __forceinline__ float bflo(unsigned w) { return __uint_as_float(w << 16); }
__device__ __forceinline__ float bfhi(unsigned w) { return __uint_as_float(w & 0xffff0000u); }
__device__ __forceinline__ float silu_f(float x) { return x / (1.f + __expf(-x)); }
__device__ __forceinline__ float gelu_tanh_f(float x) { const float y = 1.5957691216f * (x + 0.044715f * x * x * x); return x / (1.f + __expf(-y)); }
__device__ __forceinline__ float softplus_f(float x) { return x > 20.f ? x : log1pf(expf(x)); }
__device__ __forceinline__ float wave_sum(float v) {
#pragma unroll
    for (int o = 1; o < 64; o <<= 1) v += __shfl_xor(v, o);
    return v;
}
__device__ __forceinline__ void unpack8(const v4u w, float (&f)[8]) { f[0] = bflo(w.x); f[1] = bfhi(w.x); f[2] = bflo(w.y); f[3] = bfhi(w.y); f[4] = bflo(w.z); f[5] = bfhi(w.z); f[6] = bflo(w.w); f[7] = bfhi(w.w); }
__device__ __forceinline__ v4u pack8(const float (&f)[8]) { v4u w; w.x = pk2(f[0], f[1]); w.y = pk2(f[2], f[3]); w.z = pk2(f[4], f[5]); w.w = pk2(f[6], f[7]); return w; }

struct Frame {
    LAS unsigned char* lds; volatile LAS unsigned* MISC; gu32* ctl;
    int G;
    float* out;
    unsigned char* ws;
};
#define WSP(T, off) ((T*)(F.ws + (off)))
#define PH_IDS() int tid = threadIdx.x; asm volatile("" : "+v"(tid)); const int lane = tid & 63; const int wave = __builtin_amdgcn_readfirstlane(tid >> 6); int bid = blockIdx.x; asm volatile("" : "+s"(bid)); (void)lane; (void)wave; (void)bid;
__device__ __forceinline__ const float* inp_ptr(int i) { asm volatile("" : "+s"(i)); return ((const float* const __attribute__((address_space(4)))*)__builtin_amdgcn_kernarg_segment_ptr())[i]; }
enum { I_x = 0, I_c, I_ctx, I_c_ctx, I_w_ada, I_b_ada, I_w_in, I_ssd_conv_w, I_ssd_conv_b, I_ssd_dt_bias, I_ssd_a_log, I_ssd_d, I_ssd_norm_w, I_fnet_w, I_pool_w, I_pool_scale, I_w_out, I_ln1_g, I_ln1_b, I_ffn_w_up, I_ffn_conv_w, I_ffn_conv_b, I_ffn_w_down, I_ln2_g, I_ln2_b };

struct RowInfo { int pos, L, v, base; };
__device__ __forceinline__ RowInfo row_info(int row) {
    RowInfo r;
    if (row < RL) { r.pos = row & (SEQ - 1); r.L = SEQ; r.v = row >> 13; r.base = row & ~(SEQ - 1); }
    else { const int rr = row - RL; r.pos = rr & (CTXL - 1); r.L = CTXL; r.v = 4; r.base = RL + (rr & ~(CTXL - 1)); }
    return r;
}
__device__ __forceinline__ float* stream_row(Frame& F, int row) { return row < RL ? F.out + (size_t)row * DM : WSP(float, WS_XCTX) + (size_t)(row - RL) * DM; }
__device__ __forceinline__ const float* input_row(Frame& F, int row) { return row < RL ? inp_ptr(I_x) + (size_t)row * DM : inp_ptr(I_ctx) + (size_t)(row - RL) * DM; }

__device__ __forceinline__ void transpose_item(const float* W, int ldw, bf16* WT, int ldt, LAS float* scr, int lane) {
#pragma unroll 8
    for (int i = 0; i < 32; ++i) { const int kk = 2 * i + (lane >> 5); scr[kk * 33 + (lane & 31)] = W[(size_t)kk * ldw + (lane & 31)]; }
    LDS_WAIT(); asm volatile("" ::: "memory");
    const int c = lane & 7;
#pragma unroll
    for (int j = 0; j < 4; ++j) { const int n = (lane >> 3) + 8 * j; const LAS float* s = scr + (8 * c) * 33 + n;
        v4u o; o.x = pk2(s[0 * 33], s[1 * 33]); o.y = pk2(s[2 * 33], s[3 * 33]); o.z = pk2(s[4 * 33], s[5 * 33]); o.w = pk2(s[6 * 33], s[7 * 33]);
        *(GAS v4u*)(WT + (size_t)n * ldt + 8 * c) = o; }
    LDS_WAIT(); asm volatile("" ::: "memory");
}
__device__ __forceinline__ void p0a(Frame& F) {
    PH_IDS();
    {
        LAS float* sc = (LAS float*)F.lds; LAS float* red = (LAS float*)(F.lds + 20480);
        bool first = true;
        for (int unit = bid; unit < 192; unit += F.G) {
            if (first) { for (int i = tid; i < 5 * 1024; i += NTHR) { const int v = i >> 10, k = i & 1023; const float cv = v < 4 ? inp_ptr(I_c)[v * 1024 + k] : inp_ptr(I_c_ctx)[k]; sc[i] = cv / (1.f + expf(-cv)); } __syncthreads(); first = false; }
            const int l = unit / 96, jg = unit % 96;
            const float* w = inp_ptr(I_w_ada) + (size_t)l * 1024 * 6144 + jg * 64 + lane;
            float acc[5] = {0.f, 0.f, 0.f, 0.f, 0.f};
#pragma unroll 8
            for (int kk = 0; kk < 128; ++kk) { const int k = wave * 128 + kk; const float wv = w[(size_t)k * 6144];
#pragma unroll
                for (int v = 0; v < 5; ++v) acc[v] += sc[v * 1024 + k] * wv; }
#pragma unroll
            for (int v = 0; v < 5; ++v) red[(wave * 5 + v) * 64 + lane] = acc[v];
            __syncthreads();
            if (tid < 320) { const int v = tid >> 6, ln = tid & 63; float s = inp_ptr(I_b_ada)[l * 6144 + jg * 64 + ln];
#pragma unroll
                for (int w8 = 0; w8 < 8; ++w8) s += red[(w8 * 5 + v) * 64 + ln];
                WSP(float, WS_ADA)[(l * 5 + v) * 6144 + jg * 64 + ln] = s; }
            __syncthreads();
        }
        __syncthreads();
    }
    {
        LAS float* scr = (LAS float*)(F.lds + wave * 16384);
        const int gw = bid * NWAVES + wave, NGW = F.G * NWAVES;
        constexpr int I_IN = 48 * 16, I_OUT = 32 * 16, I_UP = 176 * 16, I_DN = 32 * 44, I_L = I_IN + I_OUT + I_UP + I_DN;
        for (int it = gw; it < NLAYER * I_L; it += NGW) {
            const int l = it / I_L; int r = it % I_L;
            if (r < I_IN) { const int kb = r / 48, nb = r % 48;
                transpose_item(inp_ptr(I_w_in) + (size_t)l * DM * NIN_SRC + (size_t)(64 * kb) * NIN_SRC + 32 * nb, NIN_SRC, WSP(bf16, WS_WIN) + (size_t)l * NIN * DM + (size_t)(32 * nb) * DM + 64 * kb, DM, scr, lane); continue; }
            r -= I_IN;
            if (r < I_OUT) { const int kb = r / 32, nb = r % 32;
                transpose_item(inp_ptr(I_w_out) + (size_t)l * DM * DM + (size_t)(64 * kb) * DM + 32 * nb, DM, WSP(bf16, WS_WOUT) + (size_t)l * DM * DM + (size_t)(32 * nb) * DM + 64 * kb, DM, scr, lane); continue; }
            r -= I_OUT;
            if (r < I_UP) { const int kb = r / 176, nb = r % 176, ti = nb >> 3, w8 = nb & 7; const int scol = (w8 < 4) ? 128 * ti + 32 * w8 : DFF + 128 * ti + 32 * (w8 - 4);
                transpose_item(inp_ptr(I_ffn_w_up) + (size_t)l * DM * NUP + (size_t)(64 * kb) * NUP + scol, NUP, WSP(bf16, WS_WUP) + (size_t)l * NUP * DM + (size_t)(32 * nb) * DM + 64 * kb, DM, scr, lane); continue; }
            r -= I_UP;
            { const int kb = r / 32, nb = r % 32;
                transpose_item(inp_ptr(I_ffn_w_down) + (size_t)l * DFF * DM + (size_t)(64 * kb) * DM + 32 * nb, DM, WSP(bf16, WS_WDOWN) + (size_t)l * DM * DFF + (size_t)(32 * nb) * DFF + 64 * kb, DFF, scr, lane); }
        }
    }
    {
        const int gt = bid * NTHR + tid, NGT = F.G * NTHR;
        for (int it = gt; it < NLAYER * 3 * 4 * 4096; it += NGT) {
            const int d = it & 63, c = (it >> 6) & 63, g = (it >> 12) & 3, wl = it >> 14, which = wl % 3, l = wl / 3;
            float s = 0.f;
            if (which == 2) s = inp_ptr(I_pool_w)[((size_t)(l * 4 + g) * 64 + c) * 64 + d] * inp_ptr(I_pool_scale)[l * 256 + g * 64 + d];
            else { const float* fw = inp_ptr(I_fnet_w) + (size_t)(l * 4 + g) * 4096 + d;
                for (int m = 0; m < 64; ++m) { const float a = (float)((c * m) & 63) * (1.f / 32.f); const float t = which == 0 ? cospif(a) : sinpif(a); s += t * fw[m * 64]; }
                s *= 0.125f; }
            WSP(float, WS_F)[it] = s;
        }
    }
}

__device__ __forceinline__ void ln_normalize(f32x4 (&v)[4]) {
    float s = 0.f;
#pragma unroll
    for (int j = 0; j < 4; ++j) s += (v[j].x + v[j].y) + (v[j].z + v[j].w);
    const float mean = wave_sum(s) * (1.f / DM); float s2 = 0.f;
#pragma unroll
    for (int j = 0; j < 4; ++j) { v[j] = v[j] - mean; s2 += (v[j].x * v[j].x + v[j].y * v[j].y) + (v[j].z * v[j].z + v[j].w * v[j].w); }
    const float rstd = 1.f / sqrtf(wave_sum(s2) * (1.f / DM) + LN_EPS);
#pragma unroll
    for (int j = 0; j < 4; ++j) v[j] = v[j] * rstd;
}
__device__ __forceinline__ void mod_store_dt(Frame& F, const int lane, const f32x4 (&xn)[4], const float* shift, const float* scale, bf16* hrow, bool do_dt, float* dtrow, const LAS float* wdtT) {
    f32x4 h[4];
#pragma unroll
    for (int j = 0; j < 4; ++j) { const f32x4 sc = *(const f32x4*)(scale + 256 * j + 4 * lane), sh = *(const f32x4*)(shift + 256 * j + 4 * lane);
        h[j] = xn[j] * (sc + 1.f) + sh;
        u32x2 w; w.x = pk2(h[j].x, h[j].y); w.y = pk2(h[j].z, h[j].w); *(u32x2*)(hrow + 256 * j + 4 * lane) = w; }
    if (do_dt) {
        float mine = 0.f;
#pragma unroll
        for (int o = 0; o < 16; ++o) { float a = 0.f;
#pragma unroll
            for (int j = 0; j < 4; ++j) { const f32x4 w = *(const LAS f32x4*)(wdtT + o * 1024 + 256 * j + 4 * lane); a += (h[j].x * w.x + h[j].y * w.y) + (h[j].z * w.z + h[j].w * w.w); }
            a = wave_sum(a); if (lane == o) mine = a; }
        if (lane < 16) dtrow[lane] = mine;
    }
}
__device__ __forceinline__ void stage_wdt(Frame& F, const int tid, int l, LAS float* wdtT) {
    for (int i = tid; i < 16384; i += NTHR) { const int k = i >> 4, o = i & 15; wdtT[o * 1024 + k] = inp_ptr(I_w_in)[(size_t)l * DM * NIN_SRC + (size_t)k * NIN_SRC + SRC_DT + o]; }
}
__device__ __forceinline__ void p0b(Frame& F) {
    PH_IDS();
    {
        LAS float* scr = (LAS float*)(F.lds + wave * 16384);
        const int gw = bid * NWAVES + wave, NGW = F.G * NWAVES;
        for (int it = gw; it < NLAYER * 3 * 4 * 16 * 2; it += NGW) {
            const int nb2 = it & 1, kb = (it >> 1) & 15, g = (it >> 5) & 3, wl = it >> 7, which = wl % 3, l = wl / 3;
            const int soff = (which == 2 ? SRC_POOL : SRC_FNET) + 64 * g, drow = (which == 0 ? UC_P : which == 1 ? UC_Q : UC_POOL) + 64 * g + 32 * nb2;
            const float* W = inp_ptr(I_w_in) + (size_t)l * DM * NIN_SRC + (size_t)(64 * kb) * NIN_SRC + soff;
            for (int i = 0; i < 64; ++i) scr[i * 64 + lane] = W[(size_t)i * NIN_SRC + lane];
            LDS_WAIT(); asm volatile("" ::: "memory");
            const float* Fm = WSP(float, WS_F) + (size_t)((l * 3 + which) * 4 + g) * 4096 + 32 * nb2;
            const int c8 = lane & 7, dn = lane >> 3;
#pragma unroll 1
            for (int j = 0; j < 4; ++j) { const int d = dn + 8 * j; float acc[8];
#pragma unroll
                for (int q = 0; q < 8; ++q) acc[q] = 0.f;
                for (int cc = 0; cc < 64; ++cc) { const float f = Fm[cc * 64 + d];
#pragma unroll
                    for (int q = 0; q < 8; ++q) acc[q] += scr[(8 * c8 + q) * 64 + cc] * f; }
                *(GAS v4u*)(WSP(bf16, WS_WIN) + (size_t)l * NIN * DM + (size_t)(drow + d) * DM + 64 * kb + 8 * c8) = pack8(acc); }
            LDS_WAIT(); asm volatile("" ::: "memory");
        }
    }
    __syncthreads();
    LAS float* wdtT = (LAS float*)F.lds;
    stage_wdt(F, tid, 0, wdtT);
    __syncthreads();
    const int gw = bid * NWAVES + wave, NGW = F.G * NWAVES;
    for (int row = gw; row < RT; row += NGW) {
        const RowInfo ri = row_info(row); const float* xr = input_row(F, row);
        f32x4 v[4];
#pragma unroll
        for (int j = 0; j < 4; ++j) v[j] = *(const f32x4*)(xr + 256 * j + 4 * lane);
        ln_normalize(v);
        const float* ad = WSP(float, WS_ADA) + (size_t)(0 * 5 + ri.v) * 6144;
        mod_store_dt(F, lane, v, ad, ad + 1024, WSP(bf16, WS_H) + (size_t)row * DM, true, WSP(float, WS_DTRAW) + (size_t)row * 16, wdtT);
    }
}
__device__ __forceinline__ void post_norm_pass(Frame& F, int l, int which, int nrows, const bf16* M) {
    PH_IDS();
    const bool has_next = (which == 0) || (l + 1 < NLAYER);
    const bool do_dt = (which == 1) && has_next;
    LAS float* wdtT = (LAS float*)F.lds;
    if (do_dt) { stage_wdt(F, tid, l + 1, wdtT); __syncthreads(); }
    const float* gam = (which == 0 ? inp_ptr(I_ln1_g) : inp_ptr(I_ln2_g)) + l * DM; const float* bet = (which == 0 ? inp_ptr(I_ln1_b) : inp_ptr(I_ln2_b)) + l * DM;
    const int gw = bid * NWAVES + wave, NGW = F.G * NWAVES;
    for (int row = gw; row < nrows; row += NGW) {
        const RowInfo ri = row_info(row);
        const float* xin = (which == 0 && l == 0) ? input_row(F, row) : stream_row(F, row);
        float* xout = stream_row(F, row);
        const float* ad = WSP(float, WS_ADA) + (size_t)(l * 5 + ri.v) * 6144;
        const float* gate = ad + (which == 0 ? 2048 : 5120);
        const bf16* mr = M + (size_t)row * DM;
        f32x4 v[4];
#pragma unroll
        for (int j = 0; j < 4; ++j) { const f32x4 xv = *(const f32x4*)(xin + 256 * j + 4 * lane), gv = *(const f32x4*)(gate + 256 * j + 4 * lane);
            const u32x2 mw = *(const u32x2*)(mr + 256 * j + 4 * lane);
            v[j].x = ALPHA * xv.x + gv.x * bflo(mw.x); v[j].y = ALPHA * xv.y + gv.y * bfhi(mw.x); v[j].z = ALPHA * xv.z + gv.z * bflo(mw.y); v[j].w = ALPHA * xv.w + gv.w * bfhi(mw.y); }
        ln_normalize(v);
#pragma unroll
        for (int j = 0; j < 4; ++j) { const f32x4 gm = *(const f32x4*)(gam + 256 * j + 4 * lane), bt = *(const f32x4*)(bet + 256 * j + 4 * lane);
            v[j] = v[j] * gm + bt; *(f32x4*)(xout + 256 * j + 4 * lane) = v[j]; }
        if (has_next) {
            ln_normalize(v);
            const float* ad2 = (which == 0) ? ad + 3072 : WSP(float, WS_ADA) + (size_t)((l + 1) * 5 + ri.v) * 6144;
            mod_store_dt(F, lane, v, ad2, ad2 + 1024, WSP(bf16, WS_H) + (size_t)row * DM, do_dt, WSP(float, WS_DTRAW) + (size_t)row * 16, wdtT);
        }
    }
}
__device__ __forceinline__ void p2_v1(Frame& F, int l) {
    PH_IDS();
    const int gt = bid * NTHR + tid, NGT = F.G * NTHR;
    const bf16* U = WSP(bf16, WS_U);
    for (int it = gt; it < RT * 128; it += NGT) {
        const int row = it >> 7, c8 = (it & 127) * 8; const RowInfo ri = row_info(row);
        float acc[8];
        { const f32x4 b0 = *(const f32x4*)(inp_ptr(I_ssd_conv_b) + l * 1024 + c8), b1 = *(const f32x4*)(inp_ptr(I_ssd_conv_b) + l * 1024 + c8 + 4);
          acc[0] = b0.x; acc[1] = b0.y; acc[2] = b0.z; acc[3] = b0.w; acc[4] = b1.x; acc[5] = b1.y; acc[6] = b1.z; acc[7] = b1.w; }
#pragma unroll
        for (int k = 0; k < 3; ++k) { const int t = ri.pos + k - 1;
            if (t >= 0 && t < ri.L) { float uf[8]; unpack8(*(const v4u*)(U + (size_t)(row + k - 1) * NIN + UC_XBC + c8), uf);
                const float* w = inp_ptr(I_ssd_conv_w) + (size_t)(l * 3 + k) * 1024 + c8; const f32x4 w0 = *(const f32x4*)w, w1 = *(const f32x4*)(w + 4);
                acc[0] += w0.x * uf[0]; acc[1] += w0.y * uf[1]; acc[2] += w0.z * uf[2]; acc[3] += w0.w * uf[3]; acc[4] += w1.x * uf[4]; acc[5] += w1.y * uf[5]; acc[6] += w1.z * uf[6]; acc[7] += w1.w * uf[7]; } }
#pragma unroll
        for (int q = 0; q < 8; ++q) acc[q] = silu_f(acc[q]);
        *(v4u*)(WSP(bf16, WS_XBC) + (size_t)row * DM + c8) = pack8(acc);
    }
    for (int it = gt; it < RT * 32; it += NGT) {
        const int row = it >> 5, c8 = (it & 31) * 8, gi = c8 >> 6; const RowInfo ri = row_info(row);
        const int win = 2 << gi, left = win >> 1, right = win - 1 - left;
        const int lo = max(ri.pos - left, 0), hi = min(ri.pos + right + 1, ri.L);
        float s[8], self[8];
#pragma unroll
        for (int q = 0; q < 8; ++q) s[q] = 0.f;
        for (int t = lo; t < hi; ++t) { float uf[8]; unpack8(*(const v4u*)(U + (size_t)(ri.base + t) * NIN + UC_POOL + c8), uf);
#pragma unroll
            for (int q = 0; q < 8; ++q) s[q] += uf[q]; }
        unpack8(*(const v4u*)(U + (size_t)row * NIN + UC_POOL + c8), self);
        const float inv = 1.f / (float)(hi - lo);
#pragma unroll
        for (int q = 0; q < 8; ++q) s[q] = s[q] * inv - self[q];
        *(v4u*)(WSP(bf16, WS_CONCAT) + (size_t)row * DM + 768 + c8) = pack8(s);
    }
    {
        LAS float* tw = (LAS float*)F.lds;
        if (tid < 64) { tw[tid] = cospif((float)tid * (1.f / 32.f)); tw[64 + tid] = sinpif((float)tid * (1.f / 32.f)); }
        __syncthreads();
        for (int it = gt; it < NB * 64 * 128 * 64; it += NGT) {
            const int c4 = (it & 63) * 4, l2 = (it >> 6) & 127, k1 = (it >> 13) & 63, b = it >> 19;
            float yr[4] = {0.f, 0.f, 0.f, 0.f}, yi[4] = {0.f, 0.f, 0.f, 0.f};
            for (int l1 = 0; l1 < 64; ++l1) { const size_t ro = (size_t)(b * SEQ + 128 * l1 + l2) * NIN;
                const u32x2 pw = *(const u32x2*)(U + ro + UC_P + c4), qw = *(const u32x2*)(U + ro + UC_Q + c4);
                const int e = (k1 * l1) & 63; const float wr = tw[e], wi = tw[64 + e];
                const float p[4] = {bflo(pw.x), bfhi(pw.x), bflo(pw.y), bfhi(pw.y)}, q[4] = {bflo(qw.x), bfhi(qw.x), bflo(qw.y), bfhi(qw.y)};
#pragma unroll
                for (int z = 0; z < 4; ++z) { yr[z] += wr * p[z] - wi * q[z]; yi[z] += wr * q[z] + wi * p[z]; } }
            const float ta = (float)(k1 * l2) * (1.f / 4096.f); const float tr = cospif(ta), ti = sinpif(ta);
            float orr[4], oi[4];
#pragma unroll
            for (int z = 0; z < 4; ++z) { orr[z] = yr[z] * tr - yi[z] * ti; oi[z] = yr[z] * ti + yi[z] * tr; }
            bf16* yo = WSP(bf16, WS_YFFT) + ((size_t)((b * 64 + k1) * 128 + l2) * 2) * 256 + c4;
            u32x2 w; w.x = pk2(orr[0], orr[1]); w.y = pk2(orr[2], orr[3]); *(u32x2*)yo = w;
            w.x = pk2(oi[0], oi[1]); w.y = pk2(oi[2], oi[3]); *(u32x2*)(yo + 256) = w;
        }
        __syncthreads();
        LAS float* tw2 = (LAS float*)F.lds;
        if (tid < 256) { tw2[tid] = cospif((float)tid * (1.f / 128.f)); tw2[256 + tid] = sinpif((float)tid * (1.f / 128.f)); }
        __syncthreads();
        for (int it = gt; it < NB * 256 * 64; it += NGT) {
            const int c4 = (it & 63) * 4, k = (it >> 6) & 255, b = it >> 14;
            float y[4] = {0.f, 0.f, 0.f, 0.f};
            for (int t = 0; t < 256; ++t) { const size_t ro = (size_t)(RL + b * CTXL + t) * NIN;
                const u32x2 pw = *(const u32x2*)(U + ro + UC_P + c4), qw = *(const u32x2*)(U + ro + UC_Q + c4);
                const int e = (k * t) & 255; const float wr = tw2[e], wi = tw2[256 + e];
                y[0] += wr * bflo(pw.x) - wi * bflo(qw.x); y[1] += wr * bfhi(pw.x) - wi * bfhi(qw.x); y[2] += wr * bflo(pw.y) - wi * bflo(qw.y); y[3] += wr * bfhi(pw.y) - wi * bfhi(qw.y); }
            u32x2 w; w.x = pk2(y[0] * 0.0625f, y[1] * 0.0625f); w.y = pk2(y[2] * 0.0625f, y[3] * 0.0625f);
            *(u32x2*)(WSP(bf16, WS_CONCAT) + (size_t)(RL + b * CTXL + k) * DM + 512 + c4) = w;
        }
        __syncthreads();
    }
}
__device__ __forceinline__ void p3_v1(Frame& F, int l) {
    PH_IDS();
    const int gt = bid * NTHR + tid, NGT = F.G * NTHR;
    {
        LAS float* tw = (LAS float*)F.lds;
        if (tid < 128) { tw[tid] = cospif((float)tid * (1.f / 64.f)); tw[128 + tid] = sinpif((float)tid * (1.f / 64.f)); }
        __syncthreads();
        const float nrm = 0.011048543456039806f;
        for (int it = gt; it < NB * 64 * 128 * 64; it += NGT) {
            const int c4 = (it & 63) * 4, k2 = (it >> 6) & 127, k1 = (it >> 13) & 63, b = it >> 19;
            float y[4] = {0.f, 0.f, 0.f, 0.f};
            const bf16* yb = WSP(bf16, WS_YFFT) + ((size_t)(b * 64 + k1) * 128 * 2) * 256 + c4;
            for (int l2 = 0; l2 < 128; ++l2) { const u32x2 rw = *(const u32x2*)(yb + (size_t)l2 * 512), iw = *(const u32x2*)(yb + (size_t)l2 * 512 + 256);
                const int e = (k2 * l2) & 127; const float wr = tw[e], wi = tw[128 + e];
                y[0] += wr * bflo(rw.x) - wi * bflo(iw.x); y[1] += wr * bfhi(rw.x) - wi * bfhi(iw.x); y[2] += wr * bflo(rw.y) - wi * bflo(iw.y); y[3] += wr * bfhi(rw.y) - wi * bfhi(iw.y); }
            u32x2 w; w.x = pk2(y[0] * nrm, y[1] * nrm); w.y = pk2(y[2] * nrm, y[3] * nrm);
            *(u32x2*)(WSP(bf16, WS_CONCAT) + (size_t)(b * SEQ + k1 + 64 * k2) * DM + 512 + c4) = w;
        }
        __syncthreads();
    }
    if (bid < 64 && wave == 0) {
        const int unit = bid, b = unit >> 4, hd = (unit >> 1) & 7, dir = unit & 1, g = hd >> 2;
        int vz = 0; asm volatile("v_mov_b32 %0, 0" : "=v"(vz));
        const float Aneg = -expf(inp_ptr(I_ssd_a_log)[(l * 2 + dir) * 8 + hd]), dtb = inp_ptr(I_ssd_dt_bias)[(l * 2 + dir) * 8 + hd];
        LAS float* Bs = (LAS float*)F.lds; LAS float* Cs = Bs + 16 * 128; LAS float* xs = Cs + 16 * 128; LAS float* dts = xs + 16 * 64;
        const bf16* XBC = WSP(bf16, WS_XBC); const float* DTR = WSP(float, WS_DTRAW);
        float* Y = dir == 0 ? WSP(float, WS_YF) : WSP(float, WS_YB);
        float H[128];
#pragma unroll
        for (int n = 0; n < 128; ++n) H[n] = 0.f;
        for (int part = 0; part < 2; ++part) {
            const int base = part == 0 ? RL + b * CTXL : b * SEQ, L = part == 0 ? CTXL : SEQ;
            for (int blk = 0; blk < L / 16; ++blk) {
                for (int i = 0; i < 16; ++i) { const int pos = dir == 0 ? blk * 16 + i : L - 1 - (blk * 16 + i); const size_t row = (size_t)(base + pos);
                    const unsigned bw = *(const unsigned*)(XBC + row * DM + 512 + 128 * g + 2 * lane), cw = *(const unsigned*)(XBC + row * DM + 768 + 128 * g + 2 * lane);
                    Bs[i * 128 + 2 * lane] = bflo(bw); Bs[i * 128 + 2 * lane + 1] = bfhi(bw); Cs[i * 128 + 2 * lane] = bflo(cw); Cs[i * 128 + 2 * lane + 1] = bfhi(cw);
                    xs[i * 64 + lane] = bf2f(XBC[row * DM + 64 * hd + lane]);
                    if (lane == 0) dts[i] = DTR[row * 16 + dir * 8 + hd + vz]; }
                asm volatile("s_waitcnt lgkmcnt(0)" ::: "memory");
#pragma unroll 1
                for (int i = 0; i < 16; ++i) { const int pos = dir == 0 ? blk * 16 + i : L - 1 - (blk * 16 + i); const size_t row = (size_t)(base + pos);
                    const float dt = softplus_f(dts[i] + dtb), a = expf(dt * Aneg), xd = xs[i * 64 + lane] * dt; float y = 0.f;
#pragma unroll
                    for (int n4 = 0; n4 < 32; ++n4) { const f32x4 b4 = *(const LAS f32x4*)(Bs + i * 128 + 4 * n4), c4 = *(const LAS f32x4*)(Cs + i * 128 + 4 * n4);
                        H[4 * n4 + 0] = a * H[4 * n4 + 0] + xd * b4.x; y += c4.x * H[4 * n4 + 0];
                        H[4 * n4 + 1] = a * H[4 * n4 + 1] + xd * b4.y; y += c4.y * H[4 * n4 + 1];
                        H[4 * n4 + 2] = a * H[4 * n4 + 2] + xd * b4.z; y += c4.z * H[4 * n4 + 2];
                        H[4 * n4 + 3] = a * H[4 * n4 + 3] + xd * b4.w; y += c4.w * H[4 * n4 + 3]; }
                    Y[row * 512 + 64 * hd + lane] = y; }
                asm volatile("s_waitcnt lgkmcnt(0)" ::: "memory");
            }
        }
    }
}
__device__ __forceinline__ void p4_v1(Frame& F, int l, int nrows) {
    PH_IDS();
    const int gw = bid * NWAVES + wave, NGW = F.G * NWAVES;
    for (int row = gw; row < nrows; row += NGW) {
        const int c8 = 8 * lane; const float dsk = inp_ptr(I_ssd_d)[l * 8 + (lane >> 3)];
        float xf[8], zf[8], y[8];
        unpack8(*(const v4u*)(WSP(bf16, WS_XBC) + (size_t)row * DM + c8), xf);
        unpack8(*(const v4u*)(WSP(bf16, WS_U) + (size_t)row * NIN + UC_Z + c8), zf);
        const float* yf = WSP(float, WS_YF) + (size_t)row * 512 + c8; const float* yb = WSP(float, WS_YB) + (size_t)row * 512 + c8;
        const f32x4 f0 = *(const f32x4*)yf, f1 = *(const f32x4*)(yf + 4), b0 = *(const f32x4*)yb, b1 = *(const f32x4*)(yb + 4);
        y[0] = f0.x + b0.x; y[1] = f0.y + b0.y; y[2] = f0.z + b0.z; y[3] = f0.w + b0.w; y[4] = f1.x + b1.x; y[5] = f1.y + b1.y; y[6] = f1.z + b1.z; y[7] = f1.w + b1.w;
        float ss = 0.f;
#pragma unroll
        for (int q = 0; q < 8; ++q) { y[q] = (y[q] + xf[q] * dsk) * silu_f(zf[q]); ss += y[q] * y[q]; }
#pragma unroll
        for (int o = 1; o < 32; o <<= 1) ss += __shfl_xor(ss, o);
        const float r = 1.f / sqrtf(ss * (1.f / 256.f) + LN_EPS);
        const float* nw = inp_ptr(I_ssd_norm_w) + l * 512 + c8; const f32x4 n0 = *(const f32x4*)nw, n1 = *(const f32x4*)(nw + 4);
        y[0] *= r * n0.x; y[1] *= r * n0.y; y[2] *= r * n0.z; y[3] *= r * n0.w; y[4] *= r * n1.x; y[5] *= r * n1.y; y[6] *= r * n1.z; y[7] *= r * n1.w;
        *(v4u*)(WSP(bf16, WS_CONCAT) + (size_t)row * DM + c8) = pack8(y);
    }
}
__device__ __forceinline__ void p7_conv_geglu(Frame& F, int l, int half, int nrows) {
    PH_IDS();
    const int gt = bid * NTHR + tid, NGT = F.G * NTHR;
    const bf16* A = WSP(bf16, WS_AH);
    const float* cw = inp_ptr(I_ffn_conv_w) + (size_t)l * 9 * NUP; const float* cb = inp_ptr(I_ffn_conv_b) + (size_t)l * NUP;
    for (int it = gt; it < nrows * 176; it += NGT) {
        const int row = it / 176, c8 = (it % 176) * 8; const int ti = c8 >> 7, cc = c8 & 127, j = NHALF * half + c8;
        const int acol = 256 * ti + cc;
        float va[8], ga[8];
        { const f32x4 a0 = *(const f32x4*)(cb + j), a1 = *(const f32x4*)(cb + j + 4), g0 = *(const f32x4*)(cb + DFF + j), g1 = *(const f32x4*)(cb + DFF + j + 4);
          va[0] = a0.x; va[1] = a0.y; va[2] = a0.z; va[3] = a0.w; va[4] = a1.x; va[5] = a1.y; va[6] = a1.z; va[7] = a1.w;
          ga[0] = g0.x; ga[1] = g0.y; ga[2] = g0.z; ga[3] = g0.w; ga[4] = g1.x; ga[5] = g1.y; ga[6] = g1.z; ga[7] = g1.w; }
        const bool lat = row < RL; const int pos = lat ? (row & (SEQ - 1)) : ((row - RL) & (CTXL - 1));
        const int gr = pos >> 6, gc = pos & 63;
#pragma unroll
        for (int dy = -1; dy <= 1; ++dy)
#pragma unroll
            for (int dx = -1; dx <= 1; ++dx) {
                bool ok; int nrow;
                if (lat) { ok = (gr + dy >= 0) && (gr + dy < 128) && (gc + dx >= 0) && (gc + dx < 64); nrow = row + 64 * dy + dx; }
                else { ok = (dy == 0) && (pos + dx >= 0) && (pos + dx < CTXL); nrow = row + dx; }
                if (ok) { float vf[8], gf[8]; const bf16* ap = A + (size_t)nrow * DFF + acol; unpack8(*(const v4u*)ap, vf); unpack8(*(const v4u*)(ap + 128), gf);
                    const float* w = cw + (size_t)((dy + 1) * 3 + (dx + 1)) * NUP + j;
                    const f32x4 w0 = *(const f32x4*)w, w1 = *(const f32x4*)(w + 4), u0 = *(const f32x4*)(w + DFF), u1 = *(const f32x4*)(w + DFF + 4);
                    va[0] += w0.x * vf[0]; va[1] += w0.y * vf[1]; va[2] += w0.z * vf[2]; va[3] += w0.w * vf[3]; va[4] += w1.x * vf[4]; va[5] += w1.y * vf[5]; va[6] += w1.z * vf[6]; va[7] += w1.w * vf[7];
                    ga[0] += u0.x * gf[0]; ga[1] += u0.y * gf[1]; ga[2] += u0.z * gf[2]; ga[3] += u0.w * gf[3]; ga[4] += u1.x * gf[4]; ga[5] += u1.y * gf[5]; ga[6] += u1.z * gf[6]; ga[7] += u1.w * gf[7]; } }
        float o[8];
#pragma unroll
        for (int q = 0; q < 8; ++q) o[q] = gelu_tanh_f(ga[q]) * va[q];
        *(v4u*)(WSP(bf16, WS_G) + (size_t)row * DFF + j) = pack8(o);
    }
}
#ifndef MK_PER_PHASE
#define MK_PER_PHASE 1
#endif
constexpr int N_PHASES = 2 + 12 * NLAYER;
struct Args { const float* in[25]; float* out; unsigned char* ws; int ph_lo, ph_hi, li, pad; };
__global__ void __launch_bounds__(NTHR, 2) skel_fwd(Args args) {
    extern __shared__ __attribute__((aligned(16))) unsigned char lds[];
    Frame F;
    F.lds = (LAS unsigned char*)lds; F.MISC = (volatile LAS unsigned*)(F.lds + MISC_OFF);
    F.G = gridDim.x;
    F.ws = args.ws; F.ctl = (gu32*)(F.ws + WS_CTL); F.out = args.out;
    for (int u = threadIdx.x; u < (LDS_BYTES - LDSCTL_OFF) / 4; u += NTHR) ((LAS unsigned*)(F.lds + LDSCTL_OFF))[u] = 0u;
    __syncthreads();
    XcdBarrier bar; bar.bar = (unsigned*)(F.ctl + CW_BAR); bar.x = 0; bar.st = nullptr;
    const int lo = args.ph_lo, hi = args.ph_hi;
    if (hi - lo > 1) bar = xcd_barrier_post((unsigned*)(F.ctl + CW_BAR) + args.li * XCD_BAR_WORDS, F.MISC + 8);

    for (int ph = lo; ph < hi; ++ph) {
        if (ph == 0) {
#ifndef SKIP_P0A
 p0a(F);
#endif
 }
        else if (ph == 1) {
#ifndef SKIP_P0B
 p0b(F);
#endif
 }
        else {
            const int l = (ph - 2) / 12, s = (ph - 2) % 12;
            const int nrows = (l == 0) ? RT : RL;
            if (s == 0 || s == 4 || s == 6 || s == 8 || s == 10) {
                pg8::Gemm g; bf16* O; int ldc;
                if (s == 0) { g = pg8::Gemm{WSP(bf16, WS_H), WSP(bf16, WS_WIN) + (size_t)l * NIN * DM, RT, NIN, DM}; O = WSP(bf16, WS_U); ldc = NIN; }
                else if (s == 4) { g = pg8::Gemm{WSP(bf16, WS_CONCAT), WSP(bf16, WS_WOUT) + (size_t)l * DM * DM, nrows, DM, DM}; O = WSP(bf16, WS_MIX); ldc = DM; }
                else if (s == 10) { g = pg8::Gemm{WSP(bf16, WS_G), WSP(bf16, WS_WDOWN) + (size_t)l * DM * DFF, nrows, DM, DFF}; O = WSP(bf16, WS_FFNO); ldc = DM; }
                else { const int half = (s == 8); g = pg8::Gemm{WSP(bf16, WS_H), WSP(bf16, WS_WUP) + (size_t)l * NUP * DM + (size_t)half * DFF * DM, nrows, DFF, DM}; O = WSP(bf16, WS_AH); ldc = DFF; }
                int bid = blockIdx.x; asm volatile("" : "+s"(bid)); pg8::StaticOrder S; S.init(g.M, g.N, F.G, bid);
                pg8::EpiBf16<0> E{O, ldc, nullptr, 0, 0, 1.f};
#ifndef SKIP_GEMM
                pg8::gemm_phase<pg8::EpiBf16<0>, pg8::StaticOrder, true, true>(F.lds, g, S, E);
#endif
            }
            else if (s == 1) {
#ifndef SKIP_P2
 p2_v1(F, l);
#endif
 }
            else if (s == 2) {
#ifndef SKIP_P3
 p3_v1(F, l);
#endif
 }
            else if (s == 3) {
#ifndef SKIP_P4
 p4_v1(F, l, nrows);
#endif
 }
            else if (s == 5) {
#ifndef SKIP_PN
 post_norm_pass(F, l, 0, nrows, WSP(bf16, WS_MIX));
#endif
 }
            else if (s == 7 || s == 9) {
#ifndef SKIP_P7
 p7_conv_geglu(F, l, s == 9, nrows);
#endif
 }
            else {
#ifndef SKIP_PN
 post_norm_pass(F, l, 1, nrows, WSP(bf16, WS_FFNO));
#endif
 }
        }
        if (ph + 1 < hi) xcd_barrier(bar);
    }
}

extern "C" void kernel_launch(void* const* d_in, const int* in_sizes, int n_in, void* d_out, int out_size, void* d_ws, size_t ws_size, hipStream_t stream) {
    static int grid = 0;
    if (grid == 0) {
        if (n_in != 25 || in_sizes[0] != RL * DM || out_size != RL * DM || ws_size < WS_END) { fprintf(stderr, "kernel_launch: unexpected shapes: n_in %d in0 %d out %d ws %zu (need %zu)\n", n_in, n_in > 0 ? in_sizes[0] : -1, out_size, ws_size, (size_t)WS_END); grid = -1; return; }
        int dev = 0, cus = 0, per_cu = 0;
        if (hipGetDevice(&dev) != hipSuccess || hipDeviceGetAttribute(&cus, hipDeviceAttributeMultiprocessorCount, dev) != hipSuccess) { grid = -1; return; }
        if (hipFuncSetAttribute((const void*)skel_fwd, hipFuncAttributeMaxDynamicSharedMemorySize, LDS_BYTES) != hipSuccess) { fprintf(stderr, "kernel_launch: hipFuncSetAttribute failed\n"); grid = -1; return; }
        if (hipOccupancyMaxActiveBlocksPerMultiprocessor(&per_cu, (const void*)skel_fwd, NTHR, LDS_BYTES) != hipSuccess || per_cu < 1) fprintf(stderr, "kernel_launch: occupancy query reports %d blocks per CU\n", per_cu);
        (void)hipGetLastError();
        grid = cus;
    }
    if (grid < 0) return;
    (void)hipMemsetAsync((char*)d_ws + WS_CTL, 0, CTL_ZERO_BYTES, stream);
    Args a{};
    for (int i = 0; i < 25; ++i) a.in[i] = (const float*)d_in[i];
    a.out = (float*)d_out; a.ws = (unsigned char*)d_ws;
#if MK_PER_PHASE
    for (int ph = 0; ph < N_PHASES; ++ph) { a.ph_lo = ph; a.ph_hi = ph + 1; a.li = 0; hipLaunchKernelGGL(skel_fwd, dim3(grid), dim3(NTHR), LDS_BYTES, stream, a); }
#else
    a.ph_lo = 0; a.ph_hi = N_PHASES; a.li = 0;
    hipLaunchKernelGGL(skel_fwd, dim3(grid), dim3(NTHR), LDS_BYTES, stream, a);
#endif
}
```

```cpp
#include <hip/hip_runtime.h>
#include <cstdio>
#include <cstdint>
namespace pg8 {
#define PG8_LAS __attribute__((address_space(3)))
typedef unsigned short bf16_t;
typedef short bf16x8 __attribute__((ext_vector_type(8)));
typedef float f32x4 __attribute__((ext_vector_type(4)));
typedef unsigned u32x4 __attribute__((ext_vector_type(4)));
constexpr int BM = 256, BK = 64, HALF = 128, HTB = HALF * BK * 2  , STAGE_BYTES = 8 * HTB, NXCD = 8, WGM = 8;

__host__ __device__ __forceinline__ int lds_byte(int r, int c) { const int st = (r >> 4) * 2 + (c >> 5), rr = r & 15, cc = c & 31, ob = rr * 64 + cc * 2; return st * 1024 + (ob ^ (((ob >> 9) & 1) << 5)); }
__host__ __device__ __forceinline__ void stage_rc(int b, int& R, int& C) { const int st = b / 1024, sb = b % 1024, swz = sb ^ (((sb >> 9) & 1) << 5); R = (st >> 1) * 16 + swz / 64; C = (st & 1) * 32 + (swz % 64) / 2; }
__host__ __device__ __forceinline__ int perm32(int rho) { const int n = rho >> 4, i = rho & 15; return 8 * (i >> 2) + 4 * n + (i & 3); }

struct Unit { int pm, pn, kofs; };
struct Gemm { const bf16_t* A; const bf16_t* Bt; int M, N, K; int ld = 0; int lda = 0; size_t kstepA = 0; };

struct StaticOrder {
    int nM, nN, nwg, G, c;
    __host__ __device__ void init(int M, int N, int G_, int c_) { nM = M / BM; nN = N / BM; nwg = nM * nN; G = G_; c = c_; }
    __host__ __device__ bool next(int i, Unit& u) const {
        const long L = (long)i * G + c; if (L >= nwg) return false;
        int wgid = (int)L; { const int q = nwg / NXCD, r = nwg % NXCD, xcd = wgid % NXCD, off = wgid / NXCD; wgid = (xcd < r ? xcd * (q + 1) : r * (q + 1) + (xcd - r) * q) + off; }
        const int nig = WGM * nN, gid = wgid / nig, fm = gid * WGM, gsz = (nM - fm) < WGM ? (nM - fm) : WGM;
        u.pm = fm + ((wgid % nig) % gsz); u.pn = (wgid % nig) / gsz; u.kofs = 0; return true;
    }
    __device__ __forceinline__ void a_ready(const Unit&) const {}
    __device__ __forceinline__ void done(const Unit&) const {}
};

__device__ __forceinline__ unsigned cvt_pk_bf16(float lo, float hi) { unsigned r; asm volatile("v_cvt_pk_bf16_f32 %0, %1, %2" : "=v"(r) : "v"(lo), "v"(hi)); return r; }
__device__ __forceinline__ unsigned cvt_pk_f16(float lo, float hi) { unsigned r; asm volatile("v_cvt_pk_f16_f32 %0, %1, %2" : "=v"(r) : "v"(lo), "v"(hi)); return r; }
typedef float f32x2 __attribute__((ext_vector_type(2)));
__device__ __forceinline__ f32x2 gelu_pk(f32x2 v) {
    const f32x2 av = __builtin_elementwise_abs(v), d = av * 0.2316418882f + 1.0f;
    f32x2 t; t.x = __builtin_amdgcn_rcpf(d.x); t.y = __builtin_amdgcn_rcpf(d.y);
    f32x2 q = t * 0.5307027145f + (-0.7265760135f); q = q * t + 0.7107068705f; q = q * t + (-0.142248368f); q = q * t + 0.127414796f; q = q * t;
    const f32x2 s = (v * v) * (-0.72134752044f);
    f32x2 e; e.x = __builtin_amdgcn_exp2f(s.x); e.y = __builtin_amdgcn_exp2f(s.y);
    const f32x2 m = v * (q * e), r = v - m;
    f32x2 o; o.x = v.x < 0.f ? m.x : r.x; o.y = v.y < 0.f ? m.y : r.y; return o;
}

template <int ACT  > struct EpiBf16 {
    static constexpr bool PERM = true, AFTER_DRAIN = false; static_assert(ACT == 0 || ACT == 1, "EpiBf16: ACT is 0 (none) or 1 (gelu_pk)");
    bf16_t* O; int ldc; const float* bias; int split_cols; size_t split_stride; float scale0;
    size_t cstride = 0; bool f16out = false;
    __device__ __forceinline__ void operator()(const f32x4 (&acc)[2][2][4][2], const Unit& u, int wr, int wc, int fr, int fq) const {
        const int row0 = u.pm * BM + wr * 64 + fr; int colt = u.pn * BM; bf16_t* base = O;
        float sc = 1.f; if (split_cols) { const int t = colt / split_cols; base += (size_t)t * split_stride; colt -= t * split_cols; if (t == 0) sc = scale0; }
        const size_t cs = cstride ? cstride : (size_t)HALF; const size_t col0 = (size_t)(colt >> 7) * cs + wc * 32 + 8 * fq; const int bcol0 = u.pn * BM + wc * 32 + 8 * fq;
        f32x4 bv[2][2];
#pragma unroll
        for (int bj = 0; bj < 2; ++bj)
#pragma unroll
            for (int n = 0; n < 2; ++n) bv[bj][n] = bias ? *(const f32x4*)(bias + bcol0 + bj * HALF + 4 * n) : (f32x4){0.f, 0.f, 0.f, 0.f};
#pragma unroll
        for (int ai = 0; ai < 2; ++ai)
#pragma unroll
            for (int m = 0; m < 4; ++m) { bf16_t* rowp = base + (size_t)(row0 + ai * HALF + m * 16) * ldc + col0;
#pragma unroll
                for (int bj = 0; bj < 2; ++bj) { f32x4 v0 = acc[ai][bj][m][0] + bv[bj][0], v1 = acc[ai][bj][m][1] + bv[bj][1];
                    if (ACT == 1) { f32x2 a = gelu_pk((f32x2){v0[0], v0[1]}), b = gelu_pk((f32x2){v0[2], v0[3]}), c = gelu_pk((f32x2){v1[0], v1[1]}), d = gelu_pk((f32x2){v1[2], v1[3]});
                        v0 = (f32x4){a.x, a.y, b.x, b.y}; v1 = (f32x4){c.x, c.y, d.x, d.y}; }
                    v0 = v0 * sc; v1 = v1 * sc; u32x4 w; if (f16out) { w.x = cvt_pk_f16(v0[0], v0[1]); w.y = cvt_pk_f16(v0[2], v0[3]); w.z = cvt_pk_f16(v1[0], v1[1]); w.w = cvt_pk_f16(v1[2], v1[3]); } else { w.x = cvt_pk_bf16(v0[0], v0[1]); w.y = cvt_pk_bf16(v0[2], v0[3]); w.z = cvt_pk_bf16(v1[0], v1[1]); w.w = cvt_pk_bf16(v1[2], v1[3]); }
                    *(u32x4*)(rowp + bj * cs) = w; } }
    }
};

struct SliceOrder {
    int nM, nN, nS, kslice, G, c;
    __device__ __forceinline__ bool next(int i, Unit& u) const { const long L = (long)i * G + c; if (L >= (long)nM * nN * nS) return false; int w = (int)L; u.kofs = (w % nS) * kslice; w /= nS; u.pn = w % nN; u.pm = w / nN; return true; }
    __device__ __forceinline__ void a_ready(const Unit&) const {}
    __device__ __forceinline__ void done(const Unit&) const {}
};
struct EpiF32Slab {
    static constexpr bool PERM = false, AFTER_DRAIN = false;
    float* O; int ldc; int kslice; size_t slab;
    __device__ __forceinline__ void operator()(const f32x4 (&acc)[2][2][4][2], const Unit& u, int wr, int wc, int fr, int fq) const {
        int fr_ = fr, fq_ = fq; asm volatile("" : "+v"(fr_), "+v"(fq_));
        float* base = O + (size_t)(u.kofs / kslice) * slab; const int col0 = u.pn * BM + wc * 32 + 4 * fq_;
#pragma unroll
        for (int ai = 0; ai < 2; ++ai)
#pragma unroll
            for (int m = 0; m < 4; ++m) { float* rowp = base + (size_t)(u.pm * BM + ai * HALF + wr * 64 + m * 16 + fr_) * ldc + col0;
#pragma unroll
                for (int bj = 0; bj < 2; ++bj)
#pragma unroll
                    for (int n = 0; n < 2; ++n) *(f32x4*)(rowp + bj * HALF + n * 16) = acc[ai][bj][m][n]; }
    }
};
template <class Epi, class Sched, bool ALIGN_EPI = false, bool SP2 = false>
__device__ __forceinline__ void gemm_phase(PG8_LAS unsigned char* lds, const Gemm g, const Sched& S, const Epi& E) {
    int tid_ = threadIdx.x; asm volatile("" : "+v"(tid_)); const int tid = tid_, wid = __builtin_amdgcn_readfirstlane(tid >> 6), lane = tid & 63, wr = wid >> 2, wc = wid & 3, fr = lane & 15, fq = lane >> 4;
    const int K = g.K, nt = K / BK, LD = g.ld ? g.ld : g.K, LDA = g.lda ? g.lda : LD;
    unsigned voffA[2], voffB[2];
#pragma unroll
    for (int i = 0; i < 2; ++i) { int R, C; stage_rc(tid * 16 + i * 8192, R, C); const int Rb = Epi::PERM ? ((R & ~31) + perm32(R & 31)) : R;
        voffA[i] = (unsigned)(R * LDA + C) * 2u; voffB[i] = (unsigned)(Rb * LD + C) * 2u; }
    const size_t kstep = (size_t)(BK * 2);
    const size_t hstep = (size_t)HALF * LD * 2;
    const size_t tstep = 2 * hstep;
    const size_t kstepA = g.kstepA ? g.kstepA : kstep, hstepA = (size_t)HALF * LDA * 2, tstepA = 2 * hstepA;
    const unsigned ldsw = (unsigned)wid * 1024u;
    const int aoff = lds_byte(wr * 64 + fr, fq * 8), boff = lds_byte(wc * 32 + fr, fq * 8);
#define PG8_SA(b, h) (((b) * 2 + (h)) * HTB)
#define PG8_SB(b, h) ((4 + (b) * 2 + (h)) * HTB)
#define PG8_STAGE(bufoff, gbase, voff) do { _Pragma("unroll") for (int _i = 0; _i < 2; ++_i) \
        __builtin_amdgcn_global_load_lds((const unsigned*)((const char*)(gbase) + (voff)[_i]), (PG8_LAS unsigned*)(lds + (bufoff) + ldsw + _i * 8192), 16, 0, 0); } while (0)
#define PG8_LDA(dst, b, h) do { _Pragma("unroll") for (int m = 0; m < 4; ++m) _Pragma("unroll") for (int k = 0; k < 2; ++k) dst[m][k] = *(const PG8_LAS bf16x8*)(lds + PG8_SA(b, h) + aoff + m * 2048 + k * 1024); } while (0)
#define PG8_LDB(dst, b, h) do { _Pragma("unroll") for (int n = 0; n < 2; ++n) _Pragma("unroll") for (int k = 0; k < 2; ++k) dst[n][k] = *(const PG8_LAS bf16x8*)(lds + PG8_SB(b, h) + boff + n * 2048 + k * 1024); } while (0)
#define PG8_MMA(ai, bj, At, Bt) do { __builtin_amdgcn_s_setprio(1); _Pragma("unroll") for (int m = 0; m < 4; ++m) _Pragma("unroll") for (int n = 0; n < 2; ++n) _Pragma("unroll") for (int k = 0; k < 2; ++k) \
        acc[ai][bj][m][n] = __builtin_amdgcn_mfma_f32_16x16x32_bf16(Bt[n][k], At[m][k], acc[ai][bj][m][n], 0, 0, 0); __builtin_amdgcn_s_setprio(0); } while (0)
#define PG8_WAIT_V(n) asm volatile("s_waitcnt vmcnt(" #n ")" ::: "memory")
#define PG8_WAIT_L(n) asm volatile("s_waitcnt lgkmcnt(" #n ")" ::: "memory")
#define PG8_BAR __builtin_amdgcn_s_barrier()
#define PG8_SCHED __builtin_amdgcn_sched_barrier(0)
    Unit cur, nxt; int ui = 0;
    if (!S.next(0, cur)) return;
    f32x4 acc[2][2][4][2];
#pragma unroll
    for (int a = 0; a < 2; ++a)
#pragma unroll
        for (int b = 0; b < 2; ++b)
#pragma unroll
            for (int m = 0; m < 4; ++m)
#pragma unroll
                for (int n = 0; n < 2; ++n) acc[a][b][m][n] = (f32x4){0.f, 0.f, 0.f, 0.f};
    bf16x8 At[4][2], B0[2][2], B1[2][2];
    const char* cA = (const char*)g.A + (size_t)cur.pm * tstepA + (g.kstepA ? (size_t)(cur.kofs >> 6) * kstepA : (size_t)cur.kofs * 2); const char* cB = (const char*)g.Bt + (size_t)cur.pn * tstep + (size_t)cur.kofs * 2;
    S.a_ready(cur);
    if constexpr (SP2) {
        PG8_STAGE(PG8_SB(0, 0), cB, voffB); PG8_STAGE(PG8_SB(0, 1), cB + hstep, voffB); PG8_STAGE(PG8_SA(0, 0), cA, voffA); PG8_STAGE(PG8_SA(0, 1), cA + hstepA, voffA);
        if (wr == 1) PG8_BAR;
        PG8_WAIT_V(2); PG8_BAR;
        PG8_STAGE(PG8_SB(1, 0), cB + kstep, voffB); PG8_STAGE(PG8_SA(1, 0), cA + kstepA, voffA); PG8_STAGE(PG8_SB(1, 1), cB + hstep + kstep, voffB);
        PG8_WAIT_V(6); PG8_BAR;
    } else {
        PG8_STAGE(PG8_SB(0, 0), cB, voffB); PG8_STAGE(PG8_SA(0, 0), cA, voffA); PG8_STAGE(PG8_SB(0, 1), cB + hstep, voffB); PG8_STAGE(PG8_SA(0, 1), cA + hstepA, voffA);
        if (wr == 1) PG8_BAR;
        PG8_WAIT_V(4); PG8_BAR;
        PG8_STAGE(PG8_SB(1, 0), cB + kstep, voffB); PG8_STAGE(PG8_SA(1, 0), cA + kstepA, voffA); PG8_STAGE(PG8_SB(1, 1), cB + hstep + kstep, voffB);
        PG8_WAIT_V(6); PG8_BAR;
    }
    for (;;) {
        const bool has_next = S.next(ui + 1, nxt);
        const char* nA = has_next ? (const char*)g.A + (size_t)nxt.pm * tstepA + (g.kstepA ? (size_t)(nxt.kofs >> 6) * kstepA : (size_t)nxt.kofs * 2) : cA; const char* nB = has_next ? (const char*)g.Bt + (size_t)nxt.pn * tstep + (size_t)nxt.kofs * 2 : cB;
        for (int t = 0; t < nt; t += 2) {
            const bool last = (t == nt - 2);
            const char* a1 = cA + (size_t)(t + 1) * kstepA;
            const char* a2 = last ? nA : cA + (size_t)(t + 2) * kstepA; const char* b2 = last ? nB : cB + (size_t)(t + 2) * kstep;
            const char* a3 = a2 + kstepA; const char* b3 = b2 + kstep;
            if (last && has_next) S.a_ready(nxt);
            if constexpr (SP2) {
            PG8_LDB(B0, 0, 0); PG8_LDB(B1, 0, 1); PG8_SCHED; PG8_LDA(At, 0, 0); PG8_STAGE(PG8_SA(1, 1), a1 + hstepA, voffA);
            PG8_WAIT_V(8); PG8_WAIT_L(0); PG8_BAR; PG8_MMA(0, 0, At, B0); PG8_MMA(0, 1, At, B1); PG8_BAR; PG8_SCHED;
            PG8_LDA(At, 0, 1); PG8_STAGE(PG8_SB(0, 0), b2, voffB); PG8_STAGE(PG8_SB(0, 1), b2 + hstep, voffB); PG8_STAGE(PG8_SA(0, 0), a2, voffA);
            PG8_WAIT_V(8); PG8_WAIT_L(0); PG8_BAR; PG8_MMA(1, 0, At, B0); PG8_MMA(1, 1, At, B1); PG8_BAR; PG8_SCHED;
            PG8_LDB(B0, 1, 0); PG8_LDB(B1, 1, 1); PG8_SCHED; PG8_LDA(At, 1, 0); PG8_STAGE(PG8_SA(0, 1), a2 + hstepA, voffA);
            PG8_WAIT_V(8); PG8_WAIT_L(0); PG8_BAR; PG8_MMA(0, 0, At, B0); PG8_MMA(0, 1, At, B1); PG8_BAR; PG8_SCHED;
            PG8_LDA(At, 1, 1); PG8_STAGE(PG8_SB(1, 0), b3, voffB); PG8_STAGE(PG8_SB(1, 1), b3 + hstep, voffB); PG8_STAGE(PG8_SA(1, 0), a3, voffA);
            PG8_WAIT_V(8); PG8_WAIT_L(0); PG8_BAR; PG8_MMA(1, 0, At, B0); PG8_MMA(1, 1, At, B1); PG8_BAR; PG8_SCHED;
            } else {
            PG8_LDB(B0, 0, 0); PG8_SCHED; PG8_LDA(At, 0, 0); PG8_STAGE(PG8_SA(1, 1), a1 + hstepA, voffA);
            PG8_WAIT_L(8); PG8_BAR; PG8_WAIT_L(0); PG8_MMA(0, 0, At, B0); PG8_BAR; PG8_SCHED;
            PG8_LDB(B1, 0, 1); PG8_STAGE(PG8_SB(0, 0), b2, voffB);
            PG8_BAR; PG8_WAIT_L(0); PG8_MMA(0, 1, At, B1); PG8_BAR;
            PG8_LDA(At, 0, 1); PG8_STAGE(PG8_SA(0, 0), a2, voffA);
            PG8_BAR; PG8_WAIT_L(0); PG8_MMA(1, 0, At, B0); PG8_BAR; PG8_SCHED;
            PG8_STAGE(PG8_SB(0, 1), b2 + hstep, voffB);
            PG8_WAIT_V(6); PG8_BAR; PG8_MMA(1, 1, At, B1); PG8_BAR;
            PG8_LDB(B0, 1, 0); PG8_SCHED; PG8_LDA(At, 1, 0); PG8_STAGE(PG8_SA(0, 1), a2 + hstepA, voffA);
            PG8_WAIT_L(8); PG8_BAR; PG8_WAIT_L(0); PG8_MMA(0, 0, At, B0); PG8_BAR; PG8_SCHED;
            PG8_LDB(B1, 1, 1); PG8_STAGE(PG8_SB(1, 0), b3, voffB);
            PG8_BAR; PG8_WAIT_L(0); PG8_MMA(0, 1, At, B1); PG8_BAR;
            PG8_LDA(At, 1, 1); PG8_STAGE(PG8_SA(1, 0), a3, voffA);
            PG8_BAR; PG8_WAIT_L(0); PG8_MMA(1, 0, At, B0); PG8_BAR; PG8_SCHED;
            PG8_STAGE(PG8_SB(1, 1), b3 + hstep, voffB);
            PG8_WAIT_V(6); PG8_BAR; PG8_MMA(1, 1, At, B1); PG8_BAR;
            }
        }
        if constexpr (ALIGN_EPI) { if (wr == 0) PG8_BAR; }
        if constexpr (!Epi::AFTER_DRAIN) { E(acc, cur, wr, wc, fr, fq); S.done(cur); }
        if (!has_next) break;
#pragma unroll
        for (int a = 0; a < 2; ++a)
#pragma unroll
            for (int b = 0; b < 2; ++b)
#pragma unroll
                for (int m = 0; m < 4; ++m)
#pragma unroll
                    for (int n = 0; n < 2; ++n) acc[a][b][m][n] = (f32x4){0.f, 0.f, 0.f, 0.f};
        cur = nxt; cA = nA; cB = nB; ++ui;
        if constexpr (ALIGN_EPI) { if (wr == 1) PG8_BAR; }
    }
    PG8_WAIT_V(0);
    if constexpr (!ALIGN_EPI) { if (wr == 0) PG8_BAR; }
    PG8_BAR;
    if constexpr (Epi::AFTER_DRAIN) { E.fused(acc, cur, wr, wc, fr, fq, lds, wid, lane); S.done(cur); }
#undef PG8_SA
#undef PG8_SB
#undef PG8_STAGE
#undef PG8_LDA
#undef PG8_LDB
#undef PG8_MMA
#undef PG8_WAIT_V
#undef PG8_WAIT_L
#undef PG8_BAR
#undef PG8_SCHED
}
}
constexpr int NWAVES = 8, NTHR = 512;
constexpr int DM = 1024, NB = 4, SEQ = 8192, CTXL = 256;
constexpr int RL = NB * SEQ, RC = NB * CTXL, RT = RL + RC;
constexpr int NIN_SRC = 2064, NIN = 2304;
constexpr int UC_Z = 0, UC_XBC = 512, UC_P = 1536, UC_Q = 1792, UC_POOL = 2048;
constexpr int SRC_DT = 1536, SRC_FNET = 1552, SRC_POOL = 1808;
constexpr int DFF = 2816, NUP = 5632, NHALF = 1408;
constexpr float LN_EPS = 1e-6f, ALPHA = 1.41421356237f;
constexpr int NLAYER = 2;

constexpr size_t MiB = 1u << 20;
constexpr size_t WS_CTL = 0, CTL_ZERO_BYTES = 1 * MiB;
constexpr size_t WS_ADA = 1 * MiB;
constexpr size_t WS_F = 2 * MiB;
constexpr size_t WS_WA = 2 * MiB + 512 * 1024, WS_WB = WS_WA + 32768, WS_TW = WS_WB + 65536;
constexpr size_t WS_WDT = WS_TW + 65536;
constexpr size_t WS_DTRAW = 3 * MiB;
constexpr size_t WS_WIN = 6 * MiB;
constexpr size_t WS_WOUT = 15 * MiB;
constexpr size_t WS_WUP = 19 * MiB;
constexpr size_t WS_WDOWN = 41 * MiB;
constexpr size_t WS_XCTX = 52 * MiB;
constexpr size_t WS_H = 56 * MiB;
constexpr size_t WS_SH = 122 * MiB;
constexpr size_t WS_U = WS_SH;
constexpr size_t WS_CONCAT = WS_SH + 149 * MiB;
constexpr size_t WS_SST = WS_SH + 215 * MiB;
constexpr size_t WS_HIN = WS_SH + 281 * MiB;
constexpr size_t WS_YFFT = WS_SH + 347 * MiB;
constexpr size_t WS_DEC = 5 * MiB + 512 * 1024;
constexpr size_t WS_MIX = WS_SH;
constexpr size_t WS_AH = WS_SH;
constexpr size_t WS_G = WS_SH + 193 * MiB;
constexpr size_t WS_SLAB = WS_SH + 68 * MiB;
constexpr size_t WS_FFNO = WS_SH;
constexpr size_t WS_END = 512 * MiB;
static_assert(WS_YFFT + 32 * MiB <= WS_END && WS_G + 182 * MiB <= WS_END, "ws map");
constexpr int CW_TMO = 0, CW_CODE = 1, CW_BAR = 4096;

constexpr int RING_BYTES = 131072, LDSCTL_OFF = 152576, MISC_OFF = LDSCTL_OFF + 320, LDS_BYTES = 156672;
#define GAS __attribute__((address_space(1)))
#define LAS __attribute__((address_space(3)))
typedef unsigned short bf16;
typedef unsigned v4u __attribute__((ext_vector_type(4)));
typedef float f32x4 __attribute__((ext_vector_type(4)));
typedef short bf16x8 __attribute__((ext_vector_type(8)));
typedef GAS unsigned gu32;
typedef GAS unsigned long long gu64;
#define RLX_AGENT __ATOMIC_RELAXED, __HIP_MEMORY_SCOPE_AGENT
#define LDS_WAIT() asm volatile("s_waitcnt lgkmcnt(0)" ::: "memory")
#define VM_WAIT() asm volatile("s_waitcnt vmcnt(0)" ::: "memory")
__device__ __forceinline__ unsigned long long rt() { return __builtin_amdgcn_s_memrealtime(); }
typedef __bf16 hwbf2 __attribute__((ext_vector_type(2)));
typedef float hwf2 __attribute__((ext_vector_type(2)));
__device__ __forceinline__ unsigned pk2(float lo, float hi) { const hwf2 v = {lo, hi}; return __builtin_bit_cast(unsigned, __builtin_convertvector(v, hwbf2)); }
__device__ __forceinline__ unsigned f2bf(float f) { return pk2(f, 0.f) & 0xffffu; }

#define XB_TMO      128
#define XB_XCNT(j)  (256  + 64 * (j))
#define XB_XSUB(j)  (1280 + 64 * (j))
#define XB_XGEN(j)  (2304 + 64 * (j))
#define XB_TOP      3328
#define XB_TOPGEN   3392
#define XCD_BAR_WORDS 3456
#define XB_SPIN_CAP (1u << 18)

__device__ __forceinline__ unsigned xb_ld(unsigned* p)              { return __hip_atomic_load(p, __ATOMIC_RELAXED, __HIP_MEMORY_SCOPE_AGENT); }
__device__ __forceinline__ unsigned xb_add(unsigned* p, unsigned v) { return __hip_atomic_fetch_add(p, v, __ATOMIC_RELAXED, __HIP_MEMORY_SCOPE_AGENT); }
__device__ __forceinline__ unsigned xb_xcc_id() { return (unsigned)__builtin_amdgcn_s_getreg((3 << 11) | 20) & 0xFu; }
#define XB_SPIN(cond, bar) do { unsigned _sp = 0; while (cond) { __builtin_amdgcn_s_sleep(1); \
    if ((++_sp & 255u) == 0u) { if (xb_ld(&(bar)[XB_TMO])) break; if (_sp > XB_SPIN_CAP) { atomicAdd(&(bar)[XB_TMO], 1u); break; } } } } while (0)

struct XcdBarrier {
    unsigned* bar; unsigned x;
    volatile LAS unsigned* st;
};

__device__ __forceinline__ XcdBarrier xcd_barrier_post(unsigned* bar, volatile LAS unsigned* st) {
    XcdBarrier b; b.bar = bar; b.x = xb_xcc_id(); b.st = st;
    if (threadIdx.x == 0) (void)xb_add(&bar[XB_XCNT(b.x)], 1u);
    return b;
}
__device__ __forceinline__ void xcd_barrier_complete(unsigned* bar, unsigned x, unsigned& nloc, unsigned& nx) {
    const unsigned G = gridDim.x * gridDim.y * gridDim.z;
    unsigned sum, cnt, mine, sp = 0u;
    for (;;) {
        sum = 0u; cnt = 0u; mine = 0u;
#pragma unroll
        for (unsigned j = 0; j < 16; ++j) { const unsigned c = xb_ld(&bar[XB_XCNT(j)]); sum += c; cnt += (c > 0u) ? 1u : 0u; mine = (j == x) ? c : mine; }
        if (sum == G) break;
        __builtin_amdgcn_s_sleep(1);
        if ((++sp & 255u) == 0u) { if (xb_ld(&bar[XB_TMO])) break; if (sp > XB_SPIN_CAP) { atomicAdd(&bar[XB_TMO], 1u); break; } }
    }
    nloc = mine > 0u ? mine : 1u; nx = cnt > 0u ? cnt : 1u;
}

__device__ __forceinline__ void xcd_barrier(const XcdBarrier& b) {
    asm volatile("s_waitcnt vmcnt(0)" ::: "memory");
    __syncthreads();
    if (threadIdx.x == 0) {
        unsigned* bar = b.bar;
        __builtin_amdgcn_s_waitcnt(0);
        unsigned nloc = b.st[0], nx = b.st[1];
        if (nloc == 0u) { xcd_barrier_complete(bar, b.x, nloc, nx); b.st[0] = nloc; b.st[1] = nx; }
        const unsigned old = xb_add(&bar[XB_XSUB(b.x)], 1u);
        const unsigned gen = old / nloc;
        if (old + 1u == (gen + 1u) * nloc) {
            __builtin_amdgcn_fence(__ATOMIC_RELEASE, "agent");
            asm volatile("s_waitcnt vmcnt(0)" ::: "memory");
            const unsigned og = xb_add(&bar[XB_TOP], 1u);
            const unsigned tg = og / nx;
            if (og + 1u == (tg + 1u) * nx) {
#pragma unroll
                for (unsigned j = 0; j < 16; ++j) xb_add(&bar[XB_XGEN(j)], 1u);
            }
            XB_SPIN(xb_ld(&bar[XB_XGEN(b.x)]) == gen, bar);
            __builtin_amdgcn_fence(__ATOMIC_ACQUIRE, "agent");
            asm volatile("s_waitcnt vmcnt(0)" ::: "memory");
        } else {
            XB_SPIN(xb_ld(&bar[XB_XGEN(b.x)]) == gen, bar);
            __builtin_amdgcn_fence(__ATOMIC_ACQUIRE, "agent");
            asm volatile("s_waitcnt vmcnt(0)" ::: "memory");
        }
    }
    __syncthreads();
}
typedef unsigned u32x2 __attribute__((ext_vector_type(2)));
__device__ __forceinline__ float bf2f(unsigned short b) { return __uint_as_float((unsigned)b << 16); }
__device__ __forceinline__ float bflo(unsigned w) { return __uint_as_float(w << 16); }
__device__ __forceinline__ float bfhi(unsigned w) { return __uint_as_float(w & 0xffff0000u); }
__device__ __forceinline__ float silu_f(float x) { return x * __builtin_amdgcn_rcpf(1.f + __expf(-x)); }
__device__ __forceinline__ float gelu_tanh_f(float x) { const float t = x * x, u = __builtin_fmaf(t, -0.10294324f, -2.30220819f); return x * __builtin_amdgcn_rcpf(1.f + __builtin_amdgcn_exp2f(x * u)); }
__device__ __forceinline__ float softplus_f(float x) { return x > 20.f ? x : log1pf(expf(x)); }
#define DPP_ADD(v, ctrl) ((v) + __builtin_bit_cast(float, __builtin_amdgcn_update_dpp(0, __builtin_bit_cast(int, (v)), (ctrl), 0xf, 0xf, false)))
__device__ __forceinline__ float rdl(float v, const int l) { return __builtin_bit_cast(float, __builtin_amdgcn_readlane(__builtin_bit_cast(int, v), l)); }
__device__ __forceinline__ float wave_sum(float v) {
    v = DPP_ADD(v, 0xB1); v = DPP_ADD(v, 0x4E); v = DPP_ADD(v, 0x141); v = DPP_ADD(v, 0x140);
    return (rdl(v, 0) + rdl(v, 16)) + (rdl(v, 32) + rdl(v, 48));
}
__device__ __forceinline__ void unpack8(const v4u w, float (&f)[8]) { f[0] = bflo(w.x); f[1] = bfhi(w.x); f[2] = bflo(w.y); f[3] = bfhi(w.y); f[4] = bflo(w.z); f[5] = bfhi(w.z); f[6] = bflo(w.w); f[7] = bfhi(w.w); }
__device__ __forceinline__ v4u pack8(const float (&f)[8]) { v4u w; w.x = pk2(f[0], f[1]); w.y = pk2(f[2], f[3]); w.z = pk2(f[4], f[5]); w.w = pk2(f[6], f[7]); return w; }

struct Frame {
    LAS unsigned char* lds; volatile LAS unsigned* MISC; gu32* ctl;
    int G;
    float* out;
    unsigned char* ws;
};
#define WSP(T, off) ((T*)(F.ws + (off)))
#define PH_IDS() int tid = threadIdx.x; asm volatile("" : "+v"(tid)); const int lane = tid & 63; const int wave = __builtin_amdgcn_readfirstlane(tid >> 6); int bid = blockIdx.x; asm volatile("" : "+s"(bid)); (void)lane; (void)wave; (void)bid;
__device__ __forceinline__ const float* inp_ptr(int i) { asm volatile("" : "+s"(i)); return ((const float* const __attribute__((address_space(4)))*)__builtin_amdgcn_kernarg_segment_ptr())[i]; }
enum { I_x = 0, I_c, I_ctx, I_c_ctx, I_w_ada, I_b_ada, I_w_in, I_ssd_conv_w, I_ssd_conv_b, I_ssd_dt_bias, I_ssd_a_log, I_ssd_d, I_ssd_norm_w, I_fnet_w, I_pool_w, I_pool_scale, I_w_out, I_ln1_g, I_ln1_b, I_ffn_w_up, I_ffn_conv_w, I_ffn_conv_b, I_ffn_w_down, I_ln2_g, I_ln2_b };

struct RowInfo { int pos, L, v, base; };
__device__ __forceinline__ RowInfo row_info(int row) {
    RowInfo r;
    if (row < RL) { r.pos = row & (SEQ - 1); r.L = SEQ; r.v = row >> 13; r.base = row & ~(SEQ - 1); }
    else { const int rr = row - RL; r.pos = rr & (CTXL - 1); r.L = CTXL; r.v = 4; r.base = RL + (rr & ~(CTXL - 1)); }
    return r;
}
__device__ __forceinline__ float* stream_row(Frame& F, int row) { return row < RL ? F.out + (size_t)row * DM : WSP(float, WS_XCTX) + (size_t)(row - RL) * DM; }
__device__ __forceinline__ const float* input_row(Frame& F, int row) { return row < RL ? inp_ptr(I_x) + (size_t)row * DM : inp_ptr(I_ctx) + (size_t)(row - RL) * DM; }

__device__ __forceinline__ void fft_tables(Frame& F, const int tid, const int bid);
struct TrItem { const float* W; int ldw; bf16* WT; int ldt; };
__device__ __forceinline__ TrItem tr_decode(Frame& F, int it) {
    constexpr int I_IN = 48 * 16, I_OUT = 32 * 16, I_UP = 176 * 16, I_DN = 32 * 44, I_L = I_IN + I_OUT + I_UP + I_DN;
    const int l = it / I_L; int r = it % I_L;
    if (r < I_IN) { const int kb = r / 48, nb = r % 48;
        return TrItem{inp_ptr(I_w_in) + (size_t)l * DM * NIN_SRC + (size_t)(64 * kb) * NIN_SRC + 32 * nb, NIN_SRC, WSP(bf16, WS_WIN) + (size_t)l * NIN * DM + (size_t)(32 * nb) * DM + 64 * kb, DM}; }
    r -= I_IN;
    if (r < I_OUT) { const int kb = r / 32, nb = r % 32;
        return TrItem{inp_ptr(I_w_out) + (size_t)l * DM * DM + (size_t)(64 * kb) * DM + 32 * nb, DM, WSP(bf16, WS_WOUT) + (size_t)l * DM * DM + (size_t)(32 * nb) * DM + 64 * kb, DM}; }
    r -= I_OUT;
    if (r < I_UP) { const int kb = r / 176, nb = r % 176, ti = nb >> 3, w8 = nb & 7; const int scol = ((w8 & 2) ? DFF : 0) + 128 * ti + 64 * (w8 >> 2) + 32 * (w8 & 1);
        return TrItem{inp_ptr(I_ffn_w_up) + (size_t)l * DM * NUP + (size_t)(64 * kb) * NUP + scol, NUP, WSP(bf16, WS_WUP) + (size_t)l * NUP * DM + (size_t)(32 * nb) * DM + 64 * kb, DM}; }
    r -= I_UP;
    { const int kb = r / 32, nb = r % 32;
        return TrItem{inp_ptr(I_ffn_w_down) + (size_t)l * DFF * DM + (size_t)(64 * kb) * DM + 32 * nb, DM, WSP(bf16, WS_WDOWN) + (size_t)l * DM * DFF + (size_t)(32 * nb) * DFF + 64 * kb, DFF}; }
}
__device__ __forceinline__ void tr_load(const TrItem d, const int lane, f32x4 (&rg)[8]) {
#pragma unroll
    for (int i = 0; i < 8; ++i) { const int v = lane + 64 * i; rg[i] = *(const f32x4*)(d.W + (size_t)(v >> 3) * d.ldw + 4 * (v & 7)); }
}
__device__ __forceinline__ void p0a(Frame& F) {
    PH_IDS();
    {
        LAS float* sc = (LAS float*)F.lds; LAS float* red = (LAS float*)(F.lds + 20480);
        bool first = true;
        for (int unit = bid; unit < 192; unit += F.G) {
            if (first) { for (int i = tid; i < 5 * 1024; i += NTHR) { const int v = i >> 10, k = i & 1023; const float cv = v < 4 ? inp_ptr(I_c)[v * 1024 + k] : inp_ptr(I_c_ctx)[k]; sc[i] = cv / (1.f + expf(-cv)); } __syncthreads(); first = false; }
            const int l = unit / 96, jg = unit % 96;
            const float* w = inp_ptr(I_w_ada) + (size_t)l * 1024 * 6144 + jg * 64 + lane;
            float acc[5] = {0.f, 0.f, 0.f, 0.f, 0.f};
#pragma unroll 64
            for (int kk = 0; kk < 128; ++kk) { const int k = wave * 128 + kk; const float wv = w[(size_t)k * 6144];
#pragma unroll
                for (int v = 0; v < 5; ++v) acc[v] += sc[v * 1024 + k] * wv; }
#pragma unroll
            for (int v = 0; v < 5; ++v) red[(wave * 5 + v) * 64 + lane] = acc[v];
            __syncthreads();
            if (tid < 320) { const int v = tid >> 6, ln = tid & 63; float s = inp_ptr(I_b_ada)[l * 6144 + jg * 64 + ln];
#pragma unroll
                for (int w8 = 0; w8 < 8; ++w8) s += red[(w8 * 5 + v) * 64 + ln];
                WSP(float, WS_ADA)[(l * 5 + v) * 6144 + jg * 64 + ln] = s; }
            __syncthreads();
        }
        __syncthreads();
    }
    {
        LAS float* scr = (LAS float*)(F.lds + wave * 16384);
        const int gw = bid * NWAVES + wave, NGW = F.G * NWAVES;
        constexpr int NIT = NLAYER * (48 * 16 + 32 * 16 + 176 * 16 + 32 * 44);
        f32x4 rg[8];
        if (gw < NIT) tr_load(tr_decode(F, gw), lane, rg);
        for (int it = gw; it < NIT; it += NGW) {
            const TrItem d = tr_decode(F, it);
#pragma unroll
            for (int i = 0; i < 8; ++i) { const int v = lane + 64 * i; LAS float* s = scr + (v >> 3) * 33 + 4 * (v & 7); s[0] = rg[i].x; s[1] = rg[i].y; s[2] = rg[i].z; s[3] = rg[i].w; }
            LDS_WAIT(); asm volatile("" ::: "memory");
            if (it + NGW < NIT) tr_load(tr_decode(F, it + NGW), lane, rg);
            const int c = lane & 7;
#pragma unroll
            for (int j = 0; j < 4; ++j) { const int n = (lane >> 3) + 8 * j; const LAS float* s = scr + (8 * c) * 33 + n;
                v4u o; o.x = pk2(s[0 * 33], s[1 * 33]); o.y = pk2(s[2 * 33], s[3 * 33]); o.z = pk2(s[4 * 33], s[5 * 33]); o.w = pk2(s[6 * 33], s[7 * 33]);
                *(GAS v4u*)(d.WT + (size_t)n * d.ldt + 8 * c) = o; }
            LDS_WAIT(); asm volatile("" ::: "memory");
        }
    }
    {
        LAS float* tw = (LAS float*)F.lds;
        __syncthreads();
        if (tid < 64) { tw[tid] = cospif((float)tid * (1.f / 32.f)); tw[64 + tid] = sinpif((float)tid * (1.f / 32.f)); }
        __syncthreads();
        const int gt = bid * NTHR + tid, NGT = F.G * NTHR;
        for (int it = gt; it < NLAYER * 3 * 4 * 4096; it += NGT) {
            const int d = it & 63, c = (it >> 6) & 63, g = (it >> 12) & 3, wl = it >> 14, which = wl % 3, l = wl / 3;
            float s = 0.f;
            if (which == 2) s = inp_ptr(I_pool_w)[((size_t)(l * 4 + g) * 64 + c) * 64 + d] * inp_ptr(I_pool_scale)[l * 256 + g * 64 + d];
            else { const float* fw = inp_ptr(I_fnet_w) + (size_t)(l * 4 + g) * 4096 + d; const LAS float* tb = tw + (which == 0 ? 0 : 64);
#pragma unroll
                for (int m = 0; m < 64; ++m) s += tb[(c * m) & 63] * fw[m * 64];
                s *= 0.125f; }
            WSP(float, WS_F)[it] = s;
        }
        __syncthreads();
    }
    fft_tables(F, tid, bid);
    {
        const int gt2 = bid * NTHR + tid, NGT2 = F.G * NTHR;
        for (int it = gt2; it < NLAYER * 16 * 1024; it += NGT2) { const int o = it & 15, k = (it >> 4) & 1023, l = it >> 14;
            const float w = inp_ptr(I_w_in)[(size_t)l * DM * NIN_SRC + (size_t)k * NIN_SRC + SRC_DT + o]; const unsigned hi = f2bf(w); const float wl = w - bflo(hi);
            WSP(bf16, WS_WDT)[((size_t)(l * 2 + 0) * 16 + o) * 1024 + k] = (bf16)hi; WSP(bf16, WS_WDT)[((size_t)(l * 2 + 1) * 16 + o) * 1024 + k] = (bf16)f2bf(wl); }
    }
}

__device__ __forceinline__ void ln_normalize(f32x4 (&v)[4]) {
    float s = 0.f;
#pragma unroll
    for (int j = 0; j < 4; ++j) s += (v[j].x + v[j].y) + (v[j].z + v[j].w);
    const float mean = wave_sum(s) * (1.f / DM); float s2 = 0.f;
#pragma unroll
    for (int j = 0; j < 4; ++j) { v[j] = v[j] - mean; s2 += (v[j].x * v[j].x + v[j].y * v[j].y) + (v[j].z * v[j].z + v[j].w * v[j].w); }
    const float rstd = 1.f / sqrtf(wave_sum(s2) * (1.f / DM) + LN_EPS);
#pragma unroll
    for (int j = 0; j < 4; ++j) v[j] = v[j] * rstd;
}
__device__ __forceinline__ void mod_store_dt(Frame& F, const int lane, const f32x4 (&xn)[4], const f32x4 (&shv)[4], const f32x4 (&scv)[4], bf16* hrow, bool do_dt, float* dtrow, const LAS float* wdtT) {
    f32x4 h[4];
#pragma unroll
    for (int j = 0; j < 4; ++j) { h[j] = xn[j] * (scv[j] + 1.f) + shv[j];
        u32x2 w; w.x = pk2(h[j].x, h[j].y); w.y = pk2(h[j].z, h[j].w); *(u32x2*)(hrow + 256 * j + 4 * lane) = w; }
    if (do_dt) {
        float mine = 0.f;
#pragma unroll
        for (int o = 0; o < 16; ++o) { float a = 0.f;
#pragma unroll
            for (int j = 0; j < 4; ++j) { const f32x4 w = *(const LAS f32x4*)(wdtT + o * 1024 + 256 * j + 4 * lane); a += (h[j].x * w.x + h[j].y * w.y) + (h[j].z * w.z + h[j].w * w.w); }
            a = wave_sum(a); if (lane == o) mine = a; }
        if (lane < 16) dtrow[lane] = mine;
    }
}
__device__ __forceinline__ void load_vec4_nt(const float* p, const int lane, f32x4 (&v)[4]) {
#pragma unroll
    for (int j = 0; j < 4; ++j) v[j] = __builtin_nontemporal_load((const f32x4*)(p + 256 * j + 4 * lane));
}
__device__ __forceinline__ void load_vec4(const float* p, const int lane, f32x4 (&v)[4]) {
#pragma unroll
    for (int j = 0; j < 4; ++j) v[j] = *(const f32x4*)(p + 256 * j + 4 * lane);
}
__device__ __forceinline__ void stage_wdt(Frame& F, const int tid, int l, LAS float* wdtT) {
    for (int i = tid; i < 16384; i += NTHR) { const int k = i >> 4, o = i & 15; wdtT[o * 1024 + k] = inp_ptr(I_w_in)[(size_t)l * DM * NIN_SRC + (size_t)k * NIN_SRC + SRC_DT + o]; }
}
__device__ __forceinline__ void p0b(Frame& F) {
    PH_IDS();
    {
        LAS float* scr = (LAS float*)(F.lds + wave * 16384);
        const int gw = bid * NWAVES + wave, NGW = F.G * NWAVES;
        for (int it = gw; it < NLAYER * 3 * 4 * 16 * 2; it += NGW) {
            const int nb2 = it & 1, kb = (it >> 1) & 15, g = (it >> 5) & 3, wl = it >> 7, which = wl % 3, l = wl / 3;
            const int soff = (which == 2 ? SRC_POOL : SRC_FNET) + 64 * g, drow = (which == 0 ? UC_P : which == 1 ? UC_Q : UC_POOL) + 64 * g + 32 * nb2;
            const float* W = inp_ptr(I_w_in) + (size_t)l * DM * NIN_SRC + (size_t)(64 * kb) * NIN_SRC + soff;
#pragma unroll
            for (int i = 0; i < 16; ++i) { const int v = lane + 64 * i; *(LAS f32x4*)(scr + (v >> 4) * 64 + 4 * (v & 15)) = *(const f32x4*)(W + (size_t)(v >> 4) * NIN_SRC + 4 * (v & 15)); }
            LDS_WAIT(); asm volatile("" ::: "memory");
            const float* Fm = WSP(float, WS_F) + (size_t)((l * 3 + which) * 4 + g) * 4096 + 32 * nb2;
            const int d = lane & 31, kh = lane >> 5;
            bf16* orow = WSP(bf16, WS_WIN) + (size_t)l * NIN * DM + (size_t)(drow + d) * DM + 64 * kb + 32 * kh;
            float acc[4][8];
#pragma unroll
            for (int k8 = 0; k8 < 4; ++k8)
#pragma unroll
                for (int q = 0; q < 8; ++q) acc[k8][q] = 0.f;
#pragma unroll 1
            for (int ch = 0; ch < 4; ++ch) {
                float fc[16];
#pragma unroll
                for (int cc = 0; cc < 16; ++cc) fc[cc] = Fm[(16 * ch + cc) * 64 + d];
#pragma unroll
                for (int k8 = 0; k8 < 4; ++k8)
#pragma unroll
                    for (int q = 0; q < 8; ++q) { const LAS float* wr = scr + (32 * kh + 8 * k8 + q) * 64 + 16 * ch; float s = acc[k8][q];
#pragma unroll
                        for (int c4 = 0; c4 < 4; ++c4) { const f32x4 w = *(const LAS f32x4*)(wr + 4 * c4); s += (w.x * fc[4 * c4] + w.y * fc[4 * c4 + 1]) + (w.z * fc[4 * c4 + 2] + w.w * fc[4 * c4 + 3]); }
                        acc[k8][q] = s; }
            }
#pragma unroll
            for (int k8 = 0; k8 < 4; ++k8) *(GAS v4u*)(orow + 8 * k8) = pack8(acc[k8]);
            LDS_WAIT(); asm volatile("" ::: "memory");
        }
    }
    __syncthreads();
    LAS float* wdtT = (LAS float*)F.lds;
    const int gw = bid * NWAVES + wave, NGW = F.G * NWAVES;
    {
        f32x4 xnx[4], xny[4], xnz[4], shv[4], scv[4]; int cur_v = -1;
        constexpr int NFW = NLAYER * 3 * 4 * 16 * 2, R1 = NFW * 13;
        int rb0, rst, rend;
        if (NGW > NFW && R1 < RT) { if (gw < NFW) { rb0 = gw; rst = NFW; rend = R1; } else { rb0 = R1 + gw - NFW; rst = NGW - NFW; rend = RT; } }
        else { rb0 = gw; rst = NGW; rend = RT; }
        if (rb0 < rend) load_vec4_nt(input_row(F, rb0), lane, xnx);
        if (rb0 + rst < rend) load_vec4_nt(input_row(F, rb0 + rst), lane, xny);
        if (rb0 + 2 * rst < rend) load_vec4_nt(input_row(F, rb0 + 2 * rst), lane, xnz);
        for (int row = rb0; row < rend; row += rst) {
            const RowInfo ri = row_info(row);
            f32x4 v[4];
#pragma unroll
            for (int j = 0; j < 4; ++j) { v[j] = xnx[j]; xnx[j] = xny[j]; xny[j] = xnz[j]; }
            if (row + 3 * rst < rend) load_vec4_nt(input_row(F, row + 3 * rst), lane, xnz);
            if (ri.v != cur_v) { const float* ad = WSP(float, WS_ADA) + (size_t)(0 * 5 + ri.v) * 6144; load_vec4(ad, lane, shv); load_vec4(ad + 1024, lane, scv); cur_v = ri.v; }
            ln_normalize(v);
            mod_store_dt(F, lane, v, shv, scv, WSP(bf16, WS_H) + (size_t)row * DM, false, WSP(float, WS_DTRAW) + (size_t)row * 16, wdtT);
        }
    }
}
typedef _Float16 pn_h2 __attribute__((ext_vector_type(2)));
typedef float pn_f2 __attribute__((ext_vector_type(2)));
__device__ __forceinline__ unsigned pkh2(float a, float b) { return __builtin_bit_cast(unsigned, __builtin_convertvector((pn_f2){a, b}, pn_h2)); }
__device__ __forceinline__ float hlo(unsigned w) { return (float)__builtin_bit_cast(pn_h2, w).x; }
__device__ __forceinline__ float hhi(unsigned w) { return (float)__builtin_bit_cast(pn_h2, w).y; }
template <bool SRC_F32, bool DST_F32>
__device__ __forceinline__ void post_norm_pass(Frame& F, int l, int which, int nrows, const bf16* M) {
    PH_IDS();
    constexpr bool has_next = !DST_F32;
    const bool do_dt = false;
    LAS float* wdtT = (LAS float*)F.lds;
    const float* gam = (which == 0 ? inp_ptr(I_ln1_g) : inp_ptr(I_ln2_g)) + l * DM; const float* bet = (which == 0 ? inp_ptr(I_ln1_b) : inp_ptr(I_ln2_b)) + l * DM;
    const int gw = bid * NWAVES + wave, NGW = F.G * NWAVES;
    f32x4 xn[4], xn2[4]; u32x2 hn[4], hn2[4], mn[4], mn2[4];
    f32x4 gmv[4], btv[4], gtv[4], shv[4], scv[4]; int cur_v = -1;
    load_vec4(gam, lane, gmv); load_vec4(bet, lane, btv);
    const unsigned char* sbase = (const unsigned char*)F.out;
#define PN_LOAD(xd, hd, md, rr) do { const int r_ = (rr); if (r_ < nrows) { const bf16* mi = M + (size_t)r_ * DM; \
        if constexpr (SRC_F32) { const float* xi = input_row(F, r_); _Pragma("unroll") for (int j = 0; j < 4; ++j) xd[j] = __builtin_nontemporal_load((const f32x4*)(xi + 256 * j + 4 * lane)); } \
        else { const unsigned char* xi = sbase + (size_t)r_ * 4096; _Pragma("unroll") for (int j = 0; j < 4; ++j) hd[j] = __builtin_nontemporal_load((const u32x2*)(xi + 512 * j + 8 * lane)); } \
        _Pragma("unroll") for (int j = 0; j < 4; ++j) md[j] = __builtin_nontemporal_load((const u32x2*)(mi + 256 * j + 4 * lane)); } } while (0)
    PN_LOAD(xn, hn, mn, gw); PN_LOAD(xn2, hn2, mn2, gw + NGW);
    for (int row = gw; row < nrows; row += NGW) {
        const RowInfo ri = row_info(row);
        f32x4 xc[4]; u32x2 mc[4];
#pragma unroll
        for (int j = 0; j < 4; ++j) {
            if constexpr (SRC_F32) { xc[j] = xn[j]; xn[j] = xn2[j]; }
            else { const u32x2 hw = hn[j]; xc[j] = (f32x4){hlo(hw.x), hhi(hw.x), hlo(hw.y), hhi(hw.y)}; hn[j] = hn2[j]; }
            mc[j] = mn[j]; mn[j] = mn2[j]; }
        PN_LOAD(xn2, hn2, mn2, row + 2 * NGW);
        if (ri.v != cur_v) { const float* ad = WSP(float, WS_ADA) + (size_t)(l * 5 + ri.v) * 6144; load_vec4(ad + (which == 0 ? 2048 : 5120), lane, gtv);
            if (has_next) { const float* ad2 = (which == 0) ? ad + 3072 : WSP(float, WS_ADA) + (size_t)((l + 1) * 5 + ri.v) * 6144; load_vec4(ad2, lane, shv); load_vec4(ad2 + 1024, lane, scv); }
            cur_v = ri.v; }
        f32x4 v[4];
#pragma unroll
        for (int j = 0; j < 4; ++j) { const f32x4 xv = xc[j], gv = gtv[j]; const u32x2 mw = mc[j];
            v[j].x = ALPHA * xv.x + gv.x * bflo(mw.x); v[j].y = ALPHA * xv.y + gv.y * bfhi(mw.x); v[j].z = ALPHA * xv.z + gv.z * bflo(mw.y); v[j].w = ALPHA * xv.w + gv.w * bfhi(mw.y); }
        ln_normalize(v);
        if constexpr (DST_F32) { float* xout = F.out + (size_t)row * DM;
#pragma unroll
            for (int j = 0; j < 4; ++j) { v[j] = v[j] * gmv[j] + btv[j]; __builtin_nontemporal_store(v[j], (f32x4*)(xout + 256 * j + 4 * lane)); } }
        else { unsigned char* xout = (unsigned char*)F.out + (size_t)row * 4096;
#pragma unroll
            for (int j = 0; j < 4; ++j) { v[j] = v[j] * gmv[j] + btv[j]; u32x2 w; w.x = pkh2(v[j].x, v[j].y); w.y = pkh2(v[j].z, v[j].w); __builtin_nontemporal_store(w, (u32x2*)(xout + 512 * j + 8 * lane)); } }
        if (has_next) {
            ln_normalize(v);
            mod_store_dt(F, lane, v, shv, scv, WSP(bf16, WS_H) + (size_t)row * DM, do_dt, WSP(float, WS_DTRAW) + (size_t)row * 16, wdtT);
        }
    }
#undef PN_LOAD
}

__device__ __forceinline__ void ctx_post_norm(Frame& F, int l, int which, int nsl, const bool wdt_staged) {
    PH_IDS();
    const bool do_dt = false; (void)wdt_staged;
    LAS float* wdtT = (LAS float*)F.lds;
    const float* gam = (which == 0 ? inp_ptr(I_ln1_g) : inp_ptr(I_ln2_g)) + l * DM; const float* bet = (which == 0 ? inp_ptr(I_ln1_b) : inp_ptr(I_ln2_b)) + l * DM;
    const float* ad = WSP(float, WS_ADA) + (size_t)(l * 5 + 4) * 6144;
    const float* ad2 = (which == 0) ? ad + 3072 : WSP(float, WS_ADA) + (size_t)((l + 1) * 5 + 4) * 6144;
    const int gw = bid * NWAVES + wave, NGW = F.G * NWAVES;
    for (int row = RL + gw; row < RT; row += NGW) {
        int ln = lane; asm volatile("" : "+v"(ln));
        const float* xin = (which == 0) ? input_row(F, row) : stream_row(F, row); float* xout = stream_row(F, row);
        const float* sl = WSP(float, WS_SLAB) + (size_t)(row - RL) * DM;
        f32x4 v[4];
        {
            f32x4 m[4];
#pragma unroll
            for (int j = 0; j < 4; ++j) m[j] = (f32x4){0.f, 0.f, 0.f, 0.f};
#pragma unroll 1
            for (int s = 0; s < nsl; ++s) {
#pragma unroll
                for (int j = 0; j < 4; ++j) m[j] += *(const f32x4*)(sl + (size_t)s * RC * DM + 256 * j + 4 * ln); }
            f32x4 gtv[4]; load_vec4(ad + (which == 0 ? 2048 : 5120), ln, gtv);
#pragma unroll
            for (int j = 0; j < 4; ++j) v[j] = *(const f32x4*)(xin + 256 * j + 4 * ln) * ALPHA + gtv[j] * m[j];
        }
        ln_normalize(v);
        { f32x4 gmv[4], btv[4]; load_vec4(gam, ln, gmv); load_vec4(bet, ln, btv);
#pragma unroll
          for (int j = 0; j < 4; ++j) { v[j] = v[j] * gmv[j] + btv[j]; *(f32x4*)(xout + 256 * j + 4 * ln) = v[j]; } }
        ln_normalize(v);
        f32x4 shv[4], scv[4]; load_vec4(ad2, ln, shv); load_vec4(ad2 + 1024, ln, scv);
        mod_store_dt(F, ln, v, shv, scv, WSP(bf16, WS_H) + (size_t)row * DM, do_dt, WSP(float, WS_DTRAW) + (size_t)row * 16, wdtT);
    }
}

typedef short dt_bf16x8 __attribute__((ext_vector_type(8)));
__device__ __forceinline__ void dt_mfma(Frame& F, int l, int first_block) {
    PH_IDS();
    if (bid < first_block) return;
    const int c = lane & 15, q = lane >> 4;
    const bf16* Wh = WSP(bf16, WS_WDT) + (size_t)(l * 2) * 16 * 1024 + (size_t)c * 1024 + 8 * q; const bf16* Wl = Wh + 16 * 1024;
    for (int t = (bid - first_block) * NWAVES + wave; t < RT / 16; t += (F.G - first_block) * NWAVES) {
        const bf16* Hr = WSP(bf16, WS_H) + (size_t)(16 * t + c) * DM + 8 * q;
        f32x4 acc = (f32x4){0.f, 0.f, 0.f, 0.f};
#pragma unroll 8
        for (int ks = 0; ks < 32; ++ks) { const dt_bf16x8 av = *(const dt_bf16x8*)(Hr + 32 * ks), bh = *(const dt_bf16x8*)(Wh + 32 * ks), bl = *(const dt_bf16x8*)(Wl + 32 * ks);
            acc = __builtin_amdgcn_mfma_f32_16x16x32_bf16(av, bh, acc, 0, 0, 0); acc = __builtin_amdgcn_mfma_f32_16x16x32_bf16(av, bl, acc, 0, 0, 0); }
        float* dr = WSP(float, WS_DTRAW) + (size_t)(16 * t + 4 * q) * 16 + c;
        dr[0] = acc.x; dr[16] = acc.y; dr[32] = acc.z; dr[48] = acc.w;
    }
}
__device__ __forceinline__ void p2_rest(Frame& F, int l, int first_block) {
    PH_IDS();
    if (bid < first_block) return;
    const int gt = (bid - first_block) * NTHR + tid, NGT = (F.G - first_block) * NTHR;
    const bf16* U = WSP(bf16, WS_U);
    {
        const int prows = (l == 0 ? RT : RL), pr4 = prows >> 2;
        for (int it = gt; it < 4 * pr4 * 8; it += NGT) {
            const int k8 = it & 7, r4 = (it >> 3) % pr4, gi = (it >> 3) / pr4, c8 = gi * 64 + k8 * 8, row0 = 4 * r4; const RowInfo ri = row_info(row0);
            const int win = 2 << gi, left = win >> 1, right = win - 1 - left;
            const bf16* Ub = U + (size_t)ri.base * NIN + UC_POOL + c8;
            float s[4][8], self[4][8];
#pragma unroll
            for (int i = 0; i < 4; ++i)
#pragma unroll
                for (int q = 0; q < 8; ++q) s[i][q] = 0.f;
#define POOL_WIN(W) do { v4u rw[W + 3]; _Pragma("unroll") for (int j = 0; j < W + 3; ++j) { const int tt = ri.pos - (W / 2) + j; rw[j] = (tt >= 0 && tt < ri.L) ? *(const v4u*)(Ub + (size_t)tt * NIN) : (v4u){0u, 0u, 0u, 0u}; } \
                _Pragma("unroll") for (int j = 0; j < W + 3; ++j) { float uf[8]; unpack8(rw[j], uf); \
                    _Pragma("unroll") for (int i = 0; i < 4; ++i) { if (j >= i && j <= i + W - 1) { _Pragma("unroll") for (int q = 0; q < 8; ++q) s[i][q] += uf[q]; } \
                        if (j == (W / 2) + i) { _Pragma("unroll") for (int q = 0; q < 8; ++q) self[i][q] = uf[q]; } } } } while (0)
            if (gi == 0) POOL_WIN(2); else if (gi == 1) POOL_WIN(4); else if (gi == 2) POOL_WIN(8); else POOL_WIN(16);
#undef POOL_WIN
#pragma unroll
            for (int i = 0; i < 4; ++i) { const int pos = ri.pos + i, lo = max(pos - left, 0), hi = min(pos + right + 1, ri.L); const float inv = 1.f / (float)(hi - lo);
#pragma unroll
                for (int q = 0; q < 8; ++q) s[i][q] = s[i][q] * inv - self[i][q];
                *(v4u*)(WSP(bf16, WS_CONCAT) + (size_t)(row0 + i) * DM + 768 + c8) = pack8(s[i]); }
        }
    }
    {
        LAS float* tw2 = (LAS float*)F.lds;
        if (tid < 256) { tw2[tid] = cospif((float)tid * (1.f / 128.f)); tw2[256 + tid] = sinpif((float)tid * (1.f / 128.f)); }
        __syncthreads();
        for (int it = gt; it < (l == 0 ? NB * 256 * 64 * 4 : 0); it += NGT) {
            const int tq = it & 3, c4 = ((it >> 2) & 63) * 4, k = (it >> 8) & 255, b = it >> 16;
            float y[4] = {0.f, 0.f, 0.f, 0.f};
#pragma unroll 16
            for (int tt = 0; tt < 64; ++tt) { const int t = 64 * tq + tt; const size_t ro = (size_t)(RL + b * CTXL + t) * NIN;
                const u32x2 pw = *(const u32x2*)(U + ro + UC_P + c4), qw = *(const u32x2*)(U + ro + UC_Q + c4);
                const int e = (k * t) & 255; const float wr = tw2[e], wi = tw2[256 + e];
                y[0] += wr * bflo(pw.x) - wi * bflo(qw.x); y[1] += wr * bfhi(pw.x) - wi * bfhi(qw.x); y[2] += wr * bflo(pw.y) - wi * bflo(qw.y); y[3] += wr * bfhi(pw.y) - wi * bfhi(qw.y); }
#pragma unroll
            for (int z = 0; z < 4; ++z) { y[z] = DPP_ADD(y[z], 0xB1); y[z] = DPP_ADD(y[z], 0x4E); }
            if (tq == 0) { u32x2 w; w.x = pk2(y[0] * 0.0625f, y[1] * 0.0625f); w.y = pk2(y[2] * 0.0625f, y[3] * 0.0625f);
                *(u32x2*)(WSP(bf16, WS_CONCAT) + (size_t)(RL + b * CTXL + k) * DM + 512 + c4) = w; }
        }
        __syncthreads();
    }
}
typedef _Float16 h2v __attribute__((ext_vector_type(2)));
__device__ __forceinline__ h2v as_h2(unsigned w) { return __builtin_bit_cast(h2v, w); }
__device__ __forceinline__ h2v f2h2(float a, float b) { return __builtin_convertvector((pn_f2){a, b}, h2v); }
__device__ __forceinline__ void unpack8h(const v4u w, float (&f)[8]) { f[0] = hlo(w.x); f[1] = hhi(w.x); f[2] = hlo(w.y); f[3] = hhi(w.y); f[4] = hlo(w.z); f[5] = hhi(w.z); f[6] = hlo(w.w); f[7] = hhi(w.w); }
__device__ __forceinline__ void p7_conv_geglu_rows(Frame& F, const int tid, const int bid, int l, int t0, int ntiles, int nrows, int row_lo, int row_hi) {
    const int gt = bid * NTHR + tid, NGT = F.G * NTHR;
    const bf16* A = WSP(bf16, WS_AH);
    const float* cw = inp_ptr(I_ffn_conv_w) + (size_t)l * 9 * NUP; const float* cb = inp_ptr(I_ffn_conv_b) + (size_t)l * NUP;
    const int per_row = 16 * ntiles;
    for (int it = gt; it < (row_hi - row_lo) * per_row; it += NGT) {
        const int row = row_lo + it / per_row, c8 = (it % per_row) * 8; const int j = 128 * t0 + c8;
        const bf16* Ac = A + (size_t)(c8 >> 6) * nrows * 128 + (c8 & 63);
        float va[8], ga[8];
        { const f32x4 a0 = *(const f32x4*)(cb + j), a1 = *(const f32x4*)(cb + j + 4), g0 = *(const f32x4*)(cb + DFF + j), g1 = *(const f32x4*)(cb + DFF + j + 4);
          va[0] = a0.x; va[1] = a0.y; va[2] = a0.z; va[3] = a0.w; va[4] = a1.x; va[5] = a1.y; va[6] = a1.z; va[7] = a1.w;
          ga[0] = g0.x; ga[1] = g0.y; ga[2] = g0.z; ga[3] = g0.w; ga[4] = g1.x; ga[5] = g1.y; ga[6] = g1.z; ga[7] = g1.w; }
        const bool lat = row < RL; const int pos = lat ? (row & (SEQ - 1)) : ((row - RL) & (CTXL - 1));
        const int gr = pos >> 6, gc = pos & 63;
#pragma unroll
        for (int dy = -1; dy <= 1; ++dy)
#pragma unroll
            for (int dx = -1; dx <= 1; ++dx) {
                bool ok; int nrow;
                if (lat) { ok = (gr + dy >= 0) && (gr + dy < 128) && (gc + dx >= 0) && (gc + dx < 64); nrow = row + 64 * dy + dx; }
                else { ok = (dy == 0) && (pos + dx >= 0) && (pos + dx < CTXL); nrow = row + dx; }
                if (ok) { float vf[8], gf[8]; const bf16* ap = Ac + (size_t)nrow * 128; unpack8h(*(const v4u*)ap, vf); unpack8h(*(const v4u*)(ap + 64), gf);
                    const float* w = cw + (size_t)((dy + 1) * 3 + (dx + 1)) * NUP + j;
                    const f32x4 w0 = *(const f32x4*)w, w1 = *(const f32x4*)(w + 4), u0 = *(const f32x4*)(w + DFF), u1 = *(const f32x4*)(w + DFF + 4);
                    va[0] += w0.x * vf[0]; va[1] += w0.y * vf[1]; va[2] += w0.z * vf[2]; va[3] += w0.w * vf[3]; va[4] += w1.x * vf[4]; va[5] += w1.y * vf[5]; va[6] += w1.z * vf[6]; va[7] += w1.w * vf[7];
                    ga[0] += u0.x * gf[0]; ga[1] += u0.y * gf[1]; ga[2] += u0.z * gf[2]; ga[3] += u0.w * gf[3]; ga[4] += u1.x * gf[4]; ga[5] += u1.y * gf[5]; ga[6] += u1.z * gf[6]; ga[7] += u1.w * gf[7]; } }
        float o[8];
#pragma unroll
        for (int q = 0; q < 8; ++q) o[q] = gelu_tanh_f(ga[q]) * va[q];
        *(v4u*)(WSP(bf16, WS_G) + ((size_t)(j >> 6) * RT + row) * 64 + (j & 63)) = pack8(o);
    }
}

constexpr int CT_PS = 272;
constexpr int CT2_PS = 288, CT2_TILE = 180 * CT2_PS;
__device__ __forceinline__ void p7_conv_geglu(Frame& F, int l, int t0, int ntiles, int nrows) {
    PH_IDS();
    const bf16* A = WSP(bf16, WS_AH); bf16* Gb = WSP(bf16, WS_G);
    const float* cw = inp_ptr(I_ffn_conv_w) + (size_t)l * 9 * NUP; const float* cb = inp_ptr(I_ffn_conv_b) + (size_t)l * NUP;
    const int NUNIT = NB * 8 * 8 * 2 * ntiles;
#define CT_DECODE(u, cch, tx, ty, bb) const int cch = (u) >> 8, tx = (u) & 7, ty = ((u) >> 3) & 7, bb = ((u) >> 6) & 3
    int tab[6];
#pragma unroll
    for (int i = 0; i < 6; ++i) { const int x = tid + 512 * i, pos = x >> 4, k16 = x & 15, hr = pos / 10, hc = pos - 10 * hr;
        tab[i] = (((hr * 64 + hc) * 256 + k16 * 16) << 5) | (hr == 0 ? 1 : 0) | (hr == 17 ? 2 : 0) | (hc == 0 ? 4 : 0) | (hc == 9 ? 8 : 0) | (x >= 180 * 16 ? 16 : 0); }
    const int dmy = 65 * 256 + (tid & 15) * 16;
#define CT_EDGES(ty_, tx_) (16 | ((ty_) == 0 ? 1 : 0) | ((ty_) == 7 ? 2 : 0) | ((tx_) == 0 ? 4 : 0) | ((tx_) == 7 ? 8 : 0))
#define CT_PREFETCH(P, u) do { CT_DECODE(u, cch_, tx_, ty_, bb_); const int em_ = CT_EDGES(ty_, tx_); \
        const unsigned char* tb_ = (const unsigned char*)(A + (size_t)cch_ * nrows * 128) + ((ptrdiff_t)(bb_ * SEQ + (16 * ty_ - 1) * 64 + 8 * tx_ - 1)) * 256; \
        _Pragma("unroll") for (int i = 0; i < 6; ++i) { const bool ok = (tab[i] & em_) == 0; P[i] = *(const v4u*)(tb_ + (ok ? (tab[i] >> 5) : dmy)); } } while (0)
#define CT_TOLDS(P, u, bo) do { CT_DECODE(u, cch_, tx_, ty_, bb_); (void)cch_; (void)bb_; const int em_ = CT_EDGES(ty_, tx_); \
        _Pragma("unroll") for (int i = 0; i < 6; ++i) { const bool ok = (tab[i] & em_) == 0; const v4u v = ok ? P[i] : (v4u){0u, 0u, 0u, 0u}; \
            if (i < 5 || tid < 320) *(LAS v4u*)(F.lds + (bo) + ((tid >> 4) + 32 * i) * CT2_PS + ((tid & 15) >> 3) * 128 + (tid & 7) * 16) = v; } } while (0)
    const int per = (NUNIT + F.G - 1) / F.G, ustart = bid * per, uend = min(ustart + per, NUNIT);
    int wcch = -1;
    h2v wv[9][2], wg[9][2], bv[2], bg[2];
    v4u pre[2][6];
    if (ustart < uend) {
        CT_PREFETCH(pre[0], ustart);
        if (ustart + 1 < uend) CT_PREFETCH(pre[1], ustart + 1);
        __syncthreads();
        CT_TOLDS(pre[0], ustart, 0);
        if (ustart + 2 < uend) CT_PREFETCH(pre[0], ustart + 2);
        __syncthreads();
        for (int u0 = ustart; u0 < uend; u0 += 2) {
#pragma unroll
          for (int sel = 0; sel < 2; ++sel) {
            const int unit = u0 + sel;
            if (unit < uend) {
            if (wave < 4) { if (unit + 1 < uend) CT_TOLDS(pre[sel ^ 1], unit + 1, (sel ^ 1) * CT2_TILE); if (unit + 3 < uend) CT_PREFETCH(pre[sel ^ 1], unit + 3); }
            CT_DECODE(unit, cch, tx, ty, bb);
            const int cg = tid & 15, pg = tid >> 4, r = pg >> 1, hf = pg & 1, j = 128 * t0 + 64 * cch + 4 * cg;
            if (cch != wcch) {
#pragma unroll
                for (int k = 0; k < 9; ++k) { const f32x4 a = *(const f32x4*)(cw + (size_t)k * NUP + j), g = *(const f32x4*)(cw + (size_t)k * NUP + DFF + j);
                    wv[k][0] = f2h2(a.x, a.y); wv[k][1] = f2h2(a.z, a.w); wg[k][0] = f2h2(g.x, g.y); wg[k][1] = f2h2(g.z, g.w); }
                { const f32x4 a = *(const f32x4*)(cb + j), g = *(const f32x4*)(cb + DFF + j); bv[0] = f2h2(a.x, a.y); bv[1] = f2h2(a.z, a.w); bg[0] = f2h2(g.x, g.y); bg[1] = f2h2(g.z, g.w); }
                wcch = cch; }
            const LAS unsigned char* lp = F.lds + sel * CT2_TILE + (r * 10 + 4 * hf) * CT2_PS + cg * 8;
            bf16* Go = Gb + ((size_t)(j >> 6) * RT + (bb * SEQ + (16 * ty + r) * 64 + 8 * tx + 4 * hf)) * 64 + (j & 63);
            h2v pv[2] = {bv[0], bv[1]}, pg_[2] = {bg[0], bg[1]}, cv[2] = {bv[0], bv[1]}, cg_[2] = {bg[0], bg[1]};
            u32x2 dn[6], dc[6];
#define CT_LDCOL(dst, xx) do { dst[0] = *(const LAS u32x2*)(lp + (xx) * CT2_PS); dst[1] = *(const LAS u32x2*)(lp + (xx) * CT2_PS + 128); dst[2] = *(const LAS u32x2*)(lp + (10 + (xx)) * CT2_PS); \
                dst[3] = *(const LAS u32x2*)(lp + (10 + (xx)) * CT2_PS + 128); dst[4] = *(const LAS u32x2*)(lp + (20 + (xx)) * CT2_PS); dst[5] = *(const LAS u32x2*)(lp + (20 + (xx)) * CT2_PS + 128); } while (0)
            CT_LDCOL(dn, 0);
#pragma unroll
            for (int xi = 0; xi < 6; ++xi) {
#pragma unroll
                for (int k = 0; k < 6; ++k) dc[k] = dn[k];
                if (xi < 5) CT_LDCOL(dn, xi + 1);
                h2v nv[2] = {bv[0], bv[1]}, ng[2] = {bg[0], bg[1]};
#pragma unroll
                for (int e = 0; e < 2; ++e) {
                    const h2v v0 = as_h2(e ? dc[0].y : dc[0].x), g0 = as_h2(e ? dc[1].y : dc[1].x), v1 = as_h2(e ? dc[2].y : dc[2].x), g1 = as_h2(e ? dc[3].y : dc[3].x), v2 = as_h2(e ? dc[4].y : dc[4].x), g2 = as_h2(e ? dc[5].y : dc[5].x);
                    pv[e] = wv[2][e] * v0 + pv[e]; pv[e] = wv[5][e] * v1 + pv[e]; pv[e] = wv[8][e] * v2 + pv[e];   pg_[e] = wg[2][e] * g0 + pg_[e]; pg_[e] = wg[5][e] * g1 + pg_[e]; pg_[e] = wg[8][e] * g2 + pg_[e];
                    cv[e] = wv[1][e] * v0 + cv[e]; cv[e] = wv[4][e] * v1 + cv[e]; cv[e] = wv[7][e] * v2 + cv[e];   cg_[e] = wg[1][e] * g0 + cg_[e]; cg_[e] = wg[4][e] * g1 + cg_[e]; cg_[e] = wg[7][e] * g2 + cg_[e];
                    nv[e] = wv[0][e] * v0 + nv[e]; nv[e] = wv[3][e] * v1 + nv[e]; nv[e] = wv[6][e] * v2 + nv[e];   ng[e] = wg[0][e] * g0 + ng[e]; ng[e] = wg[3][e] * g1 + ng[e]; ng[e] = wg[6][e] * g2 + ng[e];
                }
                if (xi >= 2) { u32x2 w;
#pragma unroll
                    for (int e = 0; e < 2; ++e) { const h2v g = pg_[e]; const h2v z = (g * g * (h2v){(_Float16)-0.1029432f, (_Float16)-0.1029432f} + (h2v){(_Float16)-2.3022082f, (_Float16)-2.3022082f}) * g;
                        const h2v d = __builtin_elementwise_exp2(z) + (h2v){(_Float16)1.f, (_Float16)1.f}; h2v rr; rr.x = __builtin_amdgcn_rcph(d.x); rr.y = __builtin_amdgcn_rcph(d.y);
                        const h2v o = g * rr * pv[e]; const unsigned ow_ = pk2((float)o.x, (float)o.y); if (e) w.y = ow_; else w.x = ow_; }
                    *(u32x2*)(Go + (size_t)(xi - 2) * 64) = w; }
#pragma unroll
                for (int e = 0; e < 2; ++e) { pv[e] = cv[e]; pg_[e] = cg_[e]; cv[e] = nv[e]; cg_[e] = ng[e]; }
            }
#undef CT_LDCOL
            if (wave >= 4) { if (unit + 1 < uend) CT_TOLDS(pre[sel ^ 1], unit + 1, (sel ^ 1) * CT2_TILE); if (unit + 3 < uend) CT_PREFETCH(pre[sel ^ 1], unit + 3); }
            __syncthreads();
            }
          }
        }
    }
#undef CT_DECODE
#undef CT_PREFETCH
#undef CT_TOLDS
#undef CT_EDGES
    __syncthreads();
    if (nrows > RL) p7_conv_geglu_rows(F, tid, bid, l, t0, ntiles, nrows, RL, nrows);
}
typedef short s16x4 __attribute__((ext_vector_type(4)));
typedef short v4i16_t __attribute__((ext_vector_type(4)));
constexpr int XS = 544, TS = 288;
constexpr int SSD_X = 0, SSD_B = 128 * XS, SSD_C = SSD_B + 128 * TS, SSD_AUX = SSD_C + 128 * TS, SSD_TOT = SSD_AUX + 8192;
static_assert(SSD_TOT + 64 <= LDSCTL_OFF, "SSD LDS map");
constexpr int NCHUNK = 264;
__device__ __forceinline__ s16x4 tr_read(const LAS unsigned char* p) { return __builtin_bit_cast(s16x4, __builtin_amdgcn_ds_read_tr16_b64_v4i16((LAS v4i16_t*)p)); }
__device__ __forceinline__ f32x4 mfma16(bf16x8 a, bf16x8 b, f32x4 c) { return __builtin_amdgcn_mfma_f32_16x16x32_bf16(a, b, c, 0, 0, 0); }
__device__ __forceinline__ bf16x8 cat8(s16x4 lo, s16x4 hi) { bf16x8 r; r[0] = lo[0]; r[1] = lo[1]; r[2] = lo[2]; r[3] = lo[3]; r[4] = hi[0]; r[5] = hi[1]; r[6] = hi[2]; r[7] = hi[3]; return r; }
__device__ __forceinline__ float s2f(short s) { return __uint_as_float(((unsigned)(unsigned short)s) << 16); }
__device__ __forceinline__ short f2s(float f) { return (short)f2bf(f); }
struct ChunkInfo { int row0, pos0, L; };
__device__ __forceinline__ ChunkInfo chunk_info(int ck) {
    ChunkInfo ci;
    if (ck < 256) { ci.row0 = ck * 128; ci.pos0 = (ck & 63) * 128; ci.L = SEQ; }
    else { const int k = ck - 256; ci.row0 = RL + k * 128; ci.pos0 = (k & 1) * 128; ci.L = CTXL; }
    return ci;
}
__device__ __forceinline__ void ssd_dtcs(Frame& F, int l, int g, const ChunkInfo ci, const int wave, const int lane, const bool weights) {
    LAS float* arr = (LAS float*)(F.lds + SSD_AUX); LAS float* tot = (LAS float*)(F.lds + SSD_TOT);
    const int hp = wave >> 1, dir = wave & 1, hd = 4 * g + hp;
    const float Aneg = -expf(inp_ptr(I_ssd_a_log)[(l * 2 + dir) * 8 + hd]), dtb = inp_ptr(I_ssd_dt_bias)[(l * 2 + dir) * 8 + hd];
    const float* DTR = WSP(float, WS_DTRAW) + (size_t)(ci.row0 + 2 * lane) * 16 + dir * 8 + hd;
    const float dt0 = softplus_f(DTR[0] + dtb), dt1 = softplus_f(DTR[16] + dtb), a0 = dt0 * Aneg, a1 = dt1 * Aneg, s = a0 + a1;
    float incl = s;
#pragma unroll
    for (int o = 1; o < 64; o <<= 1) { const float t = __shfl_up(incl, o); if (lane >= o) incl += t; }
    const float excl = incl - s, total = __shfl(incl, 63);
    float c0, c1;
    if (dir == 0) { c0 = excl + a0; c1 = incl; } else { c0 = excl; c1 = excl + a0; }
    if (!weights) { arr[(hp * 4 + 2 * dir) * 128 + 2 * lane] = dt0; arr[(hp * 4 + 2 * dir) * 128 + 2 * lane + 1] = dt1; arr[(hp * 4 + 2 * dir + 1) * 128 + 2 * lane] = c0; arr[(hp * 4 + 2 * dir + 1) * 128 + 2 * lane + 1] = c1; }
    else {
        const float w0 = dir == 0 ? dt0 * __expf(fminf(total - c0, 0.f)) : dt0 * __expf(c0), w1 = dir == 0 ? dt1 * __expf(fminf(total - c1, 0.f)) : dt1 * __expf(c1);
        arr[(hp * 2 + dir) * 128 + 2 * lane] = w0; arr[(hp * 2 + dir) * 128 + 2 * lane + 1] = w1; }
    if (lane == 0) tot[hp * 2 + dir] = total;
}
template <bool WITH_C>
__device__ __forceinline__ void ssd_conv(Frame& F, int l, int g, const ChunkInfo ci, const int tid) {
    const int cc = tid & 63, rb = tid >> 6;
    if (cc < (WITH_C ? 64 : 48)) {
        const int wcol = cc < 32 ? 256 * g + 8 * cc : cc < 48 ? 512 + 128 * g + 8 * (cc - 32) : 768 + 128 * g + 8 * (cc - 48);
        const float* cw = inp_ptr(I_ssd_conv_w) + (size_t)l * 3 * 1024 + wcol; const float* cb = inp_ptr(I_ssd_conv_b) + l * 1024 + wcol;
        float w0[8], w1[8], w2[8], bs[8];
        { const f32x4 a = *(const f32x4*)cw, b = *(const f32x4*)(cw + 4); w0[0] = a.x; w0[1] = a.y; w0[2] = a.z; w0[3] = a.w; w0[4] = b.x; w0[5] = b.y; w0[6] = b.z; w0[7] = b.w; }
        { const f32x4 a = *(const f32x4*)(cw + 1024), b = *(const f32x4*)(cw + 1028); w1[0] = a.x; w1[1] = a.y; w1[2] = a.z; w1[3] = a.w; w1[4] = b.x; w1[5] = b.y; w1[6] = b.z; w1[7] = b.w; }
        { const f32x4 a = *(const f32x4*)(cw + 2048), b = *(const f32x4*)(cw + 2052); w2[0] = a.x; w2[1] = a.y; w2[2] = a.z; w2[3] = a.w; w2[4] = b.x; w2[5] = b.y; w2[6] = b.z; w2[7] = b.w; }
        { const f32x4 a = *(const f32x4*)cb, b = *(const f32x4*)(cb + 4); bs[0] = a.x; bs[1] = a.y; bs[2] = a.z; bs[3] = a.w; bs[4] = b.x; bs[5] = b.y; bs[6] = b.z; bs[7] = b.w; }
        const bf16* U = WSP(bf16, WS_U) + (size_t)ci.row0 * NIN + UC_XBC + wcol;
        const int l0 = 16 * rb;
#define SSD_CONV_OUT(ll_, o_) do { int off; const int ll = (ll_); \
            if (cc < 32) off = SSD_X + ll * XS + cc * 16; else if (cc < 48) off = SSD_B + ll * TS + (cc - 32) * 16; else off = SSD_C + ll * TS + (cc - 48) * 16; \
            *(LAS v4u*)(F.lds + off) = pack8(o_); } while (0)
        float prev[8], cur[8], nxt[8];
        {
            v4u raw[12];
#pragma unroll
            for (int i = 0; i < 12; ++i) { const int ll = l0 - 1 + i; const bool ok = (ci.pos0 + ll >= 0) && (ci.pos0 + ll < ci.L); raw[i] = ok ? *(const v4u*)(U + (ptrdiff_t)ll * NIN) : (v4u){0u, 0u, 0u, 0u}; }
            unpack8(raw[0], prev); unpack8(raw[1], cur);
#pragma unroll
            for (int i = 0; i < 10; ++i) { unpack8(raw[i + 2], nxt); float o[8];
#pragma unroll
                for (int q = 0; q < 8; ++q) { o[q] = silu_f(bs[q] + w0[q] * prev[q] + w1[q] * cur[q] + w2[q] * nxt[q]); prev[q] = cur[q]; cur[q] = nxt[q]; }
                SSD_CONV_OUT(l0 + i, o); }
        }
        {
            v4u raw[6];
#pragma unroll
            for (int i = 0; i < 6; ++i) { const int ll = l0 + 11 + i; const bool ok = (ci.pos0 + ll < ci.L); raw[i] = ok ? *(const v4u*)(U + (ptrdiff_t)ll * NIN) : (v4u){0u, 0u, 0u, 0u}; }
#pragma unroll
            for (int i = 0; i < 6; ++i) { unpack8(raw[i], nxt); float o[8];
#pragma unroll
                for (int q = 0; q < 8; ++q) { o[q] = silu_f(bs[q] + w0[q] * prev[q] + w1[q] * cur[q] + w2[q] * nxt[q]); prev[q] = cur[q]; cur[q] = nxt[q]; }
                SSD_CONV_OUT(l0 + 10 + i, o); }
        }
#undef SSD_CONV_OUT
    }
}
__device__ __forceinline__ int trx_off(int row, int col) { return row * XS + col * 2; }
__device__ __forceinline__ int trb_off(int row, int col) { return row * TS + col * 2; }
__device__ __forceinline__ void ssd_states(Frame& F, int l) {
    PH_IDS();
    for (int unit = bid; unit < NCHUNK * 2; unit += F.G) {
        int lane_ = lane; asm volatile("" : "+v"(lane_));
        int tid_ = tid; asm volatile("" : "+v"(tid_));
        const int c = lane_ & 15, q = lane_ >> 4;
        const int ck = unit >> 1, g = unit & 1; const ChunkInfo ci = chunk_info(ck);
        __syncthreads();
        ssd_dtcs(F, l, g, ci, wave, lane_, true);
        ssd_conv<false>(F, l, g, ci, tid_);
        __syncthreads();
        const LAS float* arr = (const LAS float*)(F.lds + SSD_AUX); const LAS float* tot = (const LAS float*)(F.lds + SSD_TOT);
        if (tid < 8) WSP(float, WS_DEC)[(ck * 8 + 4 * g + (tid >> 1)) * 2 + (tid & 1)] = __expf(tot[tid]);
        s16x4 blo[4], bhi[4];
#pragma unroll
        for (int ks = 0; ks < 4; ++ks) { const int r0 = 32 * ks + 4 * q + (c >> 2), n0 = 16 * wave + 4 * (c & 3);
            blo[ks] = tr_read(F.lds + SSD_B + trb_off(r0, n0)); bhi[ks] = tr_read(F.lds + SSD_B + trb_off(r0 + 16, n0)); }
        if (wave >= 4) __builtin_amdgcn_s_sleep(10);
#pragma unroll 1
        for (int hp = 0; hp < 4; ++hp) {
            bf16x8 xf[4][4];
#pragma unroll
            for (int pt = 0; pt < 4; ++pt)
#pragma unroll
                for (int ks = 0; ks < 4; ++ks) { const int r0 = 32 * ks + 4 * q + (c >> 2), ch = 64 * hp + 16 * pt + 4 * (c & 3);
                    xf[pt][ks] = cat8(tr_read(F.lds + SSD_X + trx_off(r0, ch)), tr_read(F.lds + SSD_X + trx_off(r0 + 16, ch))); }
#pragma unroll
            for (int dir = 0; dir < 2; ++dir) {
                f32x4 acc[4];
#pragma unroll
                for (int pt = 0; pt < 4; ++pt) acc[pt] = (f32x4){0.f, 0.f, 0.f, 0.f};
#pragma unroll
                for (int ks = 0; ks < 4; ++ks) {
                    const f32x4 wl = *(const LAS f32x4*)(arr + (hp * 2 + dir) * 128 + 32 * ks + 4 * q), wh = *(const LAS f32x4*)(arr + (hp * 2 + dir) * 128 + 32 * ks + 16 + 4 * q);
                    v4u aw; aw.x = pk2(s2f(blo[ks][0]) * wl.x, s2f(blo[ks][1]) * wl.y); aw.y = pk2(s2f(blo[ks][2]) * wl.z, s2f(blo[ks][3]) * wl.w);
                    aw.z = pk2(s2f(bhi[ks][0]) * wh.x, s2f(bhi[ks][1]) * wh.y); aw.w = pk2(s2f(bhi[ks][2]) * wh.z, s2f(bhi[ks][3]) * wh.w);
                    const bf16x8 a = __builtin_bit_cast(bf16x8, aw);
#pragma unroll
                    for (int pt = 0; pt < 4; ++pt) acc[pt] = mfma16(a, xf[pt][ks], acc[pt]);
                }
                bf16* So = WSP(bf16, WS_SST) + ((size_t)((ck * 8 + 4 * g + hp) * 2 + dir)) * 8192 + 16 * wave + 4 * q;
#pragma unroll
                for (int pt = 0; pt < 4; ++pt) { u32x2 w; w.x = pk2(acc[pt].x, acc[pt].y); w.y = pk2(acc[pt].z, acc[pt].w); *(u32x2*)(So + (size_t)(16 * pt + c) * 128) = w; }
            }
        }
    }
    __syncthreads();
}
__device__ __forceinline__ void ssd_scan(Frame& F) {
    PH_IDS();
    const bf16* S = WSP(bf16, WS_SST); bf16* HI = WSP(bf16, WS_HIN); const float* DEC = WSP(float, WS_DEC);
    for (int item = bid * NTHR + tid; item < NB * 8 * 2 * 2048; item += F.G * NTHR) {
        const int quad = item & 2047, dir = (item >> 11) & 1, hd = (item >> 12) & 7, b = item >> 15;
        float h0 = 0.f, h1 = 0.f, h2 = 0.f, h3 = 0.f;
#pragma unroll 1
        for (int blk = 0; blk < 6; ++blk) {
            u32x2 sv[11]; float dv[11]; size_t offs[11];
#pragma unroll
            for (int j = 0; j < 11; ++j) { const int i = blk * 11 + j;
                const int ck = i < 2 ? 256 + 2 * b + (dir == 0 ? i : 1 - i) : 64 * b + (dir == 0 ? i - 2 : 65 - i);
                offs[j] = ((size_t)((ck * 8 + hd) * 2 + dir)) * 8192 + quad * 4; sv[j] = *(const u32x2*)(S + offs[j]); dv[j] = DEC[(ck * 8 + hd) * 2 + dir]; }
#pragma unroll
            for (int j = 0; j < 11; ++j) { u32x2 w; w.x = pk2(h0, h1); w.y = pk2(h2, h3); *(u32x2*)(HI + offs[j]) = w;
                h0 = dv[j] * h0 + bflo(sv[j].x); h1 = dv[j] * h1 + bfhi(sv[j].x); h2 = dv[j] * h2 + bflo(sv[j].y); h3 = dv[j] * h3 + bfhi(sv[j].y); }
        }
    }
}
__device__ __forceinline__ void ssd_out(Frame& F, int l, int nchunks) {
    PH_IDS();
    for (int unit = bid; unit < nchunks * 2; unit += F.G) {
        int lane_ = lane; asm volatile("" : "+v"(lane_));
        int tid_ = tid; asm volatile("" : "+v"(tid_));
        const int c = lane_ & 15, q = lane_ >> 4;
        const int ck = unit >> 1, g = unit & 1; const ChunkInfo ci = chunk_info(ck);
        v4u hreg[4], zreg[2];
#define SSD_HLOAD(hh) do { const bf16* Hg_ = WSP(bf16, WS_HIN) + ((size_t)(ck * 8 + 4 * g + (hh)) * 2) * 8192; \
            _Pragma("unroll") for (int j = 0; j < 4; ++j) { const int x = tid_ + 512 * j, dir = x >> 10, p = (x >> 4) & 63, k16 = x & 15; hreg[j] = *(const v4u*)(Hg_ + (size_t)dir * 8192 + p * 128 + k16 * 8); } \
            _Pragma("unroll") for (int j = 0; j < 2; ++j) { const int x = lane_ + 64 * j, row = x >> 3, k16 = x & 7; zreg[j] = *(const v4u*)(WSP(bf16, WS_U) + (size_t)(ci.row0 + 16 * wave + row) * NIN + UC_Z + 256 * g + 64 * (hh) + 8 * k16); } } while (0)
        SSD_HLOAD(0);
        __syncthreads();
        ssd_dtcs(F, l, g, ci, wave, lane_, false);
        ssd_conv<true>(F, l, g, ci, tid_);
        __syncthreads();
        const LAS float* arr = (const LAS float*)(F.lds + SSD_AUX); const LAS float* tot = (const LAS float*)(F.lds + SSD_TOT);
        const int myl = 16 * wave + c;
        bf16x8 cfr[4];
#pragma unroll
        for (int ks = 0; ks < 4; ++ks) cfr[ks] = *(const LAS bf16x8*)(F.lds + SSD_C + myl * TS + (4 * ks + q) * 16);
        unsigned gtp[8][2];
#pragma unroll
        for (int i = 0; i < 8; ++i) { f32x4 gacc = (f32x4){0.f, 0.f, 0.f, 0.f};
#pragma unroll
            for (int ks = 0; ks < 4; ++ks) { const int row = 16 * i + c; const bf16x8 a = *(const LAS bf16x8*)(F.lds + SSD_B + row * TS + (4 * ks + q) * 16); gacc = mfma16(a, cfr[ks], gacc); }
            gtp[i][0] = pk2(gacc.x, gacc.y); gtp[i][1] = pk2(gacc.z, gacc.w); }
        float ss[4] = {0.f, 0.f, 0.f, 0.f};
        bf16* Co = WSP(bf16, WS_CONCAT) + (size_t)(ci.row0 + 16 * wave) * DM + 256 * g;
        LAS unsigned char* zst = F.lds + SSD_C + wave * 2048;
#pragma unroll 1
        for (int hp = 0; hp < 4; ++hp) {
            const int hd = 4 * g + hp;
            __syncthreads();
#pragma unroll
            for (int j = 0; j < 4; ++j) { const int x = tid_ + 512 * j, dir = x >> 10, p = (x >> 4) & 63, k16 = x & 15; *(LAS v4u*)(F.lds + SSD_B + dir * (64 * TS) + p * TS + k16 * 16) = hreg[j]; }
#pragma unroll
            for (int j = 0; j < 2; ++j) { const int x = lane_ + 64 * j, row = x >> 3, k16 = x & 7; *(LAS v4u*)(zst + row * 128 + k16 * 16) = zreg[j]; }
            __syncthreads();
            if (hp < 3) SSD_HLOAD(hp + 1);
            const float csf_l = arr[(hp * 4 + 1) * 128 + myl], csb_l = arr[(hp * 4 + 3) * 128 + myl];
            f32x4 acc[4];
#pragma unroll
            for (int pt = 0; pt < 4; ++pt) acc[pt] = (f32x4){0.f, 0.f, 0.f, 0.f};
#pragma unroll
            for (int ks = 0; ks < 4; ++ks) {
                unsigned aw[4];
#pragma unroll
                for (int hf = 0; hf < 2; ++hf) { const int i = 2 * ks + hf, s0 = 16 * i + 4 * q; float m[4];
                    if (i < wave) { const f32x4 dtf = *(const LAS f32x4*)(arr + (hp * 4 + 0) * 128 + s0), csf = *(const LAS f32x4*)(arr + (hp * 4 + 1) * 128 + s0);
#pragma unroll
                        for (int r = 0; r < 4; ++r) m[r] = __expf(fminf(csf_l - csf[r], 0.f)) * dtf[r]; }
                    else if (i > wave) { const f32x4 dtb = *(const LAS f32x4*)(arr + (hp * 4 + 2) * 128 + s0), csb = *(const LAS f32x4*)(arr + (hp * 4 + 3) * 128 + s0);
#pragma unroll
                        for (int r = 0; r < 4; ++r) m[r] = __expf(fminf(csb[r] - csb_l, 0.f)) * dtb[r]; }
                    else { const f32x4 dtf = *(const LAS f32x4*)(arr + (hp * 4 + 0) * 128 + s0), csf = *(const LAS f32x4*)(arr + (hp * 4 + 1) * 128 + s0);
                        const f32x4 dtb = *(const LAS f32x4*)(arr + (hp * 4 + 2) * 128 + s0), csb = *(const LAS f32x4*)(arr + (hp * 4 + 3) * 128 + s0);
#pragma unroll
                        for (int r = 0; r < 4; ++r) { const int sl = 4 * q + r;
                            const float mf = (sl <= c) ? __expf(fminf(csf_l - csf[r], 0.f)) * dtf[r] : 0.f, mb = (sl >= c) ? __expf(fminf(csb[r] - csb_l, 0.f)) * dtb[r] : 0.f; m[r] = mf + mb; } }
                    aw[2 * hf] = pk2(bflo(gtp[i][0]) * m[0], bfhi(gtp[i][0]) * m[1]); aw[2 * hf + 1] = pk2(bflo(gtp[i][1]) * m[2], bfhi(gtp[i][1]) * m[3]); }
                const bf16x8 a = __builtin_bit_cast(bf16x8, (v4u){aw[0], aw[1], aw[2], aw[3]});
#pragma unroll
                for (int pt = 0; pt < 4; ++pt) { const int r0 = 32 * ks + 4 * q + (c >> 2), ch = 64 * hp + 16 * pt + 4 * (c & 3);
                    const bf16x8 b = cat8(tr_read(F.lds + SSD_X + trx_off(r0, ch)), tr_read(F.lds + SSD_X + trx_off(r0 + 16, ch)));
                    acc[pt] = mfma16(a, b, acc[pt]); }
            }
#pragma unroll
            for (int dir = 0; dir < 2; ++dir) {
                const float e = dir == 0 ? __expf(csf_l) : __expf(fminf(tot[hp * 2 + 1] - csb_l, 0.f));
#pragma unroll
                for (int ks = 0; ks < 4; ++ks) { v4u aw; aw.x = pk2(s2f(cfr[ks][0]) * e, s2f(cfr[ks][1]) * e); aw.y = pk2(s2f(cfr[ks][2]) * e, s2f(cfr[ks][3]) * e); aw.z = pk2(s2f(cfr[ks][4]) * e, s2f(cfr[ks][5]) * e); aw.w = pk2(s2f(cfr[ks][6]) * e, s2f(cfr[ks][7]) * e);
                    const bf16x8 a = __builtin_bit_cast(bf16x8, aw);
#pragma unroll
                    for (int pt = 0; pt < 4; ++pt) { const int p = 16 * pt + c; const bf16x8 b = *(const LAS bf16x8*)(F.lds + SSD_B + dir * (64 * TS) + p * TS + (4 * ks + q) * 16); acc[pt] = mfma16(a, b, acc[pt]); } }
            }
            const float dsk = inp_ptr(I_ssd_d)[l * 8 + hd];
#pragma unroll
            for (int pt = 0; pt < 4; ++pt) { const s16x4 xs = tr_read(F.lds + SSD_X + trx_off(16 * wave + 4 * q + (c >> 2), 64 * hp + 16 * pt + 4 * (c & 3)));
#pragma unroll
                for (int r = 0; r < 4; ++r) { LAS unsigned short* zp = (LAS unsigned short*)(zst + (4 * q + r) * 128 + (16 * pt + c) * 2);
                    const float y = (acc[pt][r] + s2f(xs[r]) * dsk) * silu_f(bf2f(*zp)); ss[r] += y * y; *zp = (unsigned short)f2bf(y); } }
            asm volatile("s_waitcnt lgkmcnt(0)" ::: "memory");
#pragma unroll
            for (int j = 0; j < 2; ++j) { const int x = lane_ + 64 * j, row = x >> 3, k16 = x & 7; *(v4u*)(Co + (size_t)row * DM + 64 * hp + 8 * k16) = *(const LAS v4u*)(zst + row * 128 + k16 * 16); }
        }
#undef SSD_HLOAD
#pragma unroll
        for (int r = 0; r < 4; ++r) { float s = ss[r]; s += __shfl_xor(s, 1); s += __shfl_xor(s, 2); s += __shfl_xor(s, 4); s += __shfl_xor(s, 8); ss[r] = 1.f / sqrtf(s * (1.f / 256.f) + LN_EPS); }
        LAS float* rs = (LAS float*)(zst);
        if (c == 0) { rs[4 * q + 0] = ss[0]; rs[4 * q + 1] = ss[1]; rs[4 * q + 2] = ss[2]; rs[4 * q + 3] = ss[3]; }
        asm volatile("s_waitcnt vmcnt(0) lgkmcnt(0)" ::: "memory");
        const float* nw = inp_ptr(I_ssd_norm_w) + l * 512 + 256 * g;
#pragma unroll 2
        for (int j = 0; j < 8; ++j) { const int x = lane_ + 64 * j, row = x >> 5, k16 = x & 31; float yf[8];
            unpack8(*(const v4u*)(Co + (size_t)row * DM + 8 * k16), yf);
            const float rr = rs[row]; const f32x4 n0 = *(const f32x4*)(nw + 8 * k16), n1 = *(const f32x4*)(nw + 8 * k16 + 4);
            yf[0] *= rr * n0.x; yf[1] *= rr * n0.y; yf[2] *= rr * n0.z; yf[3] *= rr * n0.w; yf[4] *= rr * n1.x; yf[5] *= rr * n1.y; yf[6] *= rr * n1.z; yf[7] *= rr * n1.w;
            *(v4u*)(Co + (size_t)row * DM + 8 * k16) = pack8(yf); }
    }
    __syncthreads();
}
__device__ __forceinline__ int kperm_inv(int pos) { const int ks = pos >> 5, q = (pos >> 3) & 3, j = pos & 7; return 32 * ks + (j < 4 ? 4 * q + j : 16 + 4 * q + (j - 4)); }
__device__ __forceinline__ void fft_tables(Frame& F, const int tid, const int bid) {
    const int gt = bid * NTHR + tid, NGT = F.G * NTHR;
    for (int it = gt; it < 128 * 128; it += NGT) {
        const int m = it >> 7, k = kperm_inv(it & 127), po = m >> 6, k1 = m & 63, pi = k >> 6, l1 = k & 63;
        const float a = (float)((k1 * l1) & 63) * (1.f / 32.f), wr = cospif(a), wi = sinpif(a);
        const float v = po == 0 ? (pi == 0 ? wr : -wi) : (pi == 0 ? wi : wr);
        WSP(bf16, WS_WA)[it] = (bf16)f2bf(v); }
    for (int it = gt; it < 128 * 256; it += NGT) {
        const int k2 = it >> 8, k = kperm_inv(it & 255), l2 = k >> 1, pi = k & 1;
        const float a = (float)((k2 * l2) & 127) * (1.f / 64.f);
        WSP(bf16, WS_WB)[it] = (bf16)f2bf(pi == 0 ? cospif(a) : -sinpif(a)); }
    for (int it = gt; it < 64 * 128; it += NGT) {
        const int k1 = it >> 7, l2 = it & 127; const float a = (float)(k1 * l2) * (1.f / 4096.f);
        WSP(float, WS_TW)[2 * it] = cospif(a); WSP(float, WS_TW)[2 * it + 1] = sinpif(a); }
}
__device__ __forceinline__ void fft_a(Frame& F, int first_block) {
    PH_IDS();
    const bf16* U = WSP(bf16, WS_U);
    if (bid < first_block) return;
    for (int unit = bid - first_block; unit < NB * 128; unit += F.G - first_block) {
        int lane_ = lane; asm volatile("" : "+v"(lane_));
        const int c = lane_ & 15, q = lane_ >> 4, b = unit >> 7, l2 = unit & 127, kt = wave & 3, half = wave >> 2;
        __syncthreads();
#pragma unroll
        for (int j = 0; j < 8; ++j) { const int x = tid + 512 * j, tok = x >> 6, k16 = x & 63;
            *(LAS v4u*)(F.lds + ((k16 >> 5) * 64 + tok) * XS + (k16 & 31) * 16) = *(const v4u*)(U + (size_t)(b * SEQ + 128 * tok + l2) * NIN + UC_P + 8 * k16); }
        __syncthreads();
        f32x4 acc[2][8];
#pragma unroll
        for (int i = 0; i < 2; ++i)
#pragma unroll
            for (int ct = 0; ct < 8; ++ct) acc[i][ct] = (f32x4){0.f, 0.f, 0.f, 0.f};
#pragma unroll
        for (int ks = 0; ks < 4; ++ks) {
            const bf16x8 are = *(const bf16x8*)(WSP(bf16, WS_WA) + (size_t)(16 * kt + c) * 128 + 32 * ks + 8 * q), aim = *(const bf16x8*)(WSP(bf16, WS_WA) + (size_t)(64 + 16 * kt + c) * 128 + 32 * ks + 8 * q);
#pragma unroll
            for (int ct = 0; ct < 8; ++ct) { const int r0 = 32 * ks + 4 * q + (c >> 2), ch = 128 * half + 16 * ct + 4 * (c & 3);
                const bf16x8 bfr = cat8(tr_read(F.lds + trx_off(r0, ch)), tr_read(F.lds + trx_off(r0 + 16, ch)));
                acc[0][ct] = mfma16(are, bfr, acc[0][ct]); acc[1][ct] = mfma16(aim, bfr, acc[1][ct]); }
        }
        float tr[4], ti[4];
#pragma unroll
        for (int r = 0; r < 4; ++r) { const int k1 = 16 * kt + 4 * q + r; tr[r] = WSP(float, WS_TW)[2 * (k1 * 128 + l2)]; ti[r] = WSP(float, WS_TW)[2 * (k1 * 128 + l2) + 1]; }
        __syncthreads();
#pragma unroll
        for (int ct = 0; ct < 8; ++ct)
#pragma unroll
            for (int r = 0; r < 4; ++r) { const int k1 = 16 * kt + 4 * q + r, ch = 128 * half + 16 * ct + c; const float yr = acc[0][ct][r], yi = acc[1][ct][r];
                *(LAS unsigned short*)(F.lds + k1 * XS + ch * 2) = (unsigned short)f2bf(yr * tr[r] - yi * ti[r]);
                *(LAS unsigned short*)(F.lds + (64 + k1) * XS + ch * 2) = (unsigned short)f2bf(yr * ti[r] + yi * tr[r]); }
        __syncthreads();
#pragma unroll
        for (int j = 0; j < 8; ++j) { const int x = tid + 512 * j, row = x >> 5, k16 = x & 31, part = row >> 6, k1 = row & 63;
            *(v4u*)(WSP(bf16, WS_YFFT) + ((size_t)((b * 64 + k1) * 128 + l2) * 2 + part) * 256 + 8 * k16) = *(const LAS v4u*)(F.lds + row * XS + k16 * 16); }
    }
    __syncthreads();
}
__device__ __forceinline__ void fft_b(Frame& F) {
    PH_IDS();
    for (int unit = bid; unit < NB * 64; unit += F.G) {
        int lane_ = lane; asm volatile("" : "+v"(lane_));
        const int c = lane_ & 15, q = lane_ >> 4, b = unit >> 6, k1 = unit & 63, mt0 = 2 * (wave & 3), half = wave >> 2;
        __syncthreads();
        const bf16* Yg = WSP(bf16, WS_YFFT) + (size_t)(b * 64 + k1) * 256 * 256;
#pragma unroll
        for (int j = 0; j < 16; ++j) { const int x = tid + 512 * j, row = x >> 5, k16 = x & 31; *(LAS v4u*)(F.lds + row * XS + k16 * 16) = *(const v4u*)(Yg + (size_t)row * 256 + 8 * k16); }
        __syncthreads();
        f32x4 acc[2][8];
#pragma unroll
        for (int i = 0; i < 2; ++i)
#pragma unroll
            for (int ct = 0; ct < 8; ++ct) acc[i][ct] = (f32x4){0.f, 0.f, 0.f, 0.f};
#pragma unroll 2
        for (int ks = 0; ks < 8; ++ks) {
            const bf16x8 a0 = *(const bf16x8*)(WSP(bf16, WS_WB) + (size_t)(16 * mt0 + c) * 256 + 32 * ks + 8 * q), a1 = *(const bf16x8*)(WSP(bf16, WS_WB) + (size_t)(16 * mt0 + 16 + c) * 256 + 32 * ks + 8 * q);
#pragma unroll
            for (int ct = 0; ct < 8; ++ct) { const int r0 = 32 * ks + 4 * q + (c >> 2), ch = 128 * half + 16 * ct + 4 * (c & 3);
                const bf16x8 bfr = cat8(tr_read(F.lds + trx_off(r0, ch)), tr_read(F.lds + trx_off(r0 + 16, ch)));
                acc[0][ct] = mfma16(a0, bfr, acc[0][ct]); acc[1][ct] = mfma16(a1, bfr, acc[1][ct]); }
        }
        __syncthreads();
        const float nrm = 0.011048543456039806f;
#pragma unroll
        for (int i = 0; i < 2; ++i)
#pragma unroll
            for (int ct = 0; ct < 8; ++ct)
#pragma unroll
                for (int r = 0; r < 4; ++r) *(LAS unsigned short*)(F.lds + (16 * (mt0 + i) + 4 * q + r) * XS + (128 * half + 16 * ct + c) * 2) = (unsigned short)f2bf(acc[i][ct][r] * nrm);
        __syncthreads();
#pragma unroll
        for (int j = 0; j < 8; ++j) { const int x = tid + 512 * j, k2 = x >> 5, k16 = x & 31;
            *(v4u*)(WSP(bf16, WS_CONCAT) + (size_t)(b * SEQ + k1 + 64 * k2) * DM + 512 + 8 * k16) = *(const LAS v4u*)(F.lds + k2 * XS + k16 * 16); }
    }
    __syncthreads();
}
#ifndef DBL_MASK
#define DBL_MASK 0
#endif
#ifndef MK_PER_PHASE
#define MK_PER_PHASE 0
#endif
constexpr int N_PHASES = 2 + 12 * NLAYER;
struct Args { const float* in[25]; float* out; unsigned char* ws; int ph_lo, ph_hi, li, pad; };
__global__ void __launch_bounds__(NTHR, 2) skel_fwd(Args args) {
    extern __shared__ __attribute__((aligned(16))) unsigned char lds[];
    Frame F;
    F.lds = (LAS unsigned char*)lds; F.MISC = (volatile LAS unsigned*)(F.lds + MISC_OFF);
    F.G = gridDim.x;
    F.ws = args.ws; F.ctl = (gu32*)(F.ws + WS_CTL); F.out = args.out;
    for (int u = threadIdx.x; u < (LDS_BYTES - LDSCTL_OFF) / 4; u += NTHR) ((LAS unsigned*)(F.lds + LDSCTL_OFF))[u] = 0u;
    __syncthreads();
    XcdBarrier bar; bar.bar = (unsigned*)(F.ctl + CW_BAR); bar.x = 0; bar.st = nullptr;
    const int lo = args.ph_lo, hi = args.ph_hi;
    if (hi - lo > 1) bar = xcd_barrier_post((unsigned*)(F.ctl + CW_BAR) + args.li * XCD_BAR_WORDS, F.MISC + 8);

    for (int ph = lo; ph < hi; ++ph) {
        if (ph == 0) {
#ifndef SKIP_P0A
 p0a(F); if (DBL_MASK & 8192) p0a(F);
#endif
 }
        else if (ph == 1) {
#ifndef SKIP_P0B
 p0b(F); if (DBL_MASK & 16384) p0b(F);
#endif
 }
        else {
            const int l = (ph - 2) / 12, s = (ph - 2) % 12;
            const int nrows = (l == 0) ? RT : RL;
            const int up_na = (l == 0 || F.G != 256) ? 11 : 10;
            if (s == 0) dt_mfma(F, l, (F.G == 256) ? 164 : 0);
            if (s == 0 || s == 4 || s == 6 || s == 8 || s == 10) {
                pg8::Gemm g; bf16* O; int ldc; size_t cstr = 0;
                if (s == 0) { g = pg8::Gemm{WSP(bf16, WS_H), WSP(bf16, WS_WIN) + (size_t)l * NIN * DM, RT, NIN, DM}; O = WSP(bf16, WS_U); ldc = NIN; }
                else if (s == 4) { g = pg8::Gemm{WSP(bf16, WS_CONCAT), WSP(bf16, WS_WOUT) + (size_t)l * DM * DM, RL, DM, DM}; O = WSP(bf16, WS_MIX); ldc = DM; }
                else if (s == 10) { g = pg8::Gemm{WSP(bf16, WS_G), WSP(bf16, WS_WDOWN) + (size_t)l * DM * DFF, RL, DM, DFF, 0, 64, (size_t)RT * 128}; O = WSP(bf16, WS_FFNO); ldc = DM; }
                else { const int t0 = (s == 8) ? up_na : 0, ntl = (s == 8) ? 22 - up_na : up_na; g = pg8::Gemm{WSP(bf16, WS_H), WSP(bf16, WS_WUP) + (size_t)l * NUP * DM + (size_t)t0 * 256 * DM, nrows, ntl * 256, DM}; O = WSP(bf16, WS_AH); ldc = 128; cstr = (size_t)nrows * 128; }
                int bid = blockIdx.x; asm volatile("" : "+s"(bid)); pg8::StaticOrder S; S.init(g.M, g.N, F.G, bid);
                pg8::EpiBf16<0> E{O, ldc, nullptr, 0, 0, 1.f, cstr, (s == 6 || s == 8)};
#ifndef SKIP_GEMM
                pg8::gemm_phase<pg8::EpiBf16<0>, pg8::StaticOrder, true, true>(F.lds, g, S, E);
                if (DBL_MASK & 1) pg8::gemm_phase<pg8::EpiBf16<0>, pg8::StaticOrder, true, true>(F.lds, g, S, E);
#endif
                if ((s == 4 || s == 10) && l == 0) {
                    const int Kt = (s == 4) ? DM : DFF;
                    const int ksl = Kt / 2;
                    pg8::Gemm gc{(s == 4 ? WSP(bf16, WS_CONCAT) + (size_t)RL * DM : WSP(bf16, WS_G) + (size_t)RL * 64), g.Bt, RC, DM, ksl, Kt, (s == 4 ? 0 : 64), (s == 4 ? (size_t)0 : (size_t)RT * 128)};
                    pg8::SliceOrder SO{RC / 256, DM / 256, 2, ksl, F.G, bid};
                    pg8::EpiF32Slab ES{WSP(float, WS_SLAB), DM, ksl, (size_t)RC * DM};
                    pg8::gemm_phase<pg8::EpiF32Slab, pg8::SliceOrder, false, false>(F.lds, gc, SO, ES);
                }
            }
            else if (s == 1) { ssd_states(F, l); if (DBL_MASK & 2) ssd_states(F, l); fft_a(F, (l == 0 && F.G > 32) ? 16 : 0); if (DBL_MASK & 4) fft_a(F, (l == 0 && F.G > 32) ? 16 : 0); }
            else if (s == 2) { ssd_scan(F); if (DBL_MASK & 16) ssd_scan(F); fft_b(F); if (DBL_MASK & 4) fft_b(F); }
            else if (s == 3) { ssd_out(F, l, l == 0 ? NCHUNK : 256); if (DBL_MASK & 256) ssd_out(F, l, l == 0 ? NCHUNK : 256); p2_rest(F, l, (l == 0 && F.G > 32) ? 16 : 0); if (DBL_MASK & 32) p2_rest(F, l, (l == 0 && F.G > 32) ? 16 : 0); }
            else if (s == 5) {
#ifndef SKIP_PN
 if (l == 0) post_norm_pass<true, false>(F, l, 0, RL, WSP(bf16, WS_MIX)); else post_norm_pass<false, false>(F, l, 0, RL, WSP(bf16, WS_MIX)); if (l == 0) ctx_post_norm(F, l, 0, 2, false);
#endif
 }
            else if (s == 7 || s == 9) {
#ifndef SKIP_P7
 p7_conv_geglu(F, l, s == 9 ? up_na : 0, s == 9 ? 22 - up_na : up_na, nrows); if (DBL_MASK & 8) p7_conv_geglu(F, l, s == 9 ? up_na : 0, s == 9 ? 22 - up_na : up_na, nrows);
#endif
 }
            else {
#ifndef SKIP_PN
 if (l + 1 < NLAYER) post_norm_pass<false, false>(F, l, 1, RL, WSP(bf16, WS_FFNO)); else post_norm_pass<false, true>(F, l, 1, RL, WSP(bf16, WS_FFNO)); if (l == 0) ctx_post_norm(F, l, 1, 2, true);
#endif
 }
        }
        if (ph + 1 < hi) xcd_barrier(bar);
    }
}

extern "C" void kernel_launch(void* const* d_in, const int* in_sizes, int n_in, void* d_out, int out_size, void* d_ws, size_t ws_size, hipStream_t stream) {
    static int grid = 0;
    if (grid == 0) {
        if (n_in != 25 || in_sizes[0] != RL * DM || out_size != RL * DM || ws_size < WS_END) { fprintf(stderr, "kernel_launch: unexpected shapes: n_in %d in0 %d out %d ws %zu (need %zu)\n", n_in, n_in > 0 ? in_sizes[0] : -1, out_size, ws_size, (size_t)WS_END); grid = -1; return; }
        int dev = 0, cus = 0, per_cu = 0;
        if (hipGetDevice(&dev) != hipSuccess || hipDeviceGetAttribute(&cus, hipDeviceAttributeMultiprocessorCount, dev) != hipSuccess) { grid = -1; return; }
        if (hipFuncSetAttribute((const void*)skel_fwd, hipFuncAttributeMaxDynamicSharedMemorySize, LDS_BYTES) != hipSuccess) { fprintf(stderr, "kernel_launch: hipFuncSetAttribute failed\n"); grid = -1; return; }
        if (hipOccupancyMaxActiveBlocksPerMultiprocessor(&per_cu, (const void*)skel_fwd, NTHR, LDS_BYTES) != hipSuccess || per_cu < 1) fprintf(stderr, "kernel_launch: occupancy query reports %d blocks per CU\n", per_cu);
        (void)hipGetLastError();
        grid = cus;
    }
    if (grid < 0) return;
    (void)hipMemsetAsync((char*)d_ws + WS_CTL, 0, CTL_ZERO_BYTES, stream);
    Args a{};
    for (int i = 0; i < 25; ++i) a.in[i] = (const float*)d_in[i];
    a.out = (float*)d_out; a.ws = (unsigned char*)d_ws;
#if MK_PER_PHASE
    for (int ph = 0; ph < N_PHASES; ++ph) { a.ph_lo = ph; a.ph_hi = ph + 1; a.li = 0; hipLaunchKernelGGL(skel_fwd, dim3(grid), dim3(NTHR), LDS_BYTES, stream, a); }
#else
    a.ph_lo = 0; a.ph_hi = N_PHASES; a.li = 0;
    hipLaunchKernelGGL(skel_fwd, dim3(grid), dim3(NTHR), LDS_BYTES, stream, a);
#endif
}
```

```cpp
#include <hip/hip_runtime.h>
#include <cstdio>
#include <cstdint>
namespace pg8 {
#define PG8_LAS __attribute__((address_space(3)))
typedef unsigned short bf16_t;
typedef short bf16x8 __attribute__((ext_vector_type(8)));
typedef float f32x4 __attribute__((ext_vector_type(4)));
typedef unsigned u32x4 __attribute__((ext_vector_type(4)));
constexpr int BM = 256, BK = 64, HALF = 128, HTB = HALF * BK * 2  , STAGE_BYTES = 8 * HTB, NXCD = 8, WGM = 8;

__host__ __device__ __forceinline__ int lds_byte(int r, int c) { const int st = (r >> 4) * 2 + (c >> 5), rr = r & 15, cc = c & 31, ob = rr * 64 + cc * 2; return st * 1024 + (ob ^ (((ob >> 9) & 1) << 5)); }
__host__ __device__ __forceinline__ void stage_rc(int b, int& R, int& C) { const int st = b / 1024, sb = b % 1024, swz = sb ^ (((sb >> 9) & 1) << 5); R = (st >> 1) * 16 + swz / 64; C = (st & 1) * 32 + (swz % 64) / 2; }
__host__ __device__ __forceinline__ int perm32(int rho) { const int n = rho >> 4, i = rho & 15; return 8 * (i >> 2) + 4 * n + (i & 3); }

struct Unit { int pm, pn, kofs; };
struct Gemm { const bf16_t* A; const bf16_t* Bt; int M, N, K; int ld = 0; int lda = 0; size_t kstepA = 0; };

struct StaticOrder {
    int nM, nN, nwg, G, c;
    __host__ __device__ void init(int M, int N, int G_, int c_) { nM = M / BM; nN = N / BM; nwg = nM * nN; G = G_; c = c_; }
    __host__ __device__ bool next(int i, Unit& u) const {
        const long L = (long)i * G + c; if (L >= nwg) return false;
        int wgid = (int)L; { const int q = nwg / NXCD, r = nwg % NXCD, xcd = wgid % NXCD, off = wgid / NXCD; wgid = (xcd < r ? xcd * (q + 1) : r * (q + 1) + (xcd - r) * q) + off; }
        const int nig = WGM * nN, gid = wgid / nig, fm = gid * WGM, gsz = (nM - fm) < WGM ? (nM - fm) : WGM;
        u.pm = fm + ((wgid % nig) % gsz); u.pn = (wgid % nig) / gsz; u.kofs = 0; return true;
    }
    __device__ __forceinline__ void a_ready(const Unit&) const {}
    __device__ __forceinline__ void done(const Unit&) const {}
};

__device__ __forceinline__ unsigned cvt_pk_bf16(float lo, float hi) { unsigned r; asm volatile("v_cvt_pk_bf16_f32 %0, %1, %2" : "=v"(r) : "v"(lo), "v"(hi)); return r; }
__device__ __forceinline__ unsigned cvt_pk_f16(float lo, float hi) { unsigned r; asm volatile("v_cvt_pk_f16_f32 %0, %1, %2" : "=v"(r) : "v"(lo), "v"(hi)); return r; }
typedef float f32x2 __attribute__((ext_vector_type(2)));
__device__ __forceinline__ f32x2 gelu_pk(f32x2 v) {
    const f32x2 av = __builtin_elementwise_abs(v), d = av * 0.2316418882f + 1.0f;
    f32x2 t; t.x = __builtin_amdgcn_rcpf(d.x); t.y = __builtin_amdgcn_rcpf(d.y);
    f32x2 q = t * 0.5307027145f + (-0.7265760135f); q = q * t + 0.7107068705f; q = q * t + (-0.142248368f); q = q * t + 0.127414796f; q = q * t;
    const f32x2 s = (v * v) * (-0.72134752044f);
    f32x2 e; e.x = __builtin_amdgcn_exp2f(s.x); e.y = __builtin_amdgcn_exp2f(s.y);
    const f32x2 m = v * (q * e), r = v - m;
    f32x2 o; o.x = v.x < 0.f ? m.x : r.x; o.y = v.y < 0.f ? m.y : r.y; return o;
}

template <int ACT  > struct EpiBf16 {
    static constexpr bool PERM = true, AFTER_DRAIN = false; static_assert(ACT == 0 || ACT == 1, "EpiBf16: ACT is 0 (none) or 1 (gelu_pk)");
    bf16_t* O; int ldc; const float* bias; int split_cols; size_t split_stride; float scale0;
    size_t cstride = 0; bool f16out = false;
    __device__ __forceinline__ void operator()(const f32x4 (&acc)[2][2][4][2], const Unit& u, int wr, int wc, int fr, int fq) const {
        const int row0 = u.pm * BM + wr * 64 + fr; int colt = u.pn * BM; bf16_t* base = O;
        float sc = 1.f; if (split_cols) { const int t = colt / split_cols; base += (size_t)t * split_stride; colt -= t * split_cols; if (t == 0) sc = scale0; }
        const size_t cs = cstride ? cstride : (size_t)HALF; const size_t col0 = (size_t)(colt >> 7) * cs + wc * 32 + 8 * fq; const int bcol0 = u.pn * BM + wc * 32 + 8 * fq;
        f32x4 bv[2][2];
#pragma unroll
        for (int bj = 0; bj < 2; ++bj)
#pragma unroll
            for (int n = 0; n < 2; ++n) bv[bj][n] = bias ? *(const f32x4*)(bias + bcol0 + bj * HALF + 4 * n) : (f32x4){0.f, 0.f, 0.f, 0.f};
#pragma unroll
        for (int ai = 0; ai < 2; ++ai)
#pragma unroll
            for (int m = 0; m < 4; ++m) { bf16_t* rowp = base + (size_t)(row0 + ai * HALF + m * 16) * ldc + col0;
#pragma unroll
                for (int bj = 0; bj < 2; ++bj) { f32x4 v0 = acc[ai][bj][m][0] + bv[bj][0], v1 = acc[ai][bj][m][1] + bv[bj][1];
                    if (ACT == 1) { f32x2 a = gelu_pk((f32x2){v0[0], v0[1]}), b = gelu_pk((f32x2){v0[2], v0[3]}), c = gelu_pk((f32x2){v1[0], v1[1]}), d = gelu_pk((f32x2){v1[2], v1[3]});
                        v0 = (f32x4){a.x, a.y, b.x, b.y}; v1 = (f32x4){c.x, c.y, d.x, d.y}; }
                    v0 = v0 * sc; v1 = v1 * sc; u32x4 w; if (f16out) { w.x = cvt_pk_f16(v0[0], v0[1]); w.y = cvt_pk_f16(v0[2], v0[3]); w.z = cvt_pk_f16(v1[0], v1[1]); w.w = cvt_pk_f16(v1[2], v1[3]); } else { w.x = cvt_pk_bf16(v0[0], v0[1]); w.y = cvt_pk_bf16(v0[2], v0[3]); w.z = cvt_pk_bf16(v1[0], v1[1]); w.w = cvt_pk_bf16(v1[2], v1[3]); }
                    *(u32x4*)(rowp + bj * cs) = w; } }
    }
};

struct SliceOrder {
    int nM, nN, nS, kslice, G, c;
    __device__ __forceinline__ bool next(int i, Unit& u) const { const long L = (long)i * G + c; if (L >= (long)nM * nN * nS) return false; int w = (int)L; u.kofs = (w % nS) * kslice; w /= nS; u.pn = w % nN; u.pm = w / nN; return true; }
    __device__ __forceinline__ void a_ready(const Unit&) const {}
    __device__ __forceinline__ void done(const Unit&) const {}
};
struct EpiF32Slab {
    static constexpr bool PERM = false, AFTER_DRAIN = false;
    float* O; int ldc; int kslice; size_t slab;
    __device__ __forceinline__ void operator()(const f32x4 (&acc)[2][2][4][2], const Unit& u, int wr, int wc, int fr, int fq) const {
        int fr_ = fr, fq_ = fq; asm volatile("" : "+v"(fr_), "+v"(fq_));
        float* base = O + (size_t)(u.kofs / kslice) * slab; const int col0 = u.pn * BM + wc * 32 + 4 * fq_;
#pragma unroll
        for (int ai = 0; ai < 2; ++ai)
#pragma unroll
            for (int m = 0; m < 4; ++m) { float* rowp = base + (size_t)(u.pm * BM + ai * HALF + wr * 64 + m * 16 + fr_) * ldc + col0;
#pragma unroll
                for (int bj = 0; bj < 2; ++bj)
#pragma unroll
                    for (int n = 0; n < 2; ++n) *(f32x4*)(rowp + bj * HALF + n * 16) = acc[ai][bj][m][n]; }
    }
};
template <class Epi, class Sched, bool ALIGN_EPI = false, bool SP2 = false>
__device__ __forceinline__ void gemm_phase(PG8_LAS unsigned char* lds, const Gemm g, const Sched& S, const Epi& E) {
    int tid_ = threadIdx.x; asm volatile("" : "+v"(tid_)); const int tid = tid_, wid = __builtin_amdgcn_readfirstlane(tid >> 6), lane = tid & 63, wr = wid >> 2, wc = wid & 3, fr = lane & 15, fq = lane >> 4;
    const int K = g.K, nt = K / BK, LD = g.ld ? g.ld : g.K, LDA = g.lda ? g.lda : LD;
    unsigned voffA[2], voffB[2];
#pragma unroll
    for (int i = 0; i < 2; ++i) { int R, C; stage_rc(tid * 16 + i * 8192, R, C); const int Rb = Epi::PERM ? ((R & ~31) + perm32(R & 31)) : R;
        voffA[i] = (unsigned)(R * LDA + C) * 2u; voffB[i] = (unsigned)(Rb * LD + C) * 2u; }
    const size_t kstep = (size_t)(BK * 2);
    const size_t hstep = (size_t)HALF * LD * 2;
    const size_t tstep = 2 * hstep;
    const size_t kstepA = g.kstepA ? g.kstepA : kstep, hstepA = (size_t)HALF * LDA * 2, tstepA = 2 * hstepA;
    const unsigned ldsw = (unsigned)wid * 1024u;
    const int aoff = lds_byte(wr * 64 + fr, fq * 8), boff = lds_byte(wc * 32 + fr, fq * 8);
#define PG8_SA(b, h) (((b) * 2 + (h)) * HTB)
#define PG8_SB(b, h) ((4 + (b) * 2 + (h)) * HTB)
#define PG8_STAGE(bufoff, gbase, voff) do { _Pragma("unroll") for (int _i = 0; _i < 2; ++_i) \
        __builtin_amdgcn_global_load_lds((const unsigned*)((const char*)(gbase) + (voff)[_i]), (PG8_LAS unsigned*)(lds + (bufoff) + ldsw + _i * 8192), 16, 0, 0); } while (0)
#define PG8_LDA(dst, b, h) do { _Pragma("unroll") for (int m = 0; m < 4; ++m) _Pragma("unroll") for (int k = 0; k < 2; ++k) dst[m][k] = *(const PG8_LAS bf16x8*)(lds + PG8_SA(b, h) + aoff + m * 2048 + k * 1024); } while (0)
#define PG8_LDB(dst, b, h) do { _Pragma("unroll") for (int n = 0; n < 2; ++n) _Pragma("unroll") for (int k = 0; k < 2; ++k) dst[n][k] = *(const PG8_LAS bf16x8*)(lds + PG8_SB(b, h) + boff + n * 2048 + k * 1024); } while (0)
#define PG8_MMA(ai, bj, At, Bt) do { __builtin_amdgcn_s_setprio(1); _Pragma("unroll") for (int m = 0; m < 4; ++m) _Pragma("unroll") for (int n = 0; n < 2; ++n) _Pragma("unroll") for (int k = 0; k < 2; ++k) \
        acc[ai][bj][m][n] = __builtin_amdgcn_mfma_f32_16x16x32_bf16(Bt[n][k], At[m][k], acc[ai][bj][m][n], 0, 0, 0); __builtin_amdgcn_s_setprio(0); } while (0)
#define PG8_WAIT_V(n) asm volatile("s_waitcnt vmcnt(" #n ")" ::: "memory")
#define PG8_WAIT_L(n) asm volatile("s_waitcnt lgkmcnt(" #n ")" ::: "memory")
#define PG8_BAR __builtin_amdgcn_s_barrier()
#define PG8_SCHED __builtin_amdgcn_sched_barrier(0)
    Unit cur, nxt; int ui = 0;
    if (!S.next(0, cur)) return;
    f32x4 acc[2][2][4][2];
#pragma unroll
    for (int a = 0; a < 2; ++a)
#pragma unroll
        for (int b = 0; b < 2; ++b)
#pragma unroll
            for (int m = 0; m < 4; ++m)
#pragma unroll
                for (int n = 0; n < 2; ++n) acc[a][b][m][n] = (f32x4){0.f, 0.f, 0.f, 0.f};
    bf16x8 At[4][2], B0[2][2], B1[2][2];
    const char* cA = (const char*)g.A + (size_t)cur.pm * tstepA + (g.kstepA ? (size_t)(cur.kofs >> 6) * kstepA : (size_t)cur.kofs * 2); const char* cB = (const char*)g.Bt + (size_t)cur.pn * tstep + (size_t)cur.kofs * 2;
    S.a_ready(cur);
    if constexpr (SP2) {
        PG8_STAGE(PG8_SB(0, 0), cB, voffB); PG8_STAGE(PG8_SB(0, 1), cB + hstep, voffB); PG8_STAGE(PG8_SA(0, 0), cA, voffA); PG8_STAGE(PG8_SA(0, 1), cA + hstepA, voffA);
        if (wr == 1) PG8_BAR;
        PG8_WAIT_V(2); PG8_BAR;
        PG8_STAGE(PG8_SB(1, 0), cB + kstep, voffB); PG8_STAGE(PG8_SA(1, 0), cA + kstepA, voffA); PG8_STAGE(PG8_SB(1, 1), cB + hstep + kstep, voffB);
        PG8_WAIT_V(6); PG8_BAR;
    } else {
        PG8_STAGE(PG8_SB(0, 0), cB, voffB); PG8_STAGE(PG8_SA(0, 0), cA, voffA); PG8_STAGE(PG8_SB(0, 1), cB + hstep, voffB); PG8_STAGE(PG8_SA(0, 1), cA + hstepA, voffA);
        if (wr == 1) PG8_BAR;
        PG8_WAIT_V(4); PG8_BAR;
        PG8_STAGE(PG8_SB(1, 0), cB + kstep, voffB); PG8_STAGE(PG8_SA(1, 0), cA + kstepA, voffA); PG8_STAGE(PG8_SB(1, 1), cB + hstep + kstep, voffB);
        PG8_WAIT_V(6); PG8_BAR;
    }
    for (;;) {
        const bool has_next = S.next(ui + 1, nxt);
        const char* nA = has_next ? (const char*)g.A + (size_t)nxt.pm * tstepA + (g.kstepA ? (size_t)(nxt.kofs >> 6) * kstepA : (size_t)nxt.kofs * 2) : cA; const char* nB = has_next ? (const char*)g.Bt + (size_t)nxt.pn * tstep + (size_t)nxt.kofs * 2 : cB;
        for (int t = 0; t < nt; t += 2) {
            const bool last = (t == nt - 2);
            const char* a1 = cA + (size_t)(t + 1) * kstepA;
            const char* a2 = last ? nA : cA + (size_t)(t + 2) * kstepA; const char* b2 = last ? nB : cB + (size_t)(t + 2) * kstep;
            const char* a3 = a2 + kstepA; const char* b3 = b2 + kstep;
            if (last && has_next) S.a_ready(nxt);
            if constexpr (SP2) {
            PG8_LDB(B0, 0, 0); PG8_LDB(B1, 0, 1); PG8_SCHED; PG8_LDA(At, 0, 0); PG8_STAGE(PG8_SA(1, 1), a1 + hstepA, voffA);
            PG8_WAIT_V(8); PG8_WAIT_L(0); PG8_BAR; PG8_MMA(0, 0, At, B0); PG8_MMA(0, 1, At, B1); PG8_BAR; PG8_SCHED;
            PG8_LDA(At, 0, 1); PG8_STAGE(PG8_SB(0, 0), b2, voffB); PG8_STAGE(PG8_SB(0, 1), b2 + hstep, voffB); PG8_STAGE(PG8_SA(0, 0), a2, voffA);
            PG8_WAIT_V(8); PG8_WAIT_L(0); PG8_BAR; PG8_MMA(1, 0, At, B0); PG8_MMA(1, 1, At, B1); PG8_BAR; PG8_SCHED;
            PG8_LDB(B0, 1, 0); PG8_LDB(B1, 1, 1); PG8_SCHED; PG8_LDA(At, 1, 0); PG8_STAGE(PG8_SA(0, 1), a2 + hstepA, voffA);
            PG8_WAIT_V(8); PG8_WAIT_L(0); PG8_BAR; PG8_MMA(0, 0, At, B0); PG8_MMA(0, 1, At, B1); PG8_BAR; PG8_SCHED;
            PG8_LDA(At, 1, 1); PG8_STAGE(PG8_SB(1, 0), b3, voffB); PG8_STAGE(PG8_SB(1, 1), b3 + hstep, voffB); PG8_STAGE(PG8_SA(1, 0), a3, voffA);
            PG8_WAIT_V(8); PG8_WAIT_L(0); PG8_BAR; PG8_MMA(1, 0, At, B0); PG8_MMA(1, 1, At, B1); PG8_BAR; PG8_SCHED;
            } else {
            PG8_LDB(B0, 0, 0); PG8_SCHED; PG8_LDA(At, 0, 0); PG8_STAGE(PG8_SA(1, 1), a1 + hstepA, voffA);
            PG8_WAIT_L(8); PG8_BAR; PG8_WAIT_L(0); PG8_MMA(0, 0, At, B0); PG8_BAR; PG8_SCHED;
            PG8_LDB(B1, 0, 1); PG8_STAGE(PG8_SB(0, 0), b2, voffB);
            PG8_BAR; PG8_WAIT_L(0); PG8_MMA(0, 1, At, B1); PG8_BAR;
            PG8_LDA(At, 0, 1); PG8_STAGE(PG8_SA(0, 0), a2, voffA);
            PG8_BAR; PG8_WAIT_L(0); PG8_MMA(1, 0, At, B0); PG8_BAR; PG8_SCHED;
            PG8_STAGE(PG8_SB(0, 1), b2 + hstep, voffB);
            PG8_WAIT_V(6); PG8_BAR; PG8_MMA(1, 1, At, B1); PG8_BAR;
            PG8_LDB(B0, 1, 0); PG8_SCHED; PG8_LDA(At, 1, 0); PG8_STAGE(PG8_SA(0, 1), a2 + hstepA, voffA);
            PG8_WAIT_L(8); PG8_BAR; PG8_WAIT_L(0); PG8_MMA(0, 0, At, B0); PG8_BAR; PG8_SCHED;
            PG8_LDB(B1, 1, 1); PG8_STAGE(PG8_SB(1, 0), b3, voffB);
            PG8_BAR; PG8_WAIT_L(0); PG8_MMA(0, 1, At, B1); PG8_BAR;
            PG8_LDA(At, 1, 1); PG8_STAGE(PG8_SA(1, 0), a3, voffA);
            PG8_BAR; PG8_WAIT_L(0); PG8_MMA(1, 0, At, B0); PG8_BAR; PG8_SCHED;
            PG8_STAGE(PG8_SB(1, 1), b3 + hstep, voffB);
            PG8_WAIT_V(6); PG8_BAR; PG8_MMA(1, 1, At, B1); PG8_BAR;
            }
        }
        if constexpr (ALIGN_EPI) { if (wr == 0) PG8_BAR; }
        if constexpr (!Epi::AFTER_DRAIN) { E(acc, cur, wr, wc, fr, fq); S.done(cur); }
        if (!has_next) break;
#pragma unroll
        for (int a = 0; a < 2; ++a)
#pragma unroll
            for (int b = 0; b < 2; ++b)
#pragma unroll
                for (int m = 0; m < 4; ++m)
#pragma unroll
                    for (int n = 0; n < 2; ++n) acc[a][b][m][n] = (f32x4){0.f, 0.f, 0.f, 0.f};
        cur = nxt; cA = nA; cB = nB; ++ui;
        if constexpr (ALIGN_EPI) { if (wr == 1) PG8_BAR; }
    }
    PG8_WAIT_V(0);
    if constexpr (!ALIGN_EPI) { if (wr == 0) PG8_BAR; }
    PG8_BAR;
    if constexpr (Epi::AFTER_DRAIN) { E.fused(acc, cur, wr, wc, fr, fq, lds, wid, lane); S.done(cur); }
#undef PG8_SA
#undef PG8_SB
#undef PG8_STAGE
#undef PG8_LDA
#undef PG8_LDB
#undef PG8_MMA
#undef PG8_WAIT_V
#undef PG8_WAIT_L
#undef PG8_BAR
#undef PG8_SCHED
}
}
constexpr int NWAVES = 8, NTHR = 512;
constexpr int DM = 1024, NB = 4, SEQ = 8192, CTXL = 256;
constexpr int RL = NB * SEQ, RC = NB * CTXL, RT = RL + RC;
constexpr int NIN_SRC = 2064, NIN = 2304;
constexpr int UC_Z = 0, UC_XBC = 512, UC_P = 1536, UC_Q = 1792, UC_POOL = 2048;
constexpr int SRC_DT = 1536, SRC_FNET = 1552, SRC_POOL = 1808;
constexpr int DFF = 2816, NUP = 5632, NHALF = 1408;
constexpr float LN_EPS = 1e-6f, ALPHA = 1.41421356237f;
constexpr int NLAYER = 2;

constexpr size_t MiB = 1u << 20;
constexpr size_t WS_CTL = 0, CTL_ZERO_BYTES = 1 * MiB;
constexpr size_t WS_ADA = 1 * MiB;
constexpr size_t WS_F = 2 * MiB;
constexpr size_t WS_WA = 2 * MiB + 512 * 1024, WS_WB = WS_WA + 32768, WS_TW = WS_WB + 65536;
constexpr size_t WS_WDT = WS_TW + 65536;
constexpr size_t WS_DTRAW = 3 * MiB;
constexpr size_t WS_WIN = 6 * MiB;
constexpr size_t WS_WOUT = 15 * MiB;
constexpr size_t WS_WUP = 19 * MiB;
constexpr size_t WS_WDOWN = 41 * MiB;
constexpr size_t WS_XCTX = 52 * MiB;
constexpr size_t WS_H = 56 * MiB;
constexpr size_t WS_SH = 122 * MiB;
constexpr size_t WS_U = WS_SH;
constexpr size_t WS_CONCAT = WS_SH + 149 * MiB;
constexpr size_t WS_SST = WS_SH + 215 * MiB;
constexpr size_t WS_HIN = WS_SH + 281 * MiB;
constexpr size_t WS_YFFT = WS_SH + 347 * MiB;
constexpr size_t WS_DEC = 5 * MiB + 512 * 1024;
constexpr size_t WS_MIX = WS_SH;
constexpr size_t WS_AH = WS_SH;
constexpr size_t WS_G = WS_SH + 193 * MiB;
constexpr size_t WS_SLAB = WS_SH + 68 * MiB;
constexpr size_t WS_FFNO = WS_SH;
constexpr size_t WS_END = 512 * MiB;
static_assert(WS_YFFT + 32 * MiB <= WS_END && WS_G + 182 * MiB <= WS_END, "ws map");
constexpr int CW_TMO = 0, CW_CODE = 1, CW_BAR = 4096;

constexpr int RING_BYTES = 131072, LDSCTL_OFF = 152576, MISC_OFF = LDSCTL_OFF + 320, LDS_BYTES = 156672;
#define GAS __attribute__((address_space(1)))
#define LAS __attribute__((address_space(3)))
typedef unsigned short bf16;
typedef unsigned v4u __attribute__((ext_vector_type(4)));
typedef float f32x4 __attribute__((ext_vector_type(4)));
typedef short bf16x8 __attribute__((ext_vector_type(8)));
typedef GAS unsigned gu32;
typedef GAS unsigned long long gu64;
#define RLX_AGENT __ATOMIC_RELAXED, __HIP_MEMORY_SCOPE_AGENT
#define LDS_WAIT() asm volatile("s_waitcnt lgkmcnt(0)" ::: "memory")
#define VM_WAIT() asm volatile("s_waitcnt vmcnt(0)" ::: "memory")
__device__ __forceinline__ unsigned long long rt() { return __builtin_amdgcn_s_memrealtime(); }
typedef __bf16 hwbf2 __attribute__((ext_vector_type(2)));
typedef float hwf2 __attribute__((ext_vector_type(2)));
__device__ __forceinline__ unsigned pk2(float lo, float hi) { const hwf2 v = {lo, hi}; return __builtin_bit_cast(unsigned, __builtin_convertvector(v, hwbf2)); }
__device__ __forceinline__ unsigned f2bf(float f) { return pk2(f, 0.f) & 0xffffu; }

#define XB_TMO      128
#define XB_XCNT(j)  (256  + 64 * (j))
#define XB_XSUB(j)  (1280 + 64 * (j))
#define XB_XGEN(j)  (2304 + 64 * (j))
#define XB_TOP      3328
#define XB_TOPGEN   3392
#define XCD_BAR_WORDS 3456
#define XB_SPIN_CAP (1u << 18)

__device__ __forceinline__ unsigned xb_ld(unsigned* p)              { return __hip_atomic_load(p, __ATOMIC_RELAXED, __HIP_MEMORY_SCOPE_AGENT); }
__device__ __forceinline__ unsigned xb_add(unsigned* p, unsigned v) { return __hip_atomic_fetch_add(p, v, __ATOMIC_RELAXED, __HIP_MEMORY_SCOPE_AGENT); }
__device__ __forceinline__ unsigned xb_xcc_id() { return (unsigned)__builtin_amdgcn_s_getreg((3 << 11) | 20) & 0xFu; }
#define XB_SPIN(cond, bar) do { unsigned _sp = 0; while (cond) { __builtin_amdgcn_s_sleep(1); \
    if ((++_sp & 255u) == 0u) { if (xb_ld(&(bar)[XB_TMO])) break; if (_sp > XB_SPIN_CAP) { atomicAdd(&(bar)[XB_TMO], 1u); break; } } } } while (0)

struct XcdBarrier {
    unsigned* bar; unsigned x;
    volatile LAS unsigned* st;
};

__device__ __forceinline__ XcdBarrier xcd_barrier_post(unsigned* bar, volatile LAS unsigned* st) {
    XcdBarrier b; b.bar = bar; b.x = xb_xcc_id(); b.st = st;
    if (threadIdx.x == 0) (void)xb_add(&bar[XB_XCNT(b.x)], 1u);
    return b;
}
__device__ __forceinline__ void xcd_barrier_complete(unsigned* bar, unsigned x, unsigned& nloc, unsigned& nx) {
    const unsigned G = gridDim.x * gridDim.y * gridDim.z;
    unsigned sum, cnt, mine, sp = 0u;
    for (;;) {
        sum = 0u; cnt = 0u; mine = 0u;
#pragma unroll
        for (unsigned j = 0; j < 16; ++j) { const unsigned c = xb_ld(&bar[XB_XCNT(j)]); sum += c; cnt += (c > 0u) ? 1u : 0u; mine = (j == x) ? c : mine; }
        if (sum == G) break;
        __builtin_amdgcn_s_sleep(1);
        if ((++sp & 255u) == 0u) { if (xb_ld(&bar[XB_TMO])) break; if (sp > XB_SPIN_CAP) { atomicAdd(&bar[XB_TMO], 1u); break; } }
    }
    nloc = mine > 0u ? mine : 1u; nx = cnt > 0u ? cnt : 1u;
}

__device__ __forceinline__ void xcd_barrier(const XcdBarrier& b) {
    asm volatile("s_waitcnt vmcnt(0)" ::: "memory");
    __syncthreads();
    if (threadIdx.x == 0) {
        unsigned* bar = b.bar;
        __builtin_amdgcn_s_waitcnt(0);
        unsigned nloc = b.st[0], nx = b.st[1];
        if (nloc == 0u) { xcd_barrier_complete(bar, b.x, nloc, nx); b.st[0] = nloc; b.st[1] = nx; }
        const unsigned old = xb_add(&bar[XB_XSUB(b.x)], 1u);
        const unsigned gen = old / nloc;
        if (old + 1u == (gen + 1u) * nloc) {
            __builtin_amdgcn_fence(__ATOMIC_RELEASE, "agent");
            asm volatile("s_waitcnt vmcnt(0)" ::: "memory");
            const unsigned og = xb_add(&bar[XB_TOP], 1u);
            const unsigned tg = og / nx;
            if (og + 1u == (tg + 1u) * nx) {
#pragma unroll
                for (unsigned j = 0; j < 16; ++j) xb_add(&bar[XB_XGEN(j)], 1u);
            }
            XB_SPIN(xb_ld(&bar[XB_XGEN(b.x)]) == gen, bar);
            __builtin_amdgcn_fence(__ATOMIC_ACQUIRE, "agent");
            asm volatile("s_waitcnt vmcnt(0)" ::: "memory");
        } else {
            XB_SPIN(xb_ld(&bar[XB_XGEN(b.x)]) == gen, bar);
            __builtin_amdgcn_fence(__ATOMIC_ACQUIRE, "agent");
            asm volatile("s_waitcnt vmcnt(0)" ::: "memory");
        }
    }
    __syncthreads();
}
typedef unsigned u32x2 __attribute__((ext_vector_type(2)));
__device__ __forceinline__ float bf2f(unsigned short b) { return __uint_as_float((unsigned)b << 16); }
__device__ __forceinline__ float bflo(unsigned w) { return __uint_as_float(w << 16); }
__device__ __forceinline__ float bfhi(unsigned w) { return __uint_as_float(w & 0xffff0000u); }
__device__ __forceinline__ float silu_f(float x) { return x * __builtin_amdgcn_rcpf(1.f + __expf(-x)); }
__device__ __forceinline__ float gelu_tanh_f(float x) { const float t = x * x, u = __builtin_fmaf(t, -0.10294324f, -2.30220819f); return x * __builtin_amdgcn_rcpf(1.f + __builtin_amdgcn_exp2f(x * u)); }
__device__ __forceinline__ float softplus_f(float x) { return x > 20.f ? x : log1pf(expf(x)); }
#define DPP_ADD(v, ctrl) ((v) + __builtin_bit_cast(float, __builtin_amdgcn_update_dpp(0, __builtin_bit_cast(int, (v)), (ctrl), 0xf, 0xf, false)))
__device__ __forceinline__ float rdl(float v, const int l) { return __builtin_bit_cast(float, __builtin_amdgcn_readlane(__builtin_bit_cast(int, v), l)); }
__device__ __forceinline__ float wave_sum(float v) {
    v = DPP_ADD(v, 0xB1); v = DPP_ADD(v, 0x4E); v = DPP_ADD(v, 0x141); v = DPP_ADD(v, 0x140);
    return (rdl(v, 0) + rdl(v, 16)) + (rdl(v, 32) + rdl(v, 48));
}
__device__ __forceinline__ void unpack8(const v4u w, float (&f)[8]) { f[0] = bflo(w.x); f[1] = bfhi(w.x); f[2] = bflo(w.y); f[3] = bfhi(w.y); f[4] = bflo(w.z); f[5] = bfhi(w.z); f[6] = bflo(w.w); f[7] = bfhi(w.w); }
__device__ __forceinline__ v4u pack8(const float (&f)[8]) { v4u w; w.x = pk2(f[0], f[1]); w.y = pk2(f[2], f[3]); w.z = pk2(f[4], f[5]); w.w = pk2(f[6], f[7]); return w; }

struct Frame {
    LAS unsigned char* lds; volatile LAS unsigned* MISC; gu32* ctl;
    int G;
    float* out;
    unsigned char* ws;
};
#define WSP(T, off) ((T*)(F.ws + (off)))
#define PH_IDS() int tid = threadIdx.x; asm volatile("" : "+v"(tid)); const int lane = tid & 63; const int wave = __builtin_amdgcn_readfirstlane(tid >> 6); int bid = blockIdx.x; asm volatile("" : "+s"(bid)); (void)lane; (void)wave; (void)bid;
__device__ __forceinline__ const float* inp_ptr(int i) { asm volatile("" : "+s"(i)); return ((const float* const __attribute__((address_space(4)))*)__builtin_amdgcn_kernarg_segment_ptr())[i]; }
enum { I_x = 0, I_c, I_ctx, I_c_ctx, I_w_ada, I_b_ada, I_w_in, I_ssd_conv_w, I_ssd_conv_b, I_ssd_dt_bias, I_ssd_a_log, I_ssd_d, I_ssd_norm_w, I_fnet_w, I_pool_w, I_pool_scale, I_w_out, I_ln1_g, I_ln1_b, I_ffn_w_up, I_ffn_conv_w, I_ffn_conv_b, I_ffn_w_down, I_ln2_g, I_ln2_b };

struct RowInfo { int pos, L, v, base; };
__device__ __forceinline__ RowInfo row_info(int row) {
    RowInfo r;
    if (row < RL) { r.pos = row & (SEQ - 1); r.L = SEQ; r.v = row >> 13; r.base = row & ~(SEQ - 1); }
    else { const int rr = row - RL; r.pos = rr & (CTXL - 1); r.L = CTXL; r.v = 4; r.base = RL + (rr & ~(CTXL - 1)); }
    return r;
}
__device__ __forceinline__ float* stream_row(Frame& F, int row) { return row < RL ? F.out + (size_t)row * DM : WSP(float, WS_XCTX) + (size_t)(row - RL) * DM; }
__device__ __forceinline__ const float* input_row(Frame& F, int row) { return row < RL ? inp_ptr(I_x) + (size_t)row * DM : inp_ptr(I_ctx) + (size_t)(row - RL) * DM; }

__device__ __forceinline__ void fft_tables(Frame& F, const int tid, const int bid);
struct TrItem { const float* W; int ldw; bf16* WT; int ldt; };
__device__ __forceinline__ TrItem tr_decode(Frame& F, int it) {
    constexpr int I_IN = 48 * 16, I_OUT = 32 * 16, I_UP = 176 * 16, I_DN = 32 * 44, I_L = I_IN + I_OUT + I_UP + I_DN;
    const int l = it / I_L; int r = it % I_L;
    if (r < I_IN) { const int kb = r / 48, nb = r % 48;
        return TrItem{inp_ptr(I_w_in) + (size_t)l * DM * NIN_SRC + (size_t)(64 * kb) * NIN_SRC + 32 * nb, NIN_SRC, WSP(bf16, WS_WIN) + (size_t)l * NIN * DM + (size_t)(32 * nb) * DM + 64 * kb, DM}; }
    r -= I_IN;
    if (r < I_OUT) { const int kb = r / 32, nb = r % 32;
        return TrItem{inp_ptr(I_w_out) + (size_t)l * DM * DM + (size_t)(64 * kb) * DM + 32 * nb, DM, WSP(bf16, WS_WOUT) + (size_t)l * DM * DM + (size_t)(32 * nb) * DM + 64 * kb, DM}; }
    r -= I_OUT;
    if (r < I_UP) { const int kb = r / 176, nb = r % 176, ti = nb >> 3, w8 = nb & 7; const int scol = ((w8 & 2) ? DFF : 0) + 128 * ti + 64 * (w8 >> 2) + 32 * (w8 & 1);
        return TrItem{inp_ptr(I_ffn_w_up) + (size_t)l * DM * NUP + (size_t)(64 * kb) * NUP + scol, NUP, WSP(bf16, WS_WUP) + (size_t)l * NUP * DM + (size_t)(32 * nb) * DM + 64 * kb, DM}; }
    r -= I_UP;
    { const int kb = r / 32, nb = r % 32;
        return TrItem{inp_ptr(I_ffn_w_down) + (size_t)l * DFF * DM + (size_t)(64 * kb) * DM + 32 * nb, DM, WSP(bf16, WS_WDOWN) + (size_t)l * DM * DFF + (size_t)(32 * nb) * DFF + 64 * kb, DFF}; }
}
__device__ __forceinline__ void tr_load(const TrItem d, const int lane, f32x4 (&rg)[8]) {
#pragma unroll
    for (int i = 0; i < 8; ++i) { const int v = lane + 64 * i; rg[i] = *(const f32x4*)(d.W + (size_t)(v >> 3) * d.ldw + 4 * (v & 7)); }
}
__device__ __forceinline__ void p0a(Frame& F) {
    PH_IDS();
    {
        LAS float* sc = (LAS float*)F.lds; LAS float* red = (LAS float*)(F.lds + 20480);
        bool first = true;
        for (int unit = bid; unit < 192; unit += F.G) {
            if (first) { for (int i = tid; i < 5 * 1024; i += NTHR) { const int v = i >> 10, k = i & 1023; const float cv = v < 4 ? inp_ptr(I_c)[v * 1024 + k] : inp_ptr(I_c_ctx)[k]; sc[i] = cv / (1.f + expf(-cv)); } __syncthreads(); first = false; }
            const int l = unit / 96, jg = unit % 96;
            const float* w = inp_ptr(I_w_ada) + (size_t)l * 1024 * 6144 + jg * 64 + lane;
            float acc[5] = {0.f, 0.f, 0.f, 0.f, 0.f};
#pragma unroll 64
            for (int kk = 0; kk < 128; ++kk) { const int k = wave * 128 + kk; const float wv = w[(size_t)k * 6144];
#pragma unroll
                for (int v = 0; v < 5; ++v) acc[v] += sc[v * 1024 + k] * wv; }
#pragma unroll
            for (int v = 0; v < 5; ++v) red[(wave * 5 + v) * 64 + lane] = acc[v];
            __syncthreads();
            if (tid < 320) { const int v = tid >> 6, ln = tid & 63; float s = inp_ptr(I_b_ada)[l * 6144 + jg * 64 + ln];
#pragma unroll
                for (int w8 = 0; w8 < 8; ++w8) s += red[(w8 * 5 + v) * 64 + ln];
                WSP(float, WS_ADA)[(l * 5 + v) * 6144 + jg * 64 + ln] = s; }
            __syncthreads();
        }
        __syncthreads();
    }
    {
        LAS float* scr = (LAS float*)(F.lds + wave * 16384);
        const int gw = bid * NWAVES + wave, NGW = F.G * NWAVES;
        constexpr int NIT = NLAYER * (48 * 16 + 32 * 16 + 176 * 16 + 32 * 44);
        f32x4 rg[8];
        if (gw < NIT) tr_load(tr_decode(F, gw), lane, rg);
        for (int it = gw; it < NIT; it += NGW) {
            const TrItem d = tr_decode(F, it);
#pragma unroll
            for (int i = 0; i < 8; ++i) { const int v = lane + 64 * i; LAS float* s = scr + (v >> 3) * 33 + 4 * (v & 7); s[0] = rg[i].x; s[1] = rg[i].y; s[2] = rg[i].z; s[3] = rg[i].w; }
            LDS_WAIT(); asm volatile("" ::: "memory");
            if (it + NGW < NIT) tr_load(tr_decode(F, it + NGW), lane, rg);
            const int c = lane & 7;
#pragma unroll
            for (int j = 0; j < 4; ++j) { const int n = (lane >> 3) + 8 * j; const LAS float* s = scr + (8 * c) * 33 + n;
                v4u o; o.x = pk2(s[0 * 33], s[1 * 33]); o.y = pk2(s[2 * 33], s[3 * 33]); o.z = pk2(s[4 * 33], s[5 * 33]); o.w = pk2(s[6 * 33], s[7 * 33]);
                *(GAS v4u*)(d.WT + (size_t)n * d.ldt + 8 * c) = o; }
            LDS_WAIT(); asm volatile("" ::: "memory");
        }
    }
    {
        LAS float* tw = (LAS float*)F.lds;
        __syncthreads();
        if (tid < 64) { tw[tid] = cospif((float)tid * (1.f / 32.f)); tw[64 + tid] = sinpif((float)tid * (1.f / 32.f)); }
        __syncthreads();
        const int gt = bid * NTHR + tid, NGT = F.G * NTHR;
        for (int it = gt; it < NLAYER * 3 * 4 * 4096; it += NGT) {
            const int d = it & 63, c = (it >> 6) & 63, g = (it >> 12) & 3, wl = it >> 14, which = wl % 3, l = wl / 3;
            float s = 0.f;
            if (which == 2) s = inp_ptr(I_pool_w)[((size_t)(l * 4 + g) * 64 + c) * 64 + d] * inp_ptr(I_pool_scale)[l * 256 + g * 64 + d];
            else { const float* fw = inp_ptr(I_fnet_w) + (size_t)(l * 4 + g) * 4096 + d; const LAS float* tb = tw + (which == 0 ? 0 : 64);
#pragma unroll
                for (int m = 0; m < 64; ++m) s += tb[(c * m) & 63] * fw[m * 64];
                s *= 0.125f; }
            WSP(float, WS_F)[it] = s;
        }
        __syncthreads();
    }
    fft_tables(F, tid, bid);
    {
        const int gt2 = bid * NTHR + tid, NGT2 = F.G * NTHR;
        for (int it = gt2; it < NLAYER * 16 * 1024; it += NGT2) { const int o = it & 15, k = (it >> 4) & 1023, l = it >> 14;
            const float w = inp_ptr(I_w_in)[(size_t)l * DM * NIN_SRC + (size_t)k * NIN_SRC + SRC_DT + o]; const unsigned hi = f2bf(w); const float wl = w - bflo(hi);
            WSP(bf16, WS_WDT)[((size_t)(l * 2 + 0) * 16 + o) * 1024 + k] = (bf16)hi; WSP(bf16, WS_WDT)[((size_t)(l * 2 + 1) * 16 + o) * 1024 + k] = (bf16)f2bf(wl); }
    }
}

__device__ __forceinline__ void ln_normalize(f32x4 (&v)[4]) {
    float s = 0.f;
#pragma unroll
    for (int j = 0; j < 4; ++j) s += (v[j].x + v[j].y) + (v[j].z + v[j].w);
    const float mean = wave_sum(s) * (1.f / DM); float s2 = 0.f;
#pragma unroll
    for (int j = 0; j < 4; ++j) { v[j] = v[j] - mean; s2 += (v[j].x * v[j].x + v[j].y * v[j].y) + (v[j].z * v[j].z + v[j].w * v[j].w); }
    const float rstd = 1.f / sqrtf(wave_sum(s2) * (1.f / DM) + LN_EPS);
#pragma unroll
    for (int j = 0; j < 4; ++j) v[j] = v[j] * rstd;
}
__device__ __forceinline__ void mod_store_dt(Frame& F, const int lane, const f32x4 (&xn)[4], const f32x4 (&shv)[4], const f32x4 (&scv)[4], bf16* hrow, bool do_dt, float* dtrow, const LAS float* wdtT) {
    f32x4 h[4];
#pragma unroll
    for (int j = 0; j < 4; ++j) { h[j] = xn[j] * (scv[j] + 1.f) + shv[j];
        u32x2 w; w.x = pk2(h[j].x, h[j].y); w.y = pk2(h[j].z, h[j].w); *(u32x2*)(hrow + 256 * j + 4 * lane) = w; }
    if (do_dt) {
        float mine = 0.f;
#pragma unroll
        for (int o = 0; o < 16; ++o) { float a = 0.f;
#pragma unroll
            for (int j = 0; j < 4; ++j) { const f32x4 w = *(const LAS f32x4*)(wdtT + o * 1024 + 256 * j + 4 * lane); a += (h[j].x * w.x + h[j].y * w.y) + (h[j].z * w.z + h[j].w * w.w); }
            a = wave_sum(a); if (lane == o) mine = a; }
        if (lane < 16) dtrow[lane] = mine;
    }
}
__device__ __forceinline__ void load_vec4_nt(const float* p, const int lane, f32x4 (&v)[4]) {
#pragma unroll
    for (int j = 0; j < 4; ++j) v[j] = __builtin_nontemporal_load((const f32x4*)(p + 256 * j + 4 * lane));
}
__device__ __forceinline__ void load_vec4(const float* p, const int lane, f32x4 (&v)[4]) {
#pragma unroll
    for (int j = 0; j < 4; ++j) v[j] = *(const f32x4*)(p + 256 * j + 4 * lane);
}
__device__ __forceinline__ void stage_wdt(Frame& F, const int tid, int l, LAS float* wdtT) {
    for (int i = tid; i < 16384; i += NTHR) { const int k = i >> 4, o = i & 15; wdtT[o * 1024 + k] = inp_ptr(I_w_in)[(size_t)l * DM * NIN_SRC + (size_t)k * NIN_SRC + SRC_DT + o]; }
}
__device__ __forceinline__ void p0b(Frame& F) {
    PH_IDS();
    {
        LAS float* scr = (LAS float*)(F.lds + wave * 16384);
        const int gw = bid * NWAVES + wave, NGW = F.G * NWAVES;
        for (int it = gw; it < NLAYER * 3 * 4 * 16 * 2; it += NGW) {
            const int nb2 = it & 1, kb = (it >> 1) & 15, g = (it >> 5) & 3, wl = it >> 7, which = wl % 3, l = wl / 3;
            const int soff = (which == 2 ? SRC_POOL : SRC_FNET) + 64 * g, drow = (which == 0 ? UC_P : which == 1 ? UC_Q : UC_POOL) + 64 * g + 32 * nb2;
            const float* W = inp_ptr(I_w_in) + (size_t)l * DM * NIN_SRC + (size_t)(64 * kb) * NIN_SRC + soff;
#pragma unroll
            for (int i = 0; i < 16; ++i) { const int v = lane + 64 * i; *(LAS f32x4*)(scr + (v >> 4) * 64 + 4 * (v & 15)) = *(const f32x4*)(W + (size_t)(v >> 4) * NIN_SRC + 4 * (v & 15)); }
            LDS_WAIT(); asm volatile("" ::: "memory");
            const float* Fm = WSP(float, WS_F) + (size_t)((l * 3 + which) * 4 + g) * 4096 + 32 * nb2;
            const int d = lane & 31, kh = lane >> 5;
            bf16* orow = WSP(bf16, WS_WIN) + (size_t)l * NIN * DM + (size_t)(drow + d) * DM + 64 * kb + 32 * kh;
            float acc[4][8];
#pragma unroll
            for (int k8 = 0; k8 < 4; ++k8)
#pragma unroll
                for (int q = 0; q < 8; ++q) acc[k8][q] = 0.f;
#pragma unroll 1
            for (int ch = 0; ch < 4; ++ch) {
                float fc[16];
#pragma unroll
                for (int cc = 0; cc < 16; ++cc) fc[cc] = Fm[(16 * ch + cc) * 64 + d];
#pragma unroll
                for (int k8 = 0; k8 < 4; ++k8)
#pragma unroll
                    for (int q = 0; q < 8; ++q) { const LAS float* wr = scr + (32 * kh + 8 * k8 + q) * 64 + 16 * ch; float s = acc[k8][q];
#pragma unroll
                        for (int c4 = 0; c4 < 4; ++c4) { const f32x4 w = *(const LAS f32x4*)(wr + 4 * c4); s += (w.x * fc[4 * c4] + w.y * fc[4 * c4 + 1]) + (w.z * fc[4 * c4 + 2] + w.w * fc[4 * c4 + 3]); }
                        acc[k8][q] = s; }
            }
#pragma unroll
            for (int k8 = 0; k8 < 4; ++k8) *(GAS v4u*)(orow + 8 * k8) = pack8(acc[k8]);
            LDS_WAIT(); asm volatile("" ::: "memory");
        }
    }
    __syncthreads();
    LAS float* wdtT = (LAS float*)F.lds;
    const int gw = bid * NWAVES + wave, NGW = F.G * NWAVES;
    {
        f32x4 xnx[4], xny[4], xnz[4], shv[4], scv[4]; int cur_v = -1;
        constexpr int NFW = NLAYER * 3 * 4 * 16 * 2, R1 = NFW * 13;
        int rb0, rst, rend;
        if (NGW > NFW && R1 < RT) { if (gw < NFW) { rb0 = gw; rst = NFW; rend = R1; } else { rb0 = R1 + gw - NFW; rst = NGW - NFW; rend = RT; } }
        else { rb0 = gw; rst = NGW; rend = RT; }
        if (rb0 < rend) load_vec4_nt(input_row(F, rb0), lane, xnx);
        if (rb0 + rst < rend) load_vec4_nt(input_row(F, rb0 + rst), lane, xny);
        if (rb0 + 2 * rst < rend) load_vec4_nt(input_row(F, rb0 + 2 * rst), lane, xnz);
        for (int row = rb0; row < rend; row += rst) {
            const RowInfo ri = row_info(row);
            f32x4 v[4];
#pragma unroll
            for (int j = 0; j < 4; ++j) { v[j] = xnx[j]; xnx[j] = xny[j]; xny[j] = xnz[j]; }
            if (row + 3 * rst < rend) load_vec4_nt(input_row(F, row + 3 * rst), lane, xnz);
            if (ri.v != cur_v) { const float* ad = WSP(float, WS_ADA) + (size_t)(0 * 5 + ri.v) * 6144; load_vec4(ad, lane, shv); load_vec4(ad + 1024, lane, scv); cur_v = ri.v; }
            ln_normalize(v);
            mod_store_dt(F, lane, v, shv, scv, WSP(bf16, WS_H) + (size_t)row * DM, false, WSP(float, WS_DTRAW) + (size_t)row * 16, wdtT);
        }
    }
}
typedef _Float16 pn_h2 __attribute__((ext_vector_type(2)));
typedef float pn_f2 __attribute__((ext_vector_type(2)));
__device__ __forceinline__ unsigned pkh2(float a, float b) { return __builtin_bit_cast(unsigned, __builtin_convertvector((pn_f2){a, b}, pn_h2)); }
__device__ __forceinline__ float hlo(unsigned w) { return (float)__builtin_bit_cast(pn_h2, w).x; }
__device__ __forceinline__ float hhi(unsigned w) { return (float)__builtin_bit_cast(pn_h2, w).y; }
template <bool SRC_F32, bool DST_F32>
__device__ __forceinline__ void post_norm_pass(Frame& F, int l, int which, int nrows, const bf16* M) {
    PH_IDS();
    constexpr bool has_next = !DST_F32;
    const bool do_dt = false;
    LAS float* wdtT = (LAS float*)F.lds;
    const float* gam = (which == 0 ? inp_ptr(I_ln1_g) : inp_ptr(I_ln2_g)) + l * DM; const float* bet = (which == 0 ? inp_ptr(I_ln1_b) : inp_ptr(I_ln2_b)) + l * DM;
    const int gw = bid * NWAVES + wave, NGW = F.G * NWAVES;
    f32x4 xn[4], xn2[4]; u32x2 hn[4], hn2[4], mn[4], mn2[4];
    f32x4 gmv[4], btv[4], gtv[4], shv[4], scv[4]; int cur_v = -1;
    load_vec4(gam, lane, gmv); load_vec4(bet, lane, btv);
    const unsigned char* sbase = (const unsigned char*)F.out;
#define PN_LOAD(xd, hd, md, rr) do { const int r_ = (rr); if (r_ < nrows) { const bf16* mi = M + (size_t)r_ * DM; \
        if constexpr (SRC_F32) { const float* xi = input_row(F, r_); _Pragma("unroll") for (int j = 0; j < 4; ++j) xd[j] = __builtin_nontemporal_load((const f32x4*)(xi + 256 * j + 4 * lane)); } \
        else { const unsigned char* xi = sbase + (size_t)r_ * 4096; _Pragma("unroll") for (int j = 0; j < 4; ++j) hd[j] = __builtin_nontemporal_load((const u32x2*)(xi + 512 * j + 8 * lane)); } \
        _Pragma("unroll") for (int j = 0; j < 4; ++j) md[j] = __builtin_nontemporal_load((const u32x2*)(mi + 256 * j + 4 * lane)); } } while (0)
    PN_LOAD(xn, hn, mn, gw); PN_LOAD(xn2, hn2, mn2, gw + NGW);
    for (int row = gw; row < nrows; row += NGW) {
        const RowInfo ri = row_info(row);
        f32x4 xc[4]; u32x2 mc[4];
#pragma unroll
        for (int j = 0; j < 4; ++j) {
            if constexpr (SRC_F32) { xc[j] = xn[j]; xn[j] = xn2[j]; }
            else { const u32x2 hw = hn[j]; xc[j] = (f32x4){hlo(hw.x), hhi(hw.x), hlo(hw.y), hhi(hw.y)}; hn[j] = hn2[j]; }
            mc[j] = mn[j]; mn[j] = mn2[j]; }
        PN_LOAD(xn2, hn2, mn2, row + 2 * NGW);
        if (ri.v != cur_v) { const float* ad = WSP(float, WS_ADA) + (size_t)(l * 5 + ri.v) * 6144; load_vec4(ad + (which == 0 ? 2048 : 5120), lane, gtv);
            if (has_next) { const float* ad2 = (which == 0) ? ad + 3072 : WSP(float, WS_ADA) + (size_t)((l + 1) * 5 + ri.v) * 6144; load_vec4(ad2, lane, shv); load_vec4(ad2 + 1024, lane, scv); }
            cur_v = ri.v; }
        f32x4 v[4];
#pragma unroll
        for (int j = 0; j < 4; ++j) { const f32x4 xv = xc[j], gv = gtv[j]; const u32x2 mw = mc[j];
            v[j].x = ALPHA * xv.x + gv.x * bflo(mw.x); v[j].y = ALPHA * xv.y + gv.y * bfhi(mw.x); v[j].z = ALPHA * xv.z + gv.z * bflo(mw.y); v[j].w = ALPHA * xv.w + gv.w * bfhi(mw.y); }
        ln_normalize(v);
        if constexpr (DST_F32) { float* xout = F.out + (size_t)row * DM;
#pragma unroll
            for (int j = 0; j < 4; ++j) { v[j] = v[j] * gmv[j] + btv[j]; __builtin_nontemporal_store(v[j], (f32x4*)(xout + 256 * j + 4 * lane)); } }
        else { unsigned char* xout = (unsigned char*)F.out + (size_t)row * 4096;
#pragma unroll
            for (int j = 0; j < 4; ++j) { v[j] = v[j] * gmv[j] + btv[j]; u32x2 w; w.x = pkh2(v[j].x, v[j].y); w.y = pkh2(v[j].z, v[j].w); __builtin_nontemporal_store(w, (u32x2*)(xout + 512 * j + 8 * lane)); } }
        if (has_next) {
            ln_normalize(v);
            mod_store_dt(F, lane, v, shv, scv, WSP(bf16, WS_H) + (size_t)row * DM, do_dt, WSP(float, WS_DTRAW) + (size_t)row * 16, wdtT);
        }
    }
#undef PN_LOAD
}

__device__ __forceinline__ void ctx_post_norm(Frame& F, int l, int which, int nsl, const bool wdt_staged) {
    PH_IDS();
    const bool do_dt = false; (void)wdt_staged;
    LAS float* wdtT = (LAS float*)F.lds;
    const float* gam = (which == 0 ? inp_ptr(I_ln1_g) : inp_ptr(I_ln2_g)) + l * DM; const float* bet = (which == 0 ? inp_ptr(I_ln1_b) : inp_ptr(I_ln2_b)) + l * DM;
    const float* ad = WSP(float, WS_ADA) + (size_t)(l * 5 + 4) * 6144;
    const float* ad2 = (which == 0) ? ad + 3072 : WSP(float, WS_ADA) + (size_t)((l + 1) * 5 + 4) * 6144;
    const int gw = bid * NWAVES + wave, NGW = F.G * NWAVES;
    for (int row = RL + gw; row < RT; row += NGW) {
        int ln = lane; asm volatile("" : "+v"(ln));
        const float* xin = (which == 0) ? input_row(F, row) : stream_row(F, row); float* xout = stream_row(F, row);
        const float* sl = WSP(float, WS_SLAB) + (size_t)(row - RL) * DM;
        f32x4 v[4];
        {
            f32x4 m[4];
#pragma unroll
            for (int j = 0; j < 4; ++j) m[j] = (f32x4){0.f, 0.f, 0.f, 0.f};
#pragma unroll 1
            for (int s = 0; s < nsl; ++s) {
#pragma unroll
                for (int j = 0; j < 4; ++j) m[j] += *(const f32x4*)(sl + (size_t)s * RC * DM + 256 * j + 4 * ln); }
            f32x4 gtv[4]; load_vec4(ad + (which == 0 ? 2048 : 5120), ln, gtv);
#pragma unroll
            for (int j = 0; j < 4; ++j) v[j] = *(const f32x4*)(xin + 256 * j + 4 * ln) * ALPHA + gtv[j] * m[j];
        }
        ln_normalize(v);
        { f32x4 gmv[4], btv[4]; load_vec4(gam, ln, gmv); load_vec4(bet, ln, btv);
#pragma unroll
          for (int j = 0; j < 4; ++j) { v[j] = v[j] * gmv[j] + btv[j]; *(f32x4*)(xout + 256 * j + 4 * ln) = v[j]; } }
        ln_normalize(v);
        f32x4 shv[4], scv[4]; load_vec4(ad2, ln, shv); load_vec4(ad2 + 1024, ln, scv);
        mod_store_dt(F, ln, v, shv, scv, WSP(bf16, WS_H) + (size_t)row * DM, do_dt, WSP(float, WS_DTRAW) + (size_t)row * 16, wdtT);
    }
}

typedef short dt_bf16x8 __attribute__((ext_vector_type(8)));
__device__ __forceinline__ void dt_mfma(Frame& F, int l, int first_block) {
    PH_IDS();
    if (bid < first_block) return;
    const int c = lane & 15, q = lane >> 4;
    const bf16* Wh = WSP(bf16, WS_WDT) + (size_t)(l * 2) * 16 * 1024 + (size_t)c * 1024 + 8 * q; const bf16* Wl = Wh + 16 * 1024;
    for (int t = (bid - first_block) * NWAVES + wave; t < RT / 16; t += (F.G - first_block) * NWAVES) {
        const bf16* Hr = WSP(bf16, WS_H) + (size_t)(16 * t + c) * DM + 8 * q;
        f32x4 acc = (f32x4){0.f, 0.f, 0.f, 0.f};
#pragma unroll 8
        for (int ks = 0; ks < 32; ++ks) { const dt_bf16x8 av = *(const dt_bf16x8*)(Hr + 32 * ks), bh = *(const dt_bf16x8*)(Wh + 32 * ks), bl = *(const dt_bf16x8*)(Wl + 32 * ks);
            acc = __builtin_amdgcn_mfma_f32_16x16x32_bf16(av, bh, acc, 0, 0, 0); acc = __builtin_amdgcn_mfma_f32_16x16x32_bf16(av, bl, acc, 0, 0, 0); }
        float* dr = WSP(float, WS_DTRAW) + (size_t)(16 * t + 4 * q) * 16 + c;
        dr[0] = acc.x; dr[16] = acc.y; dr[32] = acc.z; dr[48] = acc.w;
    }
}
__device__ __forceinline__ void p2_rest(Frame& F, int l, int first_block) {
    PH_IDS();
    if (bid < first_block) return;
    const int gt = (bid - first_block) * NTHR + tid, NGT = (F.G - first_block) * NTHR;
    const bf16* U = WSP(bf16, WS_U);
    {
        const int prows = (l == 0 ? RT : RL), pr4 = prows >> 2;
        for (int it = gt; it < 4 * pr4 * 8; it += NGT) {
            const int k8 = it & 7, r4 = (it >> 3) % pr4, gi = (it >> 3) / pr4, c8 = gi * 64 + k8 * 8, row0 = 4 * r4; const RowInfo ri = row_info(row0);
            const int win = 2 << gi, left = win >> 1, right = win - 1 - left;
            const bf16* Ub = U + (size_t)ri.base * NIN + UC_POOL + c8;
            float s[4][8], self[4][8];
#pragma unroll
            for (int i = 0; i < 4; ++i)
#pragma unroll
                for (int q = 0; q < 8; ++q) s[i][q] = 0.f;
#define POOL_WIN(W) do { v4u rw[W + 3]; _Pragma("unroll") for (int j = 0; j < W + 3; ++j) { const int tt = ri.pos - (W / 2) + j; rw[j] = (tt >= 0 && tt < ri.L) ? *(const v4u*)(Ub + (size_t)tt * NIN) : (v4u){0u, 0u, 0u, 0u}; } \
                _Pragma("unroll") for (int j = 0; j < W + 3; ++j) { float uf[8]; unpack8(rw[j], uf); \
                    _Pragma("unroll") for (int i = 0; i < 4; ++i) { if (j >= i && j <= i + W - 1) { _Pragma("unroll") for (int q = 0; q < 8; ++q) s[i][q] += uf[q]; } \
                        if (j == (W / 2) + i) { _Pragma("unroll") for (int q = 0; q < 8; ++q) self[i][q] = uf[q]; } } } } while (0)
            if (gi == 0) POOL_WIN(2); else if (gi == 1) POOL_WIN(4); else if (gi == 2) POOL_WIN(8); else POOL_WIN(16);
#undef POOL_WIN
#pragma unroll
            for (int i = 0; i < 4; ++i) { const int pos = ri.pos + i, lo = max(pos - left, 0), hi = min(pos + right + 1, ri.L); const float inv = 1.f / (float)(hi - lo);
#pragma unroll
                for (int q = 0; q < 8; ++q) s[i][q] = s[i][q] * inv - self[i][q];
                *(v4u*)(WSP(bf16, WS_CONCAT) + (size_t)(row0 + i) * DM + 768 + c8) = pack8(s[i]); }
        }
    }
    {
        LAS float* tw2 = (LAS float*)F.lds;
        if (tid < 256) { tw2[tid] = cospif((float)tid * (1.f / 128.f)); tw2[256 + tid] = sinpif((float)tid * (1.f / 128.f)); }
        __syncthreads();
        for (int it = gt; it < (l == 0 ? NB * 256 * 64 * 4 : 0); it += NGT) {
            const int tq = it & 3, c4 = ((it >> 2) & 63) * 4, k = (it >> 8) & 255, b = it >> 16;
            float y[4] = {0.f, 0.f, 0.f, 0.f};
#pragma unroll 16
            for (int tt = 0; tt < 64; ++tt) { const int t = 64 * tq + tt; const size_t ro = (size_t)(RL + b * CTXL + t) * NIN;
                const u32x2 pw = *(const u32x2*)(U + ro + UC_P + c4), qw = *(const u32x2*)(U + ro + UC_Q + c4);
                const int e = (k * t) & 255; const float wr = tw2[e], wi = tw2[256 + e];
                y[0] += wr * bflo(pw.x) - wi * bflo(qw.x); y[1] += wr * bfhi(pw.x) - wi * bfhi(qw.x); y[2] += wr * bflo(pw.y) - wi * bflo(qw.y); y[3] += wr * bfhi(pw.y) - wi * bfhi(qw.y); }
#pragma unroll
            for (int z = 0; z < 4; ++z) { y[z] = DPP_ADD(y[z], 0xB1); y[z] = DPP_ADD(y[z], 0x4E); }
            if (tq == 0) { u32x2 w; w.x = pk2(y[0] * 0.0625f, y[1] * 0.0625f); w.y = pk2(y[2] * 0.0625f, y[3] * 0.0625f);
                *(u32x2*)(WSP(bf16, WS_CONCAT) + (size_t)(RL + b * CTXL + k) * DM + 512 + c4) = w; }
        }
        __syncthreads();
    }
}
typedef _Float16 h2v __attribute__((ext_vector_type(2)));
__device__ __forceinline__ h2v as_h2(unsigned w) { return __builtin_bit_cast(h2v, w); }
__device__ __forceinline__ h2v f2h2(float a, float b) { return __builtin_convertvector((pn_f2){a, b}, h2v); }
__device__ __forceinline__ void unpack8h(const v4u w, float (&f)[8]) { f[0] = hlo(w.x); f[1] = hhi(w.x); f[2] = hlo(w.y); f[3] = hhi(w.y); f[4] = hlo(w.z); f[5] = hhi(w.z); f[6] = hlo(w.w); f[7] = hhi(w.w); }
__device__ __forceinline__ void p7_conv_geglu_rows(Frame& F, const int tid, const int bid, int l, int t0, int ntiles, int nrows, int row_lo, int row_hi) {
    const int gt = bid * NTHR + tid, NGT = F.G * NTHR;
    const bf16* A = WSP(bf16, WS_AH);
    const float* cw = inp_ptr(I_ffn_conv_w) + (size_t)l * 9 * NUP; const float* cb = inp_ptr(I_ffn_conv_b) + (size_t)l * NUP;
    const int per_row = 16 * ntiles;
    for (int it = gt; it < (row_hi - row_lo) * per_row; it += NGT) {
        const int row = row_lo + it / per_row, c8 = (it % per_row) * 8; const int j = 128 * t0 + c8;
        const bf16* Ac = A + (size_t)(c8 >> 6) * nrows * 128 + (c8 & 63);
        float va[8], ga[8];
        { const f32x4 a0 = *(const f32x4*)(cb + j), a1 = *(const f32x4*)(cb + j + 4), g0 = *(const f32x4*)(cb + DFF + j), g1 = *(const f32x4*)(cb + DFF + j + 4);
          va[0] = a0.x; va[1] = a0.y; va[2] = a0.z; va[3] = a0.w; va[4] = a1.x; va[5] = a1.y; va[6] = a1.z; va[7] = a1.w;
          ga[0] = g0.x; ga[1] = g0.y; ga[2] = g0.z; ga[3] = g0.w; ga[4] = g1.x; ga[5] = g1.y; ga[6] = g1.z; ga[7] = g1.w; }
        const bool lat = row < RL; const int pos = lat ? (row & (SEQ - 1)) : ((row - RL) & (CTXL - 1));
        const int gr = pos >> 6, gc = pos & 63;
#pragma unroll
        for (int dy = -1; dy <= 1; ++dy)
#pragma unroll
            for (int dx = -1; dx <= 1; ++dx) {
                bool ok; int nrow;
                if (lat) { ok = (gr + dy >= 0) && (gr + dy < 128) && (gc + dx >= 0) && (gc + dx < 64); nrow = row + 64 * dy + dx; }
                else { ok = (dy == 0) && (pos + dx >= 0) && (pos + dx < CTXL); nrow = row + dx; }
                if (ok) { float vf[8], gf[8]; const bf16* ap = Ac + (size_t)nrow * 128; unpack8h(*(const v4u*)ap, vf); unpack8h(*(const v4u*)(ap + 64), gf);
                    const float* w = cw + (size_t)((dy + 1) * 3 + (dx + 1)) * NUP + j;
                    const f32x4 w0 = *(const f32x4*)w, w1 = *(const f32x4*)(w + 4), u0 = *(const f32x4*)(w + DFF), u1 = *(const f32x4*)(w + DFF + 4);
                    va[0] += w0.x * vf[0]; va[1] += w0.y * vf[1]; va[2] += w0.z * vf[2]; va[3] += w0.w * vf[3]; va[4] += w1.x * vf[4]; va[5] += w1.y * vf[5]; va[6] += w1.z * vf[6]; va[7] += w1.w * vf[7];
                    ga[0] += u0.x * gf[0]; ga[1] += u0.y * gf[1]; ga[2] += u0.z * gf[2]; ga[3] += u0.w * gf[3]; ga[4] += u1.x * gf[4]; ga[5] += u1.y * gf[5]; ga[6] += u1.z * gf[6]; ga[7] += u1.w * gf[7]; } }
        float o[8];
#pragma unroll
        for (int q = 0; q < 8; ++q) o[q] = gelu_tanh_f(ga[q]) * va[q];
        *(v4u*)(WSP(bf16, WS_G) + ((size_t)(j >> 6) * RT + row) * 64 + (j & 63)) = pack8(o);
    }
}

constexpr int CT_PS = 272;
constexpr int CT2_PS = 288, CT2_TILE = 180 * CT2_PS;
__device__ __forceinline__ void p7_conv_geglu(Frame& F, int l, int t0, int ntiles, int nrows) {
    PH_IDS();
    const bf16* A = WSP(bf16, WS_AH); bf16* Gb = WSP(bf16, WS_G);
    const float* cw = inp_ptr(I_ffn_conv_w) + (size_t)l * 9 * NUP; const float* cb = inp_ptr(I_ffn_conv_b) + (size_t)l * NUP;
    const int NUNIT = NB * 8 * 8 * 2 * ntiles;
#define CT_DECODE(u, cch, tx, ty, bb) const int cch = (u) >> 8, tx = (u) & 7, ty = ((u) >> 3) & 7, bb = ((u) >> 6) & 3
    int tab[6];
#pragma unroll
    for (int i = 0; i < 6; ++i) { const int x = tid + 512 * i, pos = x >> 4, k16 = x & 15, hr = pos / 10, hc = pos - 10 * hr;
        tab[i] = (((hr * 64 + hc) * 256 + k16 * 16) << 5) | (hr == 0 ? 1 : 0) | (hr == 17 ? 2 : 0) | (hc == 0 ? 4 : 0) | (hc == 9 ? 8 : 0) | (x >= 180 * 16 ? 16 : 0); }
    const int dmy = 65 * 256 + (tid & 15) * 16;
#define CT_EDGES(ty_, tx_) (16 | ((ty_) == 0 ? 1 : 0) | ((ty_) == 7 ? 2 : 0) | ((tx_) == 0 ? 4 : 0) | ((tx_) == 7 ? 8 : 0))
#define CT_PREFETCH(P, u) do { CT_DECODE(u, cch_, tx_, ty_, bb_); const int em_ = CT_EDGES(ty_, tx_); \
        const unsigned char* tb_ = (const unsigned char*)(A + (size_t)cch_ * nrows * 128) + ((ptrdiff_t)(bb_ * SEQ + (16 * ty_ - 1) * 64 + 8 * tx_ - 1)) * 256; \
        _Pragma("unroll") for (int i = 0; i < 6; ++i) { const bool ok = (tab[i] & em_) == 0; P[i] = *(const v4u*)(tb_ + (ok ? (tab[i] >> 5) : dmy)); } } while (0)
#define CT_TOLDS(P, u, bo) do { CT_DECODE(u, cch_, tx_, ty_, bb_); (void)cch_; (void)bb_; const int em_ = CT_EDGES(ty_, tx_); \
        _Pragma("unroll") for (int i = 0; i < 6; ++i) { const bool ok = (tab[i] & em_) == 0; const v4u v = ok ? P[i] : (v4u){0u, 0u, 0u, 0u}; \
            if (i < 5 || tid < 320) *(LAS v4u*)(F.lds + (bo) + ((tid >> 4) + 32 * i) * CT2_PS + ((tid & 15) >> 3) * 128 + (tid & 7) * 16) = v; } } while (0)
    const int per = (NUNIT + F.G - 1) / F.G, ustart = bid * per, uend = min(ustart + per, NUNIT);
    int wcch = -1;
    h2v wv[9][2], wg[9][2], bv[2], bg[2];
    v4u pre[2][6];
    if (ustart < uend) {
        CT_PREFETCH(pre[0], ustart);
        if (ustart + 1 < uend) CT_PREFETCH(pre[1], ustart + 1);
        __syncthreads();
        CT_TOLDS(pre[0], ustart, 0);
        if (ustart + 2 < uend) CT_PREFETCH(pre[0], ustart + 2);
        __syncthreads();
        for (int u0 = ustart; u0 < uend; u0 += 2) {
#pragma unroll
          for (int sel = 0; sel < 2; ++sel) {
            const int unit = u0 + sel;
            if (unit < uend) {
            if (wave < 4) { if (unit + 1 < uend) CT_TOLDS(pre[sel ^ 1], unit + 1, (sel ^ 1) * CT2_TILE); if (unit + 3 < uend) CT_PREFETCH(pre[sel ^ 1], unit + 3); }
            CT_DECODE(unit, cch, tx, ty, bb);
            const int cg = tid & 15, pg = tid >> 4, r = pg >> 1, hf = pg & 1, j = 128 * t0 + 64 * cch + 4 * cg;
            if (cch != wcch) {
#pragma unroll
                for (int k = 0; k < 9; ++k) { const f32x4 a = *(const f32x4*)(cw + (size_t)k * NUP + j), g = *(const f32x4*)(cw + (size_t)k * NUP + DFF + j);
                    wv[k][0] = f2h2(a.x, a.y); wv[k][1] = f2h2(a.z, a.w); wg[k][0] = f2h2(g.x, g.y); wg[k][1] = f2h2(g.z, g.w); }
                { const f32x4 a = *(const f32x4*)(cb + j), g = *(const f32x4*)(cb + DFF + j); bv[0] = f2h2(a.x, a.y); bv[1] = f2h2(a.z, a.w); bg[0] = f2h2(g.x, g.y); bg[1] = f2h2(g.z, g.w); }
                wcch = cch; }
            const LAS unsigned char* lp = F.lds + sel * CT2_TILE + (r * 10 + 4 * hf) * CT2_PS + cg * 8;
            bf16* Go = Gb + ((size_t)(j >> 6) * RT + (bb * SEQ + (16 * ty + r) * 64 + 8 * tx + 4 * hf)) * 64 + (j & 63);
            h2v pv[2] = {bv[0], bv[1]}, pg_[2] = {bg[0], bg[1]}, cv[2] = {bv[0], bv[1]}, cg_[2] = {bg[0], bg[1]};
            u32x2 dn[6], dc[6];
#define CT_LDCOL(dst, xx) do { dst[0] = *(const LAS u32x2*)(lp + (xx) * CT2_PS); dst[1] = *(const LAS u32x2*)(lp + (xx) * CT2_PS + 128); dst[2] = *(const LAS u32x2*)(lp + (10 + (xx)) * CT2_PS); \
                dst[3] = *(const LAS u32x2*)(lp + (10 + (xx)) * CT2_PS + 128); dst[4] = *(const LAS u32x2*)(lp + (20 + (xx)) * CT2_PS); dst[5] = *(const LAS u32x2*)(lp + (20 + (xx)) * CT2_PS + 128); } while (0)
            CT_LDCOL(dn, 0);
#pragma unroll
            for (int xi = 0; xi < 6; ++xi) {
#pragma unroll
                for (int k = 0; k < 6; ++k) dc[k] = dn[k];
                if (xi < 5) CT_LDCOL(dn, xi + 1);
                h2v nv[2] = {bv[0], bv[1]}, ng[2] = {bg[0], bg[1]};
#pragma unroll
                for (int e = 0; e < 2; ++e) {
                    const h2v v0 = as_h2(e ? dc[0].y : dc[0].x), g0 = as_h2(e ? dc[1].y : dc[1].x), v1 = as_h2(e ? dc[2].y : dc[2].x), g1 = as_h2(e ? dc[3].y : dc[3].x), v2 = as_h2(e ? dc[4].y : dc[4].x), g2 = as_h2(e ? dc[5].y : dc[5].x);
                    pv[e] = wv[2][e] * v0 + pv[e]; pv[e] = wv[5][e] * v1 + pv[e]; pv[e] = wv[8][e] * v2 + pv[e];   pg_[e] = wg[2][e] * g0 + pg_[e]; pg_[e] = wg[5][e] * g1 + pg_[e]; pg_[e] = wg[8][e] * g2 + pg_[e];
                    cv[e] = wv[1][e] * v0 + cv[e]; cv[e] = wv[4][e] * v1 + cv[e]; cv[e] = wv[7][e] * v2 + cv[e];   cg_[e] = wg[1][e] * g0 + cg_[e]; cg_[e] = wg[4][e] * g1 + cg_[e]; cg_[e] = wg[7][e] * g2 + cg_[e];
                    nv[e] = wv[0][e] * v0 + nv[e]; nv[e] = wv[3][e] * v1 + nv[e]; nv[e] = wv[6][e] * v2 + nv[e];   ng[e] = wg[0][e] * g0 + ng[e]; ng[e] = wg[3][e] * g1 + ng[e]; ng[e] = wg[6][e] * g2 + ng[e];
                }
                if (xi >= 2) { u32x2 w;
#pragma unroll
                    for (int e = 0; e < 2; ++e) { const h2v g = pg_[e]; const h2v z = (g * g * (h2v){(_Float16)-0.1029432f, (_Float16)-0.1029432f} + (h2v){(_Float16)-2.3022082f, (_Float16)-2.3022082f}) * g;
                        const h2v d = __builtin_elementwise_exp2(z) + (h2v){(_Float16)1.f, (_Float16)1.f}; h2v rr; rr.x = __builtin_amdgcn_rcph(d.x); rr.y = __builtin_amdgcn_rcph(d.y);
                        const h2v o = g * rr * pv[e]; const unsigned ow_ = pk2((float)o.x, (float)o.y); if (e) w.y = ow_; else w.x = ow_; }
                    *(u32x2*)(Go + (size_t)(xi - 2) * 64) = w; }
#pragma unroll
                for (int e = 0; e < 2; ++e) { pv[e] = cv[e]; pg_[e] = cg_[e]; cv[e] = nv[e]; cg_[e] = ng[e]; }
            }
#undef CT_LDCOL
            if (wave >= 4) { if (unit + 1 < uend) CT_TOLDS(pre[sel ^ 1], unit + 1, (sel ^ 1) * CT2_TILE); if (unit + 3 < uend) CT_PREFETCH(pre[sel ^ 1], unit + 3); }
            __syncthreads();
            }
          }
        }
    }
#undef CT_DECODE
#undef CT_PREFETCH
#undef CT_TOLDS
#undef CT_EDGES
    __syncthreads();
    if (nrows > RL) p7_conv_geglu_rows(F, tid, bid, l, t0, ntiles, nrows, RL, nrows);
}
typedef short s16x4 __attribute__((ext_vector_type(4)));
typedef short v4i16_t __attribute__((ext_vector_type(4)));
constexpr int XS = 544, TS = 288;
constexpr int SSD_X = 0, SSD_B = 128 * XS, SSD_C = SSD_B + 128 * TS, SSD_AUX = SSD_C + 128 * TS, SSD_TOT = SSD_AUX + 8192;
static_assert(SSD_TOT + 64 <= LDSCTL_OFF, "SSD LDS map");
constexpr int NCHUNK = 264;
__device__ __forceinline__ s16x4 tr_read(const LAS unsigned char* p) { return __builtin_bit_cast(s16x4, __builtin_amdgcn_ds_read_tr16_b64_v4i16((LAS v4i16_t*)p)); }
__device__ __forceinline__ f32x4 mfma16(bf16x8 a, bf16x8 b, f32x4 c) { return __builtin_amdgcn_mfma_f32_16x16x32_bf16(a, b, c, 0, 0, 0); }
__device__ __forceinline__ bf16x8 cat8(s16x4 lo, s16x4 hi) { bf16x8 r; r[0] = lo[0]; r[1] = lo[1]; r[2] = lo[2]; r[3] = lo[3]; r[4] = hi[0]; r[5] = hi[1]; r[6] = hi[2]; r[7] = hi[3]; return r; }
__device__ __forceinline__ float s2f(short s) { return __uint_as_float(((unsigned)(unsigned short)s) << 16); }
__device__ __forceinline__ short f2s(float f) { return (short)f2bf(f); }
struct ChunkInfo { int row0, pos0, L; };
__device__ __forceinline__ ChunkInfo chunk_info(int ck) {
    ChunkInfo ci;
    if (ck < 256) { ci.row0 = ck * 128; ci.pos0 = (ck & 63) * 128; ci.L = SEQ; }
    else { const int k = ck - 256; ci.row0 = RL + k * 128; ci.pos0 = (k & 1) * 128; ci.L = CTXL; }
    return ci;
}
__device__ __forceinline__ void ssd_dtcs(Frame& F, int l, int g, const ChunkInfo ci, const int wave, const int lane, const bool weights) {
    LAS float* arr = (LAS float*)(F.lds + SSD_AUX); LAS float* tot = (LAS float*)(F.lds + SSD_TOT);
    const int hp = wave >> 1, dir = wave & 1, hd = 4 * g + hp;
    const float Aneg = -expf(inp_ptr(I_ssd_a_log)[(l * 2 + dir) * 8 + hd]), dtb = inp_ptr(I_ssd_dt_bias)[(l * 2 + dir) * 8 + hd];
    const float* DTR = WSP(float, WS_DTRAW) + (size_t)(ci.row0 + 2 * lane) * 16 + dir * 8 + hd;
    const float dt0 = softplus_f(DTR[0] + dtb), dt1 = softplus_f(DTR[16] + dtb), a0 = dt0 * Aneg, a1 = dt1 * Aneg, s = a0 + a1;
    float incl = s;
#pragma unroll
    for (int o = 1; o < 64; o <<= 1) { const float t = __shfl_up(incl, o); if (lane >= o) incl += t; }
    const float excl = incl - s, total = __shfl(incl, 63);
    float c0, c1;
    if (dir == 0) { c0 = excl + a0; c1 = incl; } else { c0 = excl; c1 = excl + a0; }
    if (!weights) { arr[(hp * 4 + 2 * dir) * 128 + 2 * lane] = dt0; arr[(hp * 4 + 2 * dir) * 128 + 2 * lane + 1] = dt1; arr[(hp * 4 + 2 * dir + 1) * 128 + 2 * lane] = c0; arr[(hp * 4 + 2 * dir + 1) * 128 + 2 * lane + 1] = c1; }
    else {
        const float w0 = dir == 0 ? dt0 * __expf(fminf(total - c0, 0.f)) : dt0 * __expf(c0), w1 = dir == 0 ? dt1 * __expf(fminf(total - c1, 0.f)) : dt1 * __expf(c1);
        arr[(hp * 2 + dir) * 128 + 2 * lane] = w0; arr[(hp * 2 + dir) * 128 + 2 * lane + 1] = w1; }
    if (lane == 0) tot[hp * 2 + dir] = total;
}
template <bool WITH_C>
__device__ __forceinline__ void ssd_conv(Frame& F, int l, int g, const ChunkInfo ci, const int tid) {
    const int cc = tid & 63, rb = tid >> 6;
    if (cc < (WITH_C ? 64 : 48)) {
        const int wcol = cc < 32 ? 256 * g + 8 * cc : cc < 48 ? 512 + 128 * g + 8 * (cc - 32) : 768 + 128 * g + 8 * (cc - 48);
        const float* cw = inp_ptr(I_ssd_conv_w) + (size_t)l * 3 * 1024 + wcol; const float* cb = inp_ptr(I_ssd_conv_b) + l * 1024 + wcol;
        float w0[8], w1[8], w2[8], bs[8];
        { const f32x4 a = *(const f32x4*)cw, b = *(const f32x4*)(cw + 4); w0[0] = a.x; w0[1] = a.y; w0[2] = a.z; w0[3] = a.w; w0[4] = b.x; w0[5] = b.y; w0[6] = b.z; w0[7] = b.w; }
        { const f32x4 a = *(const f32x4*)(cw + 1024), b = *(const f32x4*)(cw + 1028); w1[0] = a.x; w1[1] = a.y; w1[2] = a.z; w1[3] = a.w; w1[4] = b.x; w1[5] = b.y; w1[6] = b.z; w1[7] = b.w; }
        { const f32x4 a = *(const f32x4*)(cw + 2048), b = *(const f32x4*)(cw + 2052); w2[0] = a.x; w2[1] = a.y; w2[2] = a.z; w2[3] = a.w; w2[4] = b.x; w2[5] = b.y; w2[6] = b.z; w2[7] = b.w; }
        { const f32x4 a = *(const f32x4*)cb, b = *(const f32x4*)(cb + 4); bs[0] = a.x; bs[1] = a.y; bs[2] = a.z; bs[3] = a.w; bs[4] = b.x; bs[5] = b.y; bs[6] = b.z; bs[7] = b.w; }
        const bf16* U = WSP(bf16, WS_U) + (size_t)ci.row0 * NIN + UC_XBC + wcol;
        const int l0 = 16 * rb;
#define SSD_CONV_OUT(ll_, o_) do { int off; const int ll = (ll_); \
            if (cc < 32) off = SSD_X + ll * XS + cc * 16; else if (cc < 48) off = SSD_B + ll * TS + (cc - 32) * 16; else off = SSD_C + ll * TS + (cc - 48) * 16; \
            *(LAS v4u*)(F.lds + off) = pack8(o_); } while (0)
        float prev[8], cur[8], nxt[8];
        {
            v4u raw[12];
#pragma unroll
            for (int i = 0; i < 12; ++i) { const int ll = l0 - 1 + i; const bool ok = (ci.pos0 + ll >= 0) && (ci.pos0 + ll < ci.L); raw[i] = ok ? *(const v4u*)(U + (ptrdiff_t)ll * NIN) : (v4u){0u, 0u, 0u, 0u}; }
            unpack8(raw[0], prev); unpack8(raw[1], cur);
#pragma unroll
            for (int i = 0; i < 10; ++i) { unpack8(raw[i + 2], nxt); float o[8];
#pragma unroll
                for (int q = 0; q < 8; ++q) { o[q] = silu_f(bs[q] + w0[q] * prev[q] + w1[q] * cur[q] + w2[q] * nxt[q]); prev[q] = cur[q]; cur[q] = nxt[q]; }
                SSD_CONV_OUT(l0 + i, o); }
        }
        {
            v4u raw[6];
#pragma unroll
            for (int i = 0; i < 6; ++i) { const int ll = l0 + 11 + i; const bool ok = (ci.pos0 + ll < ci.L); raw[i] = ok ? *(const v4u*)(U + (ptrdiff_t)ll * NIN) : (v4u){0u, 0u, 0u, 0u}; }
#pragma unroll
            for (int i = 0; i < 6; ++i) { unpack8(raw[i], nxt); float o[8];
#pragma unroll
                for (int q = 0; q < 8; ++q) { o[q] = silu_f(bs[q] + w0[q] * prev[q] + w1[q] * cur[q] + w2[q] * nxt[q]); prev[q] = cur[q]; cur[q] = nxt[q]; }
                SSD_CONV_OUT(l0 + 10 + i, o); }
        }
#undef SSD_CONV_OUT
    }
}
__device__ __forceinline__ int trx_off(int row, int col) { return row * XS + col * 2; }
__device__ __forceinline__ int trb_off(int row, int col) { return row * TS + col * 2; }
__device__ __forceinline__ void ssd_states(Frame& F, int l) {
    PH_IDS();
    for (int unit = bid; unit < NCHUNK * 2; unit += F.G) {
        int lane_ = lane; asm volatile("" : "+v"(lane_));
        int tid_ = tid; asm volatile("" : "+v"(tid_));
        const int c = lane_ & 15, q = lane_ >> 4;
        const int ck = unit >> 1, g = unit & 1; const ChunkInfo ci = chunk_info(ck);
        __syncthreads();
        ssd_dtcs(F, l, g, ci, wave, lane_, true);
        ssd_conv<false>(F, l, g, ci, tid_);
        __syncthreads();
        const LAS float* arr = (const LAS float*)(F.lds + SSD_AUX); const LAS float* tot = (const LAS float*)(F.lds + SSD_TOT);
        if (tid < 8) WSP(float, WS_DEC)[(ck * 8 + 4 * g + (tid >> 1)) * 2 + (tid & 1)] = __expf(tot[tid]);
        s16x4 blo[4], bhi[4];
#pragma unroll
        for (int ks = 0; ks < 4; ++ks) { const int r0 = 32 * ks + 4 * q + (c >> 2), n0 = 16 * wave + 4 * (c & 3);
            blo[ks] = tr_read(F.lds + SSD_B + trb_off(r0, n0)); bhi[ks] = tr_read(F.lds + SSD_B + trb_off(r0 + 16, n0)); }
#pragma unroll 1
        for (int hp = 0; hp < 4; ++hp) {
            bf16x8 xf[4][4];
#pragma unroll
            for (int pt = 0; pt < 4; ++pt)
#pragma unroll
                for (int ks = 0; ks < 4; ++ks) { const int r0 = 32 * ks + 4 * q + (c >> 2), ch = 64 * hp + 16 * pt + 4 * (c & 3);
                    xf[pt][ks] = cat8(tr_read(F.lds + SSD_X + trx_off(r0, ch)), tr_read(F.lds + SSD_X + trx_off(r0 + 16, ch))); }
#pragma unroll
            for (int dir = 0; dir < 2; ++dir) {
                f32x4 acc[4];
#pragma unroll
                for (int pt = 0; pt < 4; ++pt) acc[pt] = (f32x4){0.f, 0.f, 0.f, 0.f};
#pragma unroll
                for (int ks = 0; ks < 4; ++ks) {
                    const f32x4 wl = *(const LAS f32x4*)(arr + (hp * 2 + dir) * 128 + 32 * ks + 4 * q), wh = *(const LAS f32x4*)(arr + (hp * 2 + dir) * 128 + 32 * ks + 16 + 4 * q);
                    v4u aw; aw.x = pk2(s2f(blo[ks][0]) * wl.x, s2f(blo[ks][1]) * wl.y); aw.y = pk2(s2f(blo[ks][2]) * wl.z, s2f(blo[ks][3]) * wl.w);
                    aw.z = pk2(s2f(bhi[ks][0]) * wh.x, s2f(bhi[ks][1]) * wh.y); aw.w = pk2(s2f(bhi[ks][2]) * wh.z, s2f(bhi[ks][3]) * wh.w);
                    const bf16x8 a = __builtin_bit_cast(bf16x8, aw);
#pragma unroll
                    for (int pt = 0; pt < 4; ++pt) acc[pt] = mfma16(a, xf[pt][ks], acc[pt]);
                }
                bf16* So = WSP(bf16, WS_SST) + ((size_t)((ck * 8 + 4 * g + hp) * 2 + dir)) * 8192 + 16 * wave + 4 * q;
#pragma unroll
                for (int pt = 0; pt < 4; ++pt) { u32x2 w; w.x = pk2(acc[pt].x, acc[pt].y); w.y = pk2(acc[pt].z, acc[pt].w); *(u32x2*)(So + (size_t)(16 * pt + c) * 128) = w; }
            }
        }
    }
    __syncthreads();
}
__device__ __forceinline__ void ssd_scan(Frame& F) {
    PH_IDS();
    const bf16* S = WSP(bf16, WS_SST); bf16* HI = WSP(bf16, WS_HIN); const float* DEC = WSP(float, WS_DEC);
    for (int item = bid * NTHR + tid; item < NB * 8 * 2 * 2048; item += F.G * NTHR) {
        const int quad = item & 2047, dir = (item >> 11) & 1, hd = (item >> 12) & 7, b = item >> 15;
        float h0 = 0.f, h1 = 0.f, h2 = 0.f, h3 = 0.f;
#pragma unroll 1
        for (int blk = 0; blk < 6; ++blk) {
            u32x2 sv[11]; float dv[11]; size_t offs[11];
#pragma unroll
            for (int j = 0; j < 11; ++j) { const int i = blk * 11 + j;
                const int ck = i < 2 ? 256 + 2 * b + (dir == 0 ? i : 1 - i) : 64 * b + (dir == 0 ? i - 2 : 65 - i);
                offs[j] = ((size_t)((ck * 8 + hd) * 2 + dir)) * 8192 + quad * 4; sv[j] = *(const u32x2*)(S + offs[j]); dv[j] = DEC[(ck * 8 + hd) * 2 + dir]; }
#pragma unroll
            for (int j = 0; j < 11; ++j) { u32x2 w; w.x = pk2(h0, h1); w.y = pk2(h2, h3); *(u32x2*)(HI + offs[j]) = w;
                h0 = dv[j] * h0 + bflo(sv[j].x); h1 = dv[j] * h1 + bfhi(sv[j].x); h2 = dv[j] * h2 + bflo(sv[j].y); h3 = dv[j] * h3 + bfhi(sv[j].y); }
        }
    }
}
__device__ __forceinline__ void ssd_out(Frame& F, int l, int nchunks) {
    PH_IDS();
    for (int unit = bid; unit < nchunks * 2; unit += F.G) {
        int lane_ = lane; asm volatile("" : "+v"(lane_));
        int tid_ = tid; asm volatile("" : "+v"(tid_));
        const int c = lane_ & 15, q = lane_ >> 4;
        const int ck = unit >> 1, g = unit & 1; const ChunkInfo ci = chunk_info(ck);
        v4u hreg[4], zreg[2];
#define SSD_HLOAD(hh) do { const bf16* Hg_ = WSP(bf16, WS_HIN) + ((size_t)(ck * 8 + 4 * g + (hh)) * 2) * 8192; \
            _Pragma("unroll") for (int j = 0; j < 4; ++j) { const int x = tid_ + 512 * j, dir = x >> 10, p = (x >> 4) & 63, k16 = x & 15; hreg[j] = *(const v4u*)(Hg_ + (size_t)dir * 8192 + p * 128 + k16 * 8); } \
            _Pragma("unroll") for (int j = 0; j < 2; ++j) { const int x = lane_ + 64 * j, row = x >> 3, k16 = x & 7; zreg[j] = *(const v4u*)(WSP(bf16, WS_U) + (size_t)(ci.row0 + 16 * wave + row) * NIN + UC_Z + 256 * g + 64 * (hh) + 8 * k16); } } while (0)
        SSD_HLOAD(0);
        __syncthreads();
        ssd_dtcs(F, l, g, ci, wave, lane_, false);
        ssd_conv<true>(F, l, g, ci, tid_);
        __syncthreads();
        const LAS float* arr = (const LAS float*)(F.lds + SSD_AUX); const LAS float* tot = (const LAS float*)(F.lds + SSD_TOT);
        const int myl = 16 * wave + c;
        bf16x8 cfr[4];
#pragma unroll
        for (int ks = 0; ks < 4; ++ks) cfr[ks] = *(const LAS bf16x8*)(F.lds + SSD_C + myl * TS + (4 * ks + q) * 16);
        unsigned gtp[8][2];
#pragma unroll
        for (int i = 0; i < 8; ++i) { f32x4 gacc = (f32x4){0.f, 0.f, 0.f, 0.f};
#pragma unroll
            for (int ks = 0; ks < 4; ++ks) { const int row = 16 * i + c; const bf16x8 a = *(const LAS bf16x8*)(F.lds + SSD_B + row * TS + (4 * ks + q) * 16); gacc = mfma16(a, cfr[ks], gacc); }
            gtp[i][0] = pk2(gacc.x, gacc.y); gtp[i][1] = pk2(gacc.z, gacc.w); }
        float ss[4] = {0.f, 0.f, 0.f, 0.f};
        bf16* Co = WSP(bf16, WS_CONCAT) + (size_t)(ci.row0 + 16 * wave) * DM + 256 * g;
        LAS unsigned char* zst = F.lds + SSD_C + wave * 2048;
#pragma unroll 1
        for (int hp = 0; hp < 4; ++hp) {
            const int hd = 4 * g + hp;
            __syncthreads();
#pragma unroll
            for (int j = 0; j < 4; ++j) { const int x = tid_ + 512 * j, dir = x >> 10, p = (x >> 4) & 63, k16 = x & 15; *(LAS v4u*)(F.lds + SSD_B + dir * (64 * TS) + p * TS + k16 * 16) = hreg[j]; }
#pragma unroll
            for (int j = 0; j < 2; ++j) { const int x = lane_ + 64 * j, row = x >> 3, k16 = x & 7; *(LAS v4u*)(zst + row * 128 + k16 * 16) = zreg[j]; }
            __syncthreads();
            if (hp < 3) SSD_HLOAD(hp + 1);
            const float csf_l = arr[(hp * 4 + 1) * 128 + myl], csb_l = arr[(hp * 4 + 3) * 128 + myl];
            f32x4 acc[4];
#pragma unroll
            for (int pt = 0; pt < 4; ++pt) acc[pt] = (f32x4){0.f, 0.f, 0.f, 0.f};
            auto intra_part = [&]() __attribute__((always_inline)) {
#pragma unroll
            for (int ks = 0; ks < 4; ++ks) {
                unsigned aw[4];
#pragma unroll
                for (int hf = 0; hf < 2; ++hf) { const int i = 2 * ks + hf, s0 = 16 * i + 4 * q; float m[4];
                    if (i < wave) { const f32x4 dtf = *(const LAS f32x4*)(arr + (hp * 4 + 0) * 128 + s0), csf = *(const LAS f32x4*)(arr + (hp * 4 + 1) * 128 + s0);
#pragma unroll
                        for (int r = 0; r < 4; ++r) m[r] = __expf(fminf(csf_l - csf[r], 0.f)) * dtf[r]; }
                    else if (i > wave) { const f32x4 dtb = *(const LAS f32x4*)(arr + (hp * 4 + 2) * 128 + s0), csb = *(const LAS f32x4*)(arr + (hp * 4 + 3) * 128 + s0);
#pragma unroll
                        for (int r = 0; r < 4; ++r) m[r] = __expf(fminf(csb[r] - csb_l, 0.f)) * dtb[r]; }
                    else { const f32x4 dtf = *(const LAS f32x4*)(arr + (hp * 4 + 0) * 128 + s0), csf = *(const LAS f32x4*)(arr + (hp * 4 + 1) * 128 + s0);
                        const f32x4 dtb = *(const LAS f32x4*)(arr + (hp * 4 + 2) * 128 + s0), csb = *(const LAS f32x4*)(arr + (hp * 4 + 3) * 128 + s0);
#pragma unroll
                        for (int r = 0; r < 4; ++r) { const int sl = 4 * q + r;
                            const float mf = (sl <= c) ? __expf(fminf(csf_l - csf[r], 0.f)) * dtf[r] : 0.f, mb = (sl >= c) ? __expf(fminf(csb[r] - csb_l, 0.f)) * dtb[r] : 0.f; m[r] = mf + mb; } }
                    aw[2 * hf] = pk2(bflo(gtp[i][0]) * m[0], bfhi(gtp[i][0]) * m[1]); aw[2 * hf + 1] = pk2(bflo(gtp[i][1]) * m[2], bfhi(gtp[i][1]) * m[3]); }
                const bf16x8 a = __builtin_bit_cast(bf16x8, (v4u){aw[0], aw[1], aw[2], aw[3]});
#pragma unroll
                for (int pt = 0; pt < 4; ++pt) { const int r0 = 32 * ks + 4 * q + (c >> 2), ch = 64 * hp + 16 * pt + 4 * (c & 3);
                    const bf16x8 b = cat8(tr_read(F.lds + SSD_X + trx_off(r0, ch)), tr_read(F.lds + SSD_X + trx_off(r0 + 16, ch)));
                    acc[pt] = mfma16(a, b, acc[pt]); }
            }
            };
            auto inter_part = [&]() __attribute__((always_inline)) {
#pragma unroll
            for (int dir = 0; dir < 2; ++dir) {
                const float e = dir == 0 ? __expf(csf_l) : __expf(fminf(tot[hp * 2 + 1] - csb_l, 0.f));
#pragma unroll
                for (int ks = 0; ks < 4; ++ks) { v4u aw; aw.x = pk2(s2f(cfr[ks][0]) * e, s2f(cfr[ks][1]) * e); aw.y = pk2(s2f(cfr[ks][2]) * e, s2f(cfr[ks][3]) * e); aw.z = pk2(s2f(cfr[ks][4]) * e, s2f(cfr[ks][5]) * e); aw.w = pk2(s2f(cfr[ks][6]) * e, s2f(cfr[ks][7]) * e);
                    const bf16x8 a = __builtin_bit_cast(bf16x8, aw);
#pragma unroll
                    for (int pt = 0; pt < 4; ++pt) { const int p = 16 * pt + c; const bf16x8 b = *(const LAS bf16x8*)(F.lds + SSD_B + dir * (64 * TS) + p * TS + (4 * ks + q) * 16); acc[pt] = mfma16(a, b, acc[pt]); } }
            }
            };
            if (wave < 4) { intra_part(); inter_part(); } else { inter_part(); intra_part(); }
            const float dsk = inp_ptr(I_ssd_d)[l * 8 + hd];
#pragma unroll
            for (int pt = 0; pt < 4; ++pt) { const s16x4 xs = tr_read(F.lds + SSD_X + trx_off(16 * wave + 4 * q + (c >> 2), 64 * hp + 16 * pt + 4 * (c & 3)));
#pragma unroll
                for (int r = 0; r < 4; ++r) { LAS unsigned short* zp = (LAS unsigned short*)(zst + (4 * q + r) * 128 + (16 * pt + c) * 2);
                    const float y = (acc[pt][r] + s2f(xs[r]) * dsk) * silu_f(bf2f(*zp)); ss[r] += y * y; *zp = (unsigned short)f2bf(y); } }
            asm volatile("s_waitcnt lgkmcnt(0)" ::: "memory");
#pragma unroll
            for (int j = 0; j < 2; ++j) { const int x = lane_ + 64 * j, row = x >> 3, k16 = x & 7; *(v4u*)(Co + (size_t)row * DM + 64 * hp + 8 * k16) = *(const LAS v4u*)(zst + row * 128 + k16 * 16); }
        }
#undef SSD_HLOAD
#pragma unroll
        for (int r = 0; r < 4; ++r) { float s = ss[r]; s += __shfl_xor(s, 1); s += __shfl_xor(s, 2); s += __shfl_xor(s, 4); s += __shfl_xor(s, 8); ss[r] = 1.f / sqrtf(s * (1.f / 256.f) + LN_EPS); }
        LAS float* rs = (LAS float*)(zst);
        if (c == 0) { rs[4 * q + 0] = ss[0]; rs[4 * q + 1] = ss[1]; rs[4 * q + 2] = ss[2]; rs[4 * q + 3] = ss[3]; }
        asm volatile("s_waitcnt vmcnt(0) lgkmcnt(0)" ::: "memory");
        const float* nw = inp_ptr(I_ssd_norm_w) + l * 512 + 256 * g;
#pragma unroll 2
        for (int j = 0; j < 8; ++j) { const int x = lane_ + 64 * j, row = x >> 5, k16 = x & 31; float yf[8];
            unpack8(*(const v4u*)(Co + (size_t)row * DM + 8 * k16), yf);
            const float rr = rs[row]; const f32x4 n0 = *(const f32x4*)(nw + 8 * k16), n1 = *(const f32x4*)(nw + 8 * k16 + 4);
            yf[0] *= rr * n0.x; yf[1] *= rr * n0.y; yf[2] *= rr * n0.z; yf[3] *= rr * n0.w; yf[4] *= rr * n1.x; yf[5] *= rr * n1.y; yf[6] *= rr * n1.z; yf[7] *= rr * n1.w;
            *(v4u*)(Co + (size_t)row * DM + 8 * k16) = pack8(yf); }
    }
    __syncthreads();
}
__device__ __forceinline__ int kperm_inv(int pos) { const int ks = pos >> 5, q = (pos >> 3) & 3, j = pos & 7; return 32 * ks + (j < 4 ? 4 * q + j : 16 + 4 * q + (j - 4)); }
__device__ __forceinline__ void fft_tables(Frame& F, const int tid, const int bid) {
    const int gt = bid * NTHR + tid, NGT = F.G * NTHR;
    for (int it = gt; it < 128 * 128; it += NGT) {
        const int m = it >> 7, k = kperm_inv(it & 127), po = m >> 6, k1 = m & 63, pi = k >> 6, l1 = k & 63;
        const float a = (float)((k1 * l1) & 63) * (1.f / 32.f), wr = cospif(a), wi = sinpif(a);
        const float v = po == 0 ? (pi == 0 ? wr : -wi) : (pi == 0 ? wi : wr);
        WSP(bf16, WS_WA)[it] = (bf16)f2bf(v); }
    for (int it = gt; it < 128 * 256; it += NGT) {
        const int k2 = it >> 8, k = kperm_inv(it & 255), l2 = k >> 1, pi = k & 1;
        const float a = (float)((k2 * l2) & 127) * (1.f / 64.f);
        WSP(bf16, WS_WB)[it] = (bf16)f2bf(pi == 0 ? cospif(a) : -sinpif(a)); }
    for (int it = gt; it < 64 * 128; it += NGT) {
        const int k1 = it >> 7, l2 = it & 127; const float a = (float)(k1 * l2) * (1.f / 4096.f);
        WSP(float, WS_TW)[2 * it] = cospif(a); WSP(float, WS_TW)[2 * it + 1] = sinpif(a); }
}
__device__ __forceinline__ void fft_a(Frame& F, int first_block) {
    PH_IDS();
    const bf16* U = WSP(bf16, WS_U);
    if (bid < first_block) return;
    for (int unit = bid - first_block; unit < NB * 128; unit += F.G - first_block) {
        int lane_ = lane; asm volatile("" : "+v"(lane_));
        const int c = lane_ & 15, q = lane_ >> 4, b = unit >> 7, l2 = unit & 127, kt = wave & 3, half = wave >> 2;
        __syncthreads();
#pragma unroll
        for (int j = 0; j < 8; ++j) { const int x = tid + 512 * j, tok = x >> 6, k16 = x & 63;
            *(LAS v4u*)(F.lds + ((k16 >> 5) * 64 + tok) * XS + (k16 & 31) * 16) = *(const v4u*)(U + (size_t)(b * SEQ + 128 * tok + l2) * NIN + UC_P + 8 * k16); }
        __syncthreads();
        f32x4 acc[2][8];
#pragma unroll
        for (int i = 0; i < 2; ++i)
#pragma unroll
            for (int ct = 0; ct < 8; ++ct) acc[i][ct] = (f32x4){0.f, 0.f, 0.f, 0.f};
#pragma unroll
        for (int ks = 0; ks < 4; ++ks) {
            const bf16x8 are = *(const bf16x8*)(WSP(bf16, WS_WA) + (size_t)(16 * kt + c) * 128 + 32 * ks + 8 * q), aim = *(const bf16x8*)(WSP(bf16, WS_WA) + (size_t)(64 + 16 * kt + c) * 128 + 32 * ks + 8 * q);
#pragma unroll
            for (int ct = 0; ct < 8; ++ct) { const int r0 = 32 * ks + 4 * q + (c >> 2), ch = 128 * half + 16 * ct + 4 * (c & 3);
                const bf16x8 bfr = cat8(tr_read(F.lds + trx_off(r0, ch)), tr_read(F.lds + trx_off(r0 + 16, ch)));
                acc[0][ct] = mfma16(are, bfr, acc[0][ct]); acc[1][ct] = mfma16(aim, bfr, acc[1][ct]); }
        }
        float tr[4], ti[4];
#pragma unroll
        for (int r = 0; r < 4; ++r) { const int k1 = 16 * kt + 4 * q + r; tr[r] = WSP(float, WS_TW)[2 * (k1 * 128 + l2)]; ti[r] = WSP(float, WS_TW)[2 * (k1 * 128 + l2) + 1]; }
        __syncthreads();
#pragma unroll
        for (int ct = 0; ct < 8; ++ct)
#pragma unroll
            for (int r = 0; r < 4; ++r) { const int k1 = 16 * kt + 4 * q + r, ch = 128 * half + 16 * ct + c; const float yr = acc[0][ct][r], yi = acc[1][ct][r];
                *(LAS unsigned short*)(F.lds + k1 * XS + ch * 2) = (unsigned short)f2bf(yr * tr[r] - yi * ti[r]);
                *(LAS unsigned short*)(F.lds + (64 + k1) * XS + ch * 2) = (unsigned short)f2bf(yr * ti[r] + yi * tr[r]); }
        __syncthreads();
#pragma unroll
        for (int j = 0; j < 8; ++j) { const int x = tid + 512 * j, row = x >> 5, k16 = x & 31, part = row >> 6, k1 = row & 63;
            *(v4u*)(WSP(bf16, WS_YFFT) + ((size_t)((b * 64 + k1) * 128 + l2) * 2 + part) * 256 + 8 * k16) = *(const LAS v4u*)(F.lds + row * XS + k16 * 16); }
    }
    __syncthreads();
}
__device__ __forceinline__ void fft_b(Frame& F) {
    PH_IDS();
    for (int unit = bid; unit < NB * 64; unit += F.G) {
        int lane_ = lane; asm volatile("" : "+v"(lane_));
        const int c = lane_ & 15, q = lane_ >> 4, b = unit >> 6, k1 = unit & 63, mt0 = 2 * (wave & 3), half = wave >> 2;
        __syncthreads();
        const bf16* Yg = WSP(bf16, WS_YFFT) + (size_t)(b * 64 + k1) * 256 * 256;
#pragma unroll
        for (int j = 0; j < 16; ++j) { const int x = tid + 512 * j, row = x >> 5, k16 = x & 31; *(LAS v4u*)(F.lds + row * XS + k16 * 16) = *(const v4u*)(Yg + (size_t)row * 256 + 8 * k16); }
        __syncthreads();
        f32x4 acc[2][8];
#pragma unroll
        for (int i = 0; i < 2; ++i)
#pragma unroll
            for (int ct = 0; ct < 8; ++ct) acc[i][ct] = (f32x4){0.f, 0.f, 0.f, 0.f};
#pragma unroll 2
        for (int ks = 0; ks < 8; ++ks) {
            const bf16x8 a0 = *(const bf16x8*)(WSP(bf16, WS_WB) + (size_t)(16 * mt0 + c) * 256 + 32 * ks + 8 * q), a1 = *(const bf16x8*)(WSP(bf16, WS_WB) + (size_t)(16 * mt0 + 16 + c) * 256 + 32 * ks + 8 * q);
#pragma unroll
            for (int ct = 0; ct < 8; ++ct) { const int r0 = 32 * ks + 4 * q + (c >> 2), ch = 128 * half + 16 * ct + 4 * (c & 3);
                const bf16x8 bfr = cat8(tr_read(F.lds + trx_off(r0, ch)), tr_read(F.lds + trx_off(r0 + 16, ch)));
                acc[0][ct] = mfma16(a0, bfr, acc[0][ct]); acc[1][ct] = mfma16(a1, bfr, acc[1][ct]); }
        }
        __syncthreads();
        const float nrm = 0.011048543456039806f;
#pragma unroll
        for (int i = 0; i < 2; ++i)
#pragma unroll
            for (int ct = 0; ct < 8; ++ct)
#pragma unroll
                for (int r = 0; r < 4; ++r) *(LAS unsigned short*)(F.lds + (16 * (mt0 + i) + 4 * q + r) * XS + (128 * half + 16 * ct + c) * 2) = (unsigned short)f2bf(acc[i][ct][r] * nrm);
        __syncthreads();
#pragma unroll
        for (int j = 0; j < 8; ++j) { const int x = tid + 512 * j, k2 = x >> 5, k16 = x & 31;
            *(v4u*)(WSP(bf16, WS_CONCAT) + (size_t)(b * SEQ + k1 + 64 * k2) * DM + 512 + 8 * k16) = *(const LAS v4u*)(F.lds + k2 * XS + k16 * 16); }
    }
    __syncthreads();
}
#ifndef DBL_MASK
#define DBL_MASK 0
#endif
#ifndef MK_PER_PHASE
#define MK_PER_PHASE 0
#endif
constexpr int N_PHASES = 2 + 12 * NLAYER;
struct Args { const float* in[25]; float* out; unsigned char* ws; int ph_lo, ph_hi, li, pad; };
__global__ void __launch_bounds__(NTHR, 2) skel_fwd(Args args) {
    extern __shared__ __attribute__((aligned(16))) unsigned char lds[];
    Frame F;
    F.lds = (LAS unsigned char*)lds; F.MISC = (volatile LAS unsigned*)(F.lds + MISC_OFF);
    F.G = gridDim.x;
    F.ws = args.ws; F.ctl = (gu32*)(F.ws + WS_CTL); F.out = args.out;
    for (int u = threadIdx.x; u < (LDS_BYTES - LDSCTL_OFF) / 4; u += NTHR) ((LAS unsigned*)(F.lds + LDSCTL_OFF))[u] = 0u;
    __syncthreads();
    XcdBarrier bar; bar.bar = (unsigned*)(F.ctl + CW_BAR); bar.x = 0; bar.st = nullptr;
    const int lo = args.ph_lo, hi = args.ph_hi;
    if (hi - lo > 1) bar = xcd_barrier_post((unsigned*)(F.ctl + CW_BAR) + args.li * XCD_BAR_WORDS, F.MISC + 8);

    for (int ph = lo; ph < hi; ++ph) {
        if (ph == 0) {
#ifndef SKIP_P0A
 p0a(F); if (DBL_MASK & 8192) p0a(F);
#endif
 }
        else if (ph == 1) {
#ifndef SKIP_P0B
 p0b(F); if (DBL_MASK & 16384) p0b(F);
#endif
 }
        else {
            const int l = (ph - 2) / 12, s = (ph - 2) % 12;
            const int nrows = (l == 0) ? RT : RL;
            const int up_na = (l == 0 || F.G != 256) ? 11 : 10;
            if (s == 0) dt_mfma(F, l, (F.G == 256) ? 164 : 0);
            if (s == 0 || s == 4 || s == 6 || s == 8 || s == 10) {
                pg8::Gemm g; bf16* O; int ldc; size_t cstr = 0;
                if (s == 0) { g = pg8::Gemm{WSP(bf16, WS_H), WSP(bf16, WS_WIN) + (size_t)l * NIN * DM, RT, NIN, DM}; O = WSP(bf16, WS_U); ldc = NIN; }
                else if (s == 4) { g = pg8::Gemm{WSP(bf16, WS_CONCAT), WSP(bf16, WS_WOUT) + (size_t)l * DM * DM, RL, DM, DM}; O = WSP(bf16, WS_MIX); ldc = DM; }
                else if (s == 10) { g = pg8::Gemm{WSP(bf16, WS_G), WSP(bf16, WS_WDOWN) + (size_t)l * DM * DFF, RL, DM, DFF, 0, 64, (size_t)RT * 128}; O = WSP(bf16, WS_FFNO); ldc = DM; }
                else { const int t0 = (s == 8) ? up_na : 0, ntl = (s == 8) ? 22 - up_na : up_na; g = pg8::Gemm{WSP(bf16, WS_H), WSP(bf16, WS_WUP) + (size_t)l * NUP * DM + (size_t)t0 * 256 * DM, nrows, ntl * 256, DM}; O = WSP(bf16, WS_AH); ldc = 128; cstr = (size_t)nrows * 128; }
                int bid = blockIdx.x; asm volatile("" : "+s"(bid)); pg8::StaticOrder S; S.init(g.M, g.N, F.G, bid);
                pg8::EpiBf16<0> E{O, ldc, nullptr, 0, 0, 1.f, cstr, (s == 6 || s == 8)};
#ifndef SKIP_GEMM
                pg8::gemm_phase<pg8::EpiBf16<0>, pg8::StaticOrder, true, true>(F.lds, g, S, E);
                if (DBL_MASK & 1) pg8::gemm_phase<pg8::EpiBf16<0>, pg8::StaticOrder, true, true>(F.lds, g, S, E);
#endif
                if ((s == 4 || s == 10) && l == 0) {
                    const int Kt = (s == 4) ? DM : DFF;
                    const int ksl = Kt / 2;
                    pg8::Gemm gc{(s == 4 ? WSP(bf16, WS_CONCAT) + (size_t)RL * DM : WSP(bf16, WS_G) + (size_t)RL * 64), g.Bt, RC, DM, ksl, Kt, (s == 4 ? 0 : 64), (s == 4 ? (size_t)0 : (size_t)RT * 128)};
                    pg8::SliceOrder SO{RC / 256, DM / 256, 2, ksl, F.G, bid};
                    pg8::EpiF32Slab ES{WSP(float, WS_SLAB), DM, ksl, (size_t)RC * DM};
                    pg8::gemm_phase<pg8::EpiF32Slab, pg8::SliceOrder, false, false>(F.lds, gc, SO, ES);
                }
            }
            else if (s == 1) { ssd_states(F, l); if (DBL_MASK & 2) ssd_states(F, l); fft_a(F, (l == 0 && F.G > 32) ? 16 : 0); if (DBL_MASK & 4) fft_a(F, (l == 0 && F.G > 32) ? 16 : 0); }
            else if (s == 2) { ssd_scan(F); if (DBL_MASK & 16) ssd_scan(F); fft_b(F); if (DBL_MASK & 4) fft_b(F); }
            else if (s == 3) { ssd_out(F, l, l == 0 ? NCHUNK : 256); if (DBL_MASK & 256) ssd_out(F, l, l == 0 ? NCHUNK : 256); p2_rest(F, l, (l == 0 && F.G > 32) ? 16 : 0); if (DBL_MASK & 32) p2_rest(F, l, (l == 0 && F.G > 32) ? 16 : 0); }
            else if (s == 5) {
#ifndef SKIP_PN
 if (l == 0) post_norm_pass<true, false>(F, l, 0, RL, WSP(bf16, WS_MIX)); else post_norm_pass<false, false>(F, l, 0, RL, WSP(bf16, WS_MIX)); if (l == 0) ctx_post_norm(F, l, 0, 2, false);
#endif
 }
            else if (s == 7 || s == 9) {
#ifndef SKIP_P7
 p7_conv_geglu(F, l, s == 9 ? up_na : 0, s == 9 ? 22 - up_na : up_na, nrows); if (DBL_MASK & 8) p7_conv_geglu(F, l, s == 9 ? up_na : 0, s == 9 ? 22 - up_na : up_na, nrows);
#endif
 }
            else {
#ifndef SKIP_PN
 if (l + 1 < NLAYER) post_norm_pass<false, false>(F, l, 1, RL, WSP(bf16, WS_FFNO)); else post_norm_pass<false, true>(F, l, 1, RL, WSP(bf16, WS_FFNO)); if (l == 0) ctx_post_norm(F, l, 1, 2, true);
#endif
 }
        }
        if (ph + 1 < hi) xcd_barrier(bar);
    }
}

extern "C" void kernel_launch(void* const* d_in, const int* in_sizes, int n_in, void* d_out, int out_size, void* d_ws, size_t ws_size, hipStream_t stream) {
    static int grid = 0;
    if (grid == 0) {
        if (n_in != 25 || in_sizes[0] != RL * DM || out_size != RL * DM || ws_size < WS_END) { fprintf(stderr, "kernel_launch: unexpected shapes: n_in %d in0 %d out %d ws %zu (need %zu)\n", n_in, n_in > 0 ? in_sizes[0] : -1, out_size, ws_size, (size_t)WS_END); grid = -1; return; }
        int dev = 0, cus = 0, per_cu = 0;
        if (hipGetDevice(&dev) != hipSuccess || hipDeviceGetAttribute(&cus, hipDeviceAttributeMultiprocessorCount, dev) != hipSuccess) { grid = -1; return; }
        if (hipFuncSetAttribute((const void*)skel_fwd, hipFuncAttributeMaxDynamicSharedMemorySize, LDS_BYTES) != hipSuccess) { fprintf(stderr, "kernel_launch: hipFuncSetAttribute failed\n"); grid = -1; return; }
        if (hipOccupancyMaxActiveBlocksPerMultiprocessor(&per_cu, (const void*)skel_fwd, NTHR, LDS_BYTES) != hipSuccess || per_cu < 1) fprintf(stderr, "kernel_launch: occupancy query reports %d blocks per CU\n", per_cu);
        (void)hipGetLastError();
        grid = cus;
    }
    if (grid < 0) return;
    (void)hipMemsetAsync((char*)d_ws + WS_CTL, 0, CTL_ZERO_BYTES, stream);
    Args a{};
    for (int i = 0; i < 25; ++i) a.in[i] = (const float*)d_in[i];
    a.out = (float*)d_out; a.ws = (unsigned char*)d_ws;
#if MK_PER_PHASE
    for (int ph = 0; ph < N_PHASES; ++ph) { a.ph_lo = ph; a.ph_hi = ph + 1; a.li = 0; hipLaunchKernelGGL(skel_fwd, dim3(grid), dim3(NTHR), LDS_BYTES, stream, a); }
#else
    a.ph_lo = 0; a.ph_hi = N_PHASES; a.li = 0;
    hipLaunchKernelGGL(skel_fwd, dim3(grid), dim3(NTHR), LDS_BYTES, stream, a);
#endif
}
```

```cpp
#include <hip/hip_runtime.h>
#include <cstdio>
#include <cstdint>
namespace pg8 {
#define PG8_LAS __attribute__((address_space(3)))
typedef unsigned short bf16_t;
typedef short bf16x8 __attribute__((ext_vector_type(8)));
typedef float f32x4 __attribute__((ext_vector_type(4)));
typedef unsigned u32x4 __attribute__((ext_vector_type(4)));
constexpr int BM = 256, BK = 64, HALF = 128, HTB = HALF * BK * 2  , STAGE_BYTES = 8 * HTB, NXCD = 8, WGM = 8;

__host__ __device__ __forceinline__ int lds_byte(int r, int c) { const int st = (r >> 4) * 2 + (c >> 5), rr = r & 15, cc = c & 31, ob = rr * 64 + cc * 2; return st * 1024 + (ob ^ (((ob >> 9) & 1) << 5)); }
__host__ __device__ __forceinline__ void stage_rc(int b, int& R, int& C) { const int st = b / 1024, sb = b % 1024, swz = sb ^ (((sb >> 9) & 1) << 5); R = (st >> 1) * 16 + swz / 64; C = (st & 1) * 32 + (swz % 64) / 2; }
__host__ __device__ __forceinline__ int perm32(int rho) { const int n = rho >> 4, i = rho & 15; return 8 * (i >> 2) + 4 * n + (i & 3); }

struct Unit { int pm, pn, kofs; };
struct Gemm { const bf16_t* A; const bf16_t* Bt; int M, N, K; int ld = 0; int lda = 0; size_t kstepA = 0; };

struct StaticOrder {
    int nM, nN, nwg, G, c;
    __host__ __device__ void init(int M, int N, int G_, int c_) { nM = M / BM; nN = N / BM; nwg = nM * nN; G = G_; c = c_; }
    __host__ __device__ bool next(int i, Unit& u) const {
        const long L = (long)i * G + c; if (L >= nwg) return false;
        int wgid = (int)L; { const int q = nwg / NXCD, r = nwg % NXCD, xcd = wgid % NXCD, off = wgid / NXCD; wgid = (xcd < r ? xcd * (q + 1) : r * (q + 1) + (xcd - r) * q) + off; }
        const int nig = WGM * nN, gid = wgid / nig, fm = gid * WGM, gsz = (nM - fm) < WGM ? (nM - fm) : WGM;
        u.pm = fm + ((wgid % nig) % gsz); u.pn = (wgid % nig) / gsz; u.kofs = 0; return true;
    }
    __device__ __forceinline__ void a_ready(const Unit&) const {}
    __device__ __forceinline__ void done(const Unit&) const {}
};

__device__ __forceinline__ unsigned cvt_pk_bf16(float lo, float hi) { unsigned r; asm volatile("v_cvt_pk_bf16_f32 %0, %1, %2" : "=v"(r) : "v"(lo), "v"(hi)); return r; }
__device__ __forceinline__ unsigned cvt_pk_f16(float lo, float hi) { unsigned r; asm volatile("v_cvt_pk_f16_f32 %0, %1, %2" : "=v"(r) : "v"(lo), "v"(hi)); return r; }
typedef float f32x2 __attribute__((ext_vector_type(2)));
__device__ __forceinline__ f32x2 gelu_pk(f32x2 v) {
    const f32x2 av = __builtin_elementwise_abs(v), d = av * 0.2316418882f + 1.0f;
    f32x2 t; t.x = __builtin_amdgcn_rcpf(d.x); t.y = __builtin_amdgcn_rcpf(d.y);
    f32x2 q = t * 0.5307027145f + (-0.7265760135f); q = q * t + 0.7107068705f; q = q * t + (-0.142248368f); q = q * t + 0.127414796f; q = q * t;
    const f32x2 s = (v * v) * (-0.72134752044f);
    f32x2 e; e.x = __builtin_amdgcn_exp2f(s.x); e.y = __builtin_amdgcn_exp2f(s.y);
    const f32x2 m = v * (q * e), r = v - m;
    f32x2 o; o.x = v.x < 0.f ? m.x : r.x; o.y = v.y < 0.f ? m.y : r.y; return o;
}

template <int ACT  > struct EpiBf16 {
    static constexpr bool PERM = true, AFTER_DRAIN = false; static_assert(ACT == 0 || ACT == 1, "EpiBf16: ACT is 0 (none) or 1 (gelu_pk)");
    bf16_t* O; int ldc; const float* bias; int split_cols; size_t split_stride; float scale0;
    size_t cstride = 0; bool f16out = false;
    __device__ __forceinline__ void operator()(const f32x4 (&acc)[2][2][4][2], const Unit& u, int wr, int wc, int fr, int fq) const {
        const int row0 = u.pm * BM + wr * 64 + fr; int colt = u.pn * BM; bf16_t* base = O;
        float sc = 1.f; if (split_cols) { const int t = colt / split_cols; base += (size_t)t * split_stride; colt -= t * split_cols; if (t == 0) sc = scale0; }
        const size_t cs = cstride ? cstride : (size_t)HALF; const size_t col0 = (size_t)(colt >> 7) * cs + wc * 32 + 8 * fq; const int bcol0 = u.pn * BM + wc * 32 + 8 * fq;
        f32x4 bv[2][2];
#pragma unroll
        for (int bj = 0; bj < 2; ++bj)
#pragma unroll
            for (int n = 0; n < 2; ++n) bv[bj][n] = bias ? *(const f32x4*)(bias + bcol0 + bj * HALF + 4 * n) : (f32x4){0.f, 0.f, 0.f, 0.f};
#pragma unroll
        for (int ai = 0; ai < 2; ++ai)
#pragma unroll
            for (int m = 0; m < 4; ++m) { bf16_t* rowp = base + (size_t)(row0 + ai * HALF + m * 16) * ldc + col0;
#pragma unroll
                for (int bj = 0; bj < 2; ++bj) { f32x4 v0 = acc[ai][bj][m][0] + bv[bj][0], v1 = acc[ai][bj][m][1] + bv[bj][1];
                    if (ACT == 1) { f32x2 a = gelu_pk((f32x2){v0[0], v0[1]}), b = gelu_pk((f32x2){v0[2], v0[3]}), c = gelu_pk((f32x2){v1[0], v1[1]}), d = gelu_pk((f32x2){v1[2], v1[3]});
                        v0 = (f32x4){a.x, a.y, b.x, b.y}; v1 = (f32x4){c.x, c.y, d.x, d.y}; }
                    v0 = v0 * sc; v1 = v1 * sc; u32x4 w; if (f16out) { w.x = cvt_pk_f16(v0[0], v0[1]); w.y = cvt_pk_f16(v0[2], v0[3]); w.z = cvt_pk_f16(v1[0], v1[1]); w.w = cvt_pk_f16(v1[2], v1[3]); } else { w.x = cvt_pk_bf16(v0[0], v0[1]); w.y = cvt_pk_bf16(v0[2], v0[3]); w.z = cvt_pk_bf16(v1[0], v1[1]); w.w = cvt_pk_bf16(v1[2], v1[3]); }
                    *(u32x4*)(rowp + bj * cs) = w; } }
    }
};

struct SliceOrder {
    int nM, nN, nS, kslice, G, c;
    __device__ __forceinline__ bool next(int i, Unit& u) const { const long L = (long)i * G + c; if (L >= (long)nM * nN * nS) return false; int w = (int)L; u.kofs = (w % nS) * kslice; w /= nS; u.pn = w % nN; u.pm = w / nN; return true; }
    __device__ __forceinline__ void a_ready(const Unit&) const {}
    __device__ __forceinline__ void done(const Unit&) const {}
};
struct EpiF32Slab {
    static constexpr bool PERM = false, AFTER_DRAIN = false;
    float* O; int ldc; int kslice; size_t slab;
    __device__ __forceinline__ void operator()(const f32x4 (&acc)[2][2][4][2], const Unit& u, int wr, int wc, int fr, int fq) const {
        int fr_ = fr, fq_ = fq; asm volatile("" : "+v"(fr_), "+v"(fq_));
        float* base = O + (size_t)(u.kofs / kslice) * slab; const int col0 = u.pn * BM + wc * 32 + 4 * fq_;
#pragma unroll
        for (int ai = 0; ai < 2; ++ai)
#pragma unroll
            for (int m = 0; m < 4; ++m) { float* rowp = base + (size_t)(u.pm * BM + ai * HALF + wr * 64 + m * 16 + fr_) * ldc + col0;
#pragma unroll
                for (int bj = 0; bj < 2; ++bj)
#pragma unroll
                    for (int n = 0; n < 2; ++n) *(f32x4*)(rowp + bj * HALF + n * 16) = acc[ai][bj][m][n]; }
    }
};
template <class Epi, class Sched, bool ALIGN_EPI = false, bool SP2 = false>
__device__ __forceinline__ void gemm_phase(PG8_LAS unsigned char* lds, const Gemm g, const Sched& S, const Epi& E) {
    int tid_ = threadIdx.x; asm volatile("" : "+v"(tid_)); const int tid = tid_, wid = __builtin_amdgcn_readfirstlane(tid >> 6), lane = tid & 63, wr = wid >> 2, wc = wid & 3, fr = lane & 15, fq = lane >> 4;
    const int K = g.K, nt = K / BK, LD = g.ld ? g.ld : g.K, LDA = g.lda ? g.lda : LD;
    unsigned voffA[2], voffB[2];
#pragma unroll
    for (int i = 0; i < 2; ++i) { int R, C; stage_rc(tid * 16 + i * 8192, R, C); const int Rb = Epi::PERM ? ((R & ~31) + perm32(R & 31)) : R;
        voffA[i] = (unsigned)(R * LDA + C) * 2u; voffB[i] = (unsigned)(Rb * LD + C) * 2u; }
    const size_t kstep = (size_t)(BK * 2);
    const size_t hstep = (size_t)HALF * LD * 2;
    const size_t tstep = 2 * hstep;
    const size_t kstepA = g.kstepA ? g.kstepA : kstep, hstepA = (size_t)HALF * LDA * 2, tstepA = 2 * hstepA;
    const unsigned ldsw = (unsigned)wid * 1024u;
    const int aoff = lds_byte(wr * 64 + fr, fq * 8), boff = lds_byte(wc * 32 + fr, fq * 8);
#define PG8_SA(b, h) (((b) * 2 + (h)) * HTB)
#define PG8_SB(b, h) ((4 + (b) * 2 + (h)) * HTB)
#define PG8_STAGE(bufoff, gbase, voff) do { _Pragma("unroll") for (int _i = 0; _i < 2; ++_i) \
        __builtin_amdgcn_global_load_lds((const unsigned*)((const char*)(gbase) + (voff)[_i]), (PG8_LAS unsigned*)(lds + (bufoff) + ldsw + _i * 8192), 16, 0, 0); } while (0)
#define PG8_LDA(dst, b, h) do { _Pragma("unroll") for (int m = 0; m < 4; ++m) _Pragma("unroll") for (int k = 0; k < 2; ++k) dst[m][k] = *(const PG8_LAS bf16x8*)(lds + PG8_SA(b, h) + aoff + m * 2048 + k * 1024); } while (0)
#define PG8_LDB(dst, b, h) do { _Pragma("unroll") for (int n = 0; n < 2; ++n) _Pragma("unroll") for (int k = 0; k < 2; ++k) dst[n][k] = *(const PG8_LAS bf16x8*)(lds + PG8_SB(b, h) + boff + n * 2048 + k * 1024); } while (0)
#define PG8_MMA(ai, bj, At, Bt) do { __builtin_amdgcn_s_setprio(1); _Pragma("unroll") for (int m = 0; m < 4; ++m) _Pragma("unroll") for (int n = 0; n < 2; ++n) _Pragma("unroll") for (int k = 0; k < 2; ++k) \
        acc[ai][bj][m][n] = __builtin_amdgcn_mfma_f32_16x16x32_bf16(Bt[n][k], At[m][k], acc[ai][bj][m][n], 0, 0, 0); __builtin_amdgcn_s_setprio(0); } while (0)
#define PG8_WAIT_V(n) asm volatile("s_waitcnt vmcnt(" #n ")" ::: "memory")
#define PG8_WAIT_L(n) asm volatile("s_waitcnt lgkmcnt(" #n ")" ::: "memory")
#define PG8_BAR __builtin_amdgcn_s_barrier()
#define PG8_SCHED __builtin_amdgcn_sched_barrier(0)
    Unit cur, nxt; int ui = 0;
    if (!S.next(0, cur)) return;
    f32x4 acc[2][2][4][2];
#pragma unroll
    for (int a = 0; a < 2; ++a)
#pragma unroll
        for (int b = 0; b < 2; ++b)
#pragma unroll
            for (int m = 0; m < 4; ++m)
#pragma unroll
                for (int n = 0; n < 2; ++n) acc[a][b][m][n] = (f32x4){0.f, 0.f, 0.f, 0.f};
    bf16x8 At[4][2], B0[2][2], B1[2][2];
    const char* cA = (const char*)g.A + (size_t)cur.pm * tstepA + (g.kstepA ? (size_t)(cur.kofs >> 6) * kstepA : (size_t)cur.kofs * 2); const char* cB = (const char*)g.Bt + (size_t)cur.pn * tstep + (size_t)cur.kofs * 2;
    S.a_ready(cur);
    if constexpr (SP2) {
        PG8_STAGE(PG8_SB(0, 0), cB, voffB); PG8_STAGE(PG8_SB(0, 1), cB + hstep, voffB); PG8_STAGE(PG8_SA(0, 0), cA, voffA); PG8_STAGE(PG8_SA(0, 1), cA + hstepA, voffA);
        if (wr == 1) PG8_BAR;
        PG8_WAIT_V(2); PG8_BAR;
        PG8_STAGE(PG8_SB(1, 0), cB + kstep, voffB); PG8_STAGE(PG8_SA(1, 0), cA + kstepA, voffA); PG8_STAGE(PG8_SB(1, 1), cB + hstep + kstep, voffB);
        PG8_WAIT_V(6); PG8_BAR;
    } else {
        PG8_STAGE(PG8_SB(0, 0), cB, voffB); PG8_STAGE(PG8_SA(0, 0), cA, voffA); PG8_STAGE(PG8_SB(0, 1), cB + hstep, voffB); PG8_STAGE(PG8_SA(0, 1), cA + hstepA, voffA);
        if (wr == 1) PG8_BAR;
        PG8_WAIT_V(4); PG8_BAR;
        PG8_STAGE(PG8_SB(1, 0), cB + kstep, voffB); PG8_STAGE(PG8_SA(1, 0), cA + kstepA, voffA); PG8_STAGE(PG8_SB(1, 1), cB + hstep + kstep, voffB);
        PG8_WAIT_V(6); PG8_BAR;
    }
    for (;;) {
        const bool has_next = S.next(ui + 1, nxt);
        const char* nA = has_next ? (const char*)g.A + (size_t)nxt.pm * tstepA + (g.kstepA ? (size_t)(nxt.kofs >> 6) * kstepA : (size_t)nxt.kofs * 2) : cA; const char* nB = has_next ? (const char*)g.Bt + (size_t)nxt.pn * tstep + (size_t)nxt.kofs * 2 : cB;
        for (int t = 0; t < nt; t += 2) {
            const bool last = (t == nt - 2);
            const char* a1 = cA + (size_t)(t + 1) * kstepA;
            const char* a2 = last ? nA : cA + (size_t)(t + 2) * kstepA; const char* b2 = last ? nB : cB + (size_t)(t + 2) * kstep;
            const char* a3 = a2 + kstepA; const char* b3 = b2 + kstep;
            if (last && has_next) S.a_ready(nxt);
            if constexpr (SP2) {
            PG8_LDB(B0, 0, 0); PG8_LDB(B1, 0, 1); PG8_SCHED; PG8_LDA(At, 0, 0); PG8_STAGE(PG8_SA(1, 1), a1 + hstepA, voffA);
            PG8_WAIT_V(8); PG8_WAIT_L(0); PG8_BAR; PG8_MMA(0, 0, At, B0); PG8_MMA(0, 1, At, B1); PG8_BAR; PG8_SCHED;
            PG8_LDA(At, 0, 1); PG8_STAGE(PG8_SB(0, 0), b2, voffB); PG8_STAGE(PG8_SB(0, 1), b2 + hstep, voffB); PG8_STAGE(PG8_SA(0, 0), a2, voffA);
            PG8_WAIT_V(8); PG8_WAIT_L(0); PG8_BAR; PG8_MMA(1, 0, At, B0); PG8_MMA(1, 1, At, B1); PG8_BAR; PG8_SCHED;
            PG8_LDB(B0, 1, 0); PG8_LDB(B1, 1, 1); PG8_SCHED; PG8_LDA(At, 1, 0); PG8_STAGE(PG8_SA(0, 1), a2 + hstepA, voffA);
            PG8_WAIT_V(8); PG8_WAIT_L(0); PG8_BAR; PG8_MMA(0, 0, At, B0); PG8_MMA(0, 1, At, B1); PG8_BAR; PG8_SCHED;
            PG8_LDA(At, 1, 1); PG8_STAGE(PG8_SB(1, 0), b3, voffB); PG8_STAGE(PG8_SB(1, 1), b3 + hstep, voffB); PG8_STAGE(PG8_SA(1, 0), a3, voffA);
            PG8_WAIT_V(8); PG8_WAIT_L(0); PG8_BAR; PG8_MMA(1, 0, At, B0); PG8_MMA(1, 1, At, B1); PG8_BAR; PG8_SCHED;
            } else {
            PG8_LDB(B0, 0, 0); PG8_SCHED; PG8_LDA(At, 0, 0); PG8_STAGE(PG8_SA(1, 1), a1 + hstepA, voffA);
            PG8_WAIT_L(8); PG8_BAR; PG8_WAIT_L(0); PG8_MMA(0, 0, At, B0); PG8_BAR; PG8_SCHED;
            PG8_LDB(B1, 0, 1); PG8_STAGE(PG8_SB(0, 0), b2, voffB);
            PG8_BAR; PG8_WAIT_L(0); PG8_MMA(0, 1, At, B1); PG8_BAR;
            PG8_LDA(At, 0, 1); PG8_STAGE(PG8_SA(0, 0), a2, voffA);
            PG8_BAR; PG8_WAIT_L(0); PG8_MMA(1, 0, At, B0); PG8_BAR; PG8_SCHED;
            PG8_STAGE(PG8_SB(0, 1), b2 + hstep, voffB);
            PG8_WAIT_V(6); PG8_BAR; PG8_MMA(1, 1, At, B1); PG8_BAR;
            PG8_LDB(B0, 1, 0); PG8_SCHED; PG8_LDA(At, 1, 0); PG8_STAGE(PG8_SA(0, 1), a2 + hstepA, voffA);
            PG8_WAIT_L(8); PG8_BAR; PG8_WAIT_L(0); PG8_MMA(0, 0, At, B0); PG8_BAR; PG8_SCHED;
            PG8_LDB(B1, 1, 1); PG8_STAGE(PG8_SB(1, 0), b3, voffB);
            PG8_BAR; PG8_WAIT_L(0); PG8_MMA(0, 1, At, B1); PG8_BAR;
            PG8_LDA(At, 1, 1); PG8_STAGE(PG8_SA(1, 0), a3, voffA);
            PG8_BAR; PG8_WAIT_L(0); PG8_MMA(1, 0, At, B0); PG8_BAR; PG8_SCHED;
            PG8_STAGE(PG8_SB(1, 1), b3 + hstep, voffB);
            PG8_WAIT_V(6); PG8_BAR; PG8_MMA(1, 1, At, B1); PG8_BAR;
            }
        }
        if constexpr (ALIGN_EPI) { if (wr == 0) PG8_BAR; }
        if constexpr (!Epi::AFTER_DRAIN) { E(acc, cur, wr, wc, fr, fq); S.done(cur); }
        if (!has_next) break;
#pragma unroll
        for (int a = 0; a < 2; ++a)
#pragma unroll
            for (int b = 0; b < 2; ++b)
#pragma unroll
                for (int m = 0; m < 4; ++m)
#pragma unroll
                    for (int n = 0; n < 2; ++n) acc[a][b][m][n] = (f32x4){0.f, 0.f, 0.f, 0.f};
        cur = nxt; cA = nA; cB = nB; ++ui;
        if constexpr (ALIGN_EPI) { if (wr == 1) PG8_BAR; }
    }
    PG8_WAIT_V(0);
    if constexpr (!ALIGN_EPI) { if (wr == 0) PG8_BAR; }
    PG8_BAR;
    if constexpr (Epi::AFTER_DRAIN) { E.fused(acc, cur, wr, wc, fr, fq, lds, wid, lane); S.done(cur); }
#undef PG8_SA
#undef PG8_SB
#undef PG8_STAGE
#undef PG8_LDA
#undef PG8_LDB
#undef PG8_MMA
#undef PG8_WAIT_V
#undef PG8_WAIT_L
#undef PG8_BAR
#undef PG8_SCHED
}
}
constexpr int NWAVES = 8, NTHR = 512;
constexpr int DM = 1024, NB = 4, SEQ = 8192, CTXL = 256;
constexpr int RL = NB * SEQ, RC = NB * CTXL, RT = RL + RC;
constexpr int NIN_SRC = 2064, NIN = 2304;
constexpr int UC_Z = 0, UC_XBC = 512, UC_P = 1536, UC_Q = 1792, UC_POOL = 2048;
constexpr int SRC_DT = 1536, SRC_FNET = 1552, SRC_POOL = 1808;
constexpr int DFF = 2816, NUP = 5632, NHALF = 1408;
constexpr float LN_EPS = 1e-6f, ALPHA = 1.41421356237f;
constexpr int NLAYER = 2;

constexpr size_t MiB = 1u << 20;
constexpr size_t WS_CTL = 0, CTL_ZERO_BYTES = 1 * MiB;
constexpr size_t WS_ADA = 1 * MiB;
constexpr size_t WS_F = 2 * MiB;
constexpr size_t WS_WA = 2 * MiB + 512 * 1024, WS_WB = WS_WA + 32768, WS_TW = WS_WB + 65536;
constexpr size_t WS_WDT = WS_TW + 65536;
constexpr size_t WS_DTRAW = 3 * MiB;
constexpr size_t WS_WIN = 6 * MiB;
constexpr size_t WS_WOUT = 15 * MiB;
constexpr size_t WS_WUP = 19 * MiB;
constexpr size_t WS_WDOWN = 41 * MiB;
constexpr size_t WS_XCTX = 52 * MiB;
constexpr size_t WS_H = 56 * MiB;
constexpr size_t WS_SH = 122 * MiB;
constexpr size_t WS_U = WS_SH;
constexpr size_t WS_CONCAT = WS_SH + 149 * MiB;
constexpr size_t WS_SST = WS_SH + 215 * MiB;
constexpr size_t WS_HIN = WS_SH + 281 * MiB;
constexpr size_t WS_YFFT = WS_SH + 347 * MiB;
constexpr size_t WS_DEC = 5 * MiB + 512 * 1024;
constexpr size_t WS_MIX = WS_SH;
constexpr size_t WS_AH = WS_SH;
constexpr size_t WS_G = WS_SH + 193 * MiB;
constexpr size_t WS_SLAB = WS_SH + 68 * MiB;
constexpr size_t WS_FFNO = WS_SH;
constexpr size_t WS_XBC = WS_SH + 379 * MiB;
constexpr size_t WS_DTCS = WS_SH + 381 * MiB;
constexpr size_t WS_END = 512 * MiB;
static_assert(WS_YFFT + 32 * MiB <= WS_XBC && WS_XBC + 2 * MiB <= WS_DTCS && WS_DTCS + 5 * MiB <= WS_END && WS_G + 182 * MiB <= WS_END, "ws map");
constexpr int CW_TMO = 0, CW_CODE = 1, CW_BAR = 4096;

constexpr int RING_BYTES = 131072, LDSCTL_OFF = 152576, MISC_OFF = LDSCTL_OFF + 320, LDS_BYTES = 156672;
#define GAS __attribute__((address_space(1)))
#define LAS __attribute__((address_space(3)))
typedef unsigned short bf16;
typedef unsigned v4u __attribute__((ext_vector_type(4)));
typedef float f32x4 __attribute__((ext_vector_type(4)));
typedef short bf16x8 __attribute__((ext_vector_type(8)));
typedef GAS unsigned gu32;
typedef GAS unsigned long long gu64;
#define RLX_AGENT __ATOMIC_RELAXED, __HIP_MEMORY_SCOPE_AGENT
#define LDS_WAIT() asm volatile("s_waitcnt lgkmcnt(0)" ::: "memory")
#define VM_WAIT() asm volatile("s_waitcnt vmcnt(0)" ::: "memory")
__device__ __forceinline__ unsigned long long rt() { return __builtin_amdgcn_s_memrealtime(); }
typedef __bf16 hwbf2 __attribute__((ext_vector_type(2)));
typedef float hwf2 __attribute__((ext_vector_type(2)));
__device__ __forceinline__ unsigned pk2(float lo, float hi) { const hwf2 v = {lo, hi}; return __builtin_bit_cast(unsigned, __builtin_convertvector(v, hwbf2)); }
__device__ __forceinline__ unsigned f2bf(float f) { return pk2(f, 0.f) & 0xffffu; }

#define XB_TMO      128
#define XB_XCNT(j)  (256  + 64 * (j))
#define XB_XSUB(j)  (1280 + 64 * (j))
#define XB_XGEN(j)  (2304 + 64 * (j))
#define XB_TOP      3328
#define XB_TOPGEN   3392
#define XCD_BAR_WORDS 3456
#define XB_SPIN_CAP (1u << 18)

__device__ __forceinline__ unsigned xb_ld(unsigned* p)              { return __hip_atomic_load(p, __ATOMIC_RELAXED, __HIP_MEMORY_SCOPE_AGENT); }
__device__ __forceinline__ unsigned xb_add(unsigned* p, unsigned v) { return __hip_atomic_fetch_add(p, v, __ATOMIC_RELAXED, __HIP_MEMORY_SCOPE_AGENT); }
__device__ __forceinline__ unsigned xb_xcc_id() { return (unsigned)__builtin_amdgcn_s_getreg((3 << 11) | 20) & 0xFu; }
#define XB_SPIN(cond, bar) do { unsigned _sp = 0; while (cond) { __builtin_amdgcn_s_sleep(1); \
    if ((++_sp & 255u) == 0u) { if (xb_ld(&(bar)[XB_TMO])) break; if (_sp > XB_SPIN_CAP) { atomicAdd(&(bar)[XB_TMO], 1u); break; } } } } while (0)

struct XcdBarrier {
    unsigned* bar; unsigned x;
    volatile LAS unsigned* st;
};

__device__ __forceinline__ XcdBarrier xcd_barrier_post(unsigned* bar, volatile LAS unsigned* st) {
    XcdBarrier b; b.bar = bar; b.x = xb_xcc_id(); b.st = st;
    if (threadIdx.x == 0) (void)xb_add(&bar[XB_XCNT(b.x)], 1u);
    return b;
}
__device__ __forceinline__ void xcd_barrier_complete(unsigned* bar, unsigned x, unsigned& nloc, unsigned& nx) {
    const unsigned G = gridDim.x * gridDim.y * gridDim.z;
    unsigned sum, cnt, mine, sp = 0u;
    for (;;) {
        sum = 0u; cnt = 0u; mine = 0u;
#pragma unroll
        for (unsigned j = 0; j < 16; ++j) { const unsigned c = xb_ld(&bar[XB_XCNT(j)]); sum += c; cnt += (c > 0u) ? 1u : 0u; mine = (j == x) ? c : mine; }
        if (sum == G) break;
        __builtin_amdgcn_s_sleep(1);
        if ((++sp & 255u) == 0u) { if (xb_ld(&bar[XB_TMO])) break; if (sp > XB_SPIN_CAP) { atomicAdd(&bar[XB_TMO], 1u); break; } }
    }
    nloc = mine > 0u ? mine : 1u; nx = cnt > 0u ? cnt : 1u;
}

__device__ __forceinline__ void xcd_barrier(const XcdBarrier& b) {
    asm volatile("s_waitcnt vmcnt(0)" ::: "memory");
    __syncthreads();
    if (threadIdx.x == 0) {
        unsigned* bar = b.bar;
        __builtin_amdgcn_s_waitcnt(0);
        unsigned nloc = b.st[0], nx = b.st[1];
        if (nloc == 0u) { xcd_barrier_complete(bar, b.x, nloc, nx); b.st[0] = nloc; b.st[1] = nx; }
        const unsigned old = xb_add(&bar[XB_XSUB(b.x)], 1u);
        const unsigned gen = old / nloc;
        if (old + 1u == (gen + 1u) * nloc) {
            __builtin_amdgcn_fence(__ATOMIC_RELEASE, "agent");
            asm volatile("s_waitcnt vmcnt(0)" ::: "memory");
            const unsigned og = xb_add(&bar[XB_TOP], 1u);
            const unsigned tg = og / nx;
            if (og + 1u == (tg + 1u) * nx) {
#pragma unroll
                for (unsigned j = 0; j < 16; ++j) xb_add(&bar[XB_XGEN(j)], 1u);
            }
            XB_SPIN(xb_ld(&bar[XB_XGEN(b.x)]) == gen, bar);
            __builtin_amdgcn_fence(__ATOMIC_ACQUIRE, "agent");
            asm volatile("s_waitcnt vmcnt(0)" ::: "memory");
        } else {
            XB_SPIN(xb_ld(&bar[XB_XGEN(b.x)]) == gen, bar);
            __builtin_amdgcn_fence(__ATOMIC_ACQUIRE, "agent");
            asm volatile("s_waitcnt vmcnt(0)" ::: "memory");
        }
    }
    __syncthreads();
}
typedef unsigned u32x2 __attribute__((ext_vector_type(2)));
__device__ __forceinline__ float bf2f(unsigned short b) { return __uint_as_float((unsigned)b << 16); }
__device__ __forceinline__ float bflo(unsigned w) { return __uint_as_float(w << 16); }
__device__ __forceinline__ float bfhi(unsigned w) { return __uint_as_float(w & 0xffff0000u); }
__device__ __forceinline__ float silu_f(float x) { return x * __builtin_amdgcn_rcpf(1.f + __expf(-x)); }
__device__ __forceinline__ float gelu_tanh_f(float x) { const float t = x * x, u = __builtin_fmaf(t, -0.10294324f, -2.30220819f); return x * __builtin_amdgcn_rcpf(1.f + __builtin_amdgcn_exp2f(x * u)); }
__device__ __forceinline__ float softplus_f(float x) { return x > 20.f ? x : log1pf(expf(x)); }
#define DPP_ADD(v, ctrl) ((v) + __builtin_bit_cast(float, __builtin_amdgcn_update_dpp(0, __builtin_bit_cast(int, (v)), (ctrl), 0xf, 0xf, false)))
__device__ __forceinline__ float rdl(float v, const int l) { return __builtin_bit_cast(float, __builtin_amdgcn_readlane(__builtin_bit_cast(int, v), l)); }
__device__ __forceinline__ float wave_sum(float v) {
    v = DPP_ADD(v, 0xB1); v = DPP_ADD(v, 0x4E); v = DPP_ADD(v, 0x141); v = DPP_ADD(v, 0x140);
    return (rdl(v, 0) + rdl(v, 16)) + (rdl(v, 32) + rdl(v, 48));
}
__device__ __forceinline__ void unpack8(const v4u w, float (&f)[8]) { f[0] = bflo(w.x); f[1] = bfhi(w.x); f[2] = bflo(w.y); f[3] = bfhi(w.y); f[4] = bflo(w.z); f[5] = bfhi(w.z); f[6] = bflo(w.w); f[7] = bfhi(w.w); }
__device__ __forceinline__ v4u pack8(const float (&f)[8]) { v4u w; w.x = pk2(f[0], f[1]); w.y = pk2(f[2], f[3]); w.z = pk2(f[4], f[5]); w.w = pk2(f[6], f[7]); return w; }

struct Frame {
    LAS unsigned char* lds; volatile LAS unsigned* MISC; gu32* ctl;
    int G;
    float* out;
    unsigned char* ws;
};
#define WSP(T, off) ((T*)(F.ws + (off)))
#define PH_IDS() int tid = threadIdx.x; asm volatile("" : "+v"(tid)); const int lane = tid & 63; const int wave = __builtin_amdgcn_readfirstlane(tid >> 6); int bid = blockIdx.x; asm volatile("" : "+s"(bid)); (void)lane; (void)wave; (void)bid;
__device__ __forceinline__ const float* inp_ptr(int i) { asm volatile("" : "+s"(i)); return ((const float* const __attribute__((address_space(4)))*)__builtin_amdgcn_kernarg_segment_ptr())[i]; }
enum { I_x = 0, I_c, I_ctx, I_c_ctx, I_w_ada, I_b_ada, I_w_in, I_ssd_conv_w, I_ssd_conv_b, I_ssd_dt_bias, I_ssd_a_log, I_ssd_d, I_ssd_norm_w, I_fnet_w, I_pool_w, I_pool_scale, I_w_out, I_ln1_g, I_ln1_b, I_ffn_w_up, I_ffn_conv_w, I_ffn_conv_b, I_ffn_w_down, I_ln2_g, I_ln2_b };

struct RowInfo { int pos, L, v, base; };
__device__ __forceinline__ RowInfo row_info(int row) {
    RowInfo r;
    if (row < RL) { r.pos = row & (SEQ - 1); r.L = SEQ; r.v = row >> 13; r.base = row & ~(SEQ - 1); }
    else { const int rr = row - RL; r.pos = rr & (CTXL - 1); r.L = CTXL; r.v = 4; r.base = RL + (rr & ~(CTXL - 1)); }
    return r;
}
__device__ __forceinline__ float* stream_row(Frame& F, int row) { return row < RL ? F.out + (size_t)row * DM : WSP(float, WS_XCTX) + (size_t)(row - RL) * DM; }
__device__ __forceinline__ const float* input_row(Frame& F, int row) { return row < RL ? inp_ptr(I_x) + (size_t)row * DM : inp_ptr(I_ctx) + (size_t)(row - RL) * DM; }

__device__ __forceinline__ void fft_tables(Frame& F, const int tid, const int bid);
struct TrItem { const float* W; int ldw; bf16* WT; int ldt; };
__device__ __forceinline__ TrItem tr_decode(Frame& F, int it) {
    constexpr int I_IN = 48 * 16, I_OUT = 32 * 16, I_UP = 176 * 16, I_DN = 32 * 44, I_L = I_IN + I_OUT + I_UP + I_DN;
    const int l = it / I_L; int r = it % I_L;
    if (r < I_IN) { const int kb = r / 48, nb = r % 48;
        return TrItem{inp_ptr(I_w_in) + (size_t)l * DM * NIN_SRC + (size_t)(64 * kb) * NIN_SRC + 32 * nb, NIN_SRC, WSP(bf16, WS_WIN) + (size_t)l * NIN * DM + (size_t)(32 * nb) * DM + 64 * kb, DM}; }
    r -= I_IN;
    if (r < I_OUT) { const int kb = r / 32, nb = r % 32;
        return TrItem{inp_ptr(I_w_out) + (size_t)l * DM * DM + (size_t)(64 * kb) * DM + 32 * nb, DM, WSP(bf16, WS_WOUT) + (size_t)l * DM * DM + (size_t)(32 * nb) * DM + 64 * kb, DM}; }
    r -= I_OUT;
    if (r < I_UP) { const int kb = r / 176, nb = r % 176, ti = nb >> 3, w8 = nb & 7; const int scol = ((w8 & 2) ? DFF : 0) + 128 * ti + 64 * (w8 >> 2) + 32 * (w8 & 1);
        return TrItem{inp_ptr(I_ffn_w_up) + (size_t)l * DM * NUP + (size_t)(64 * kb) * NUP + scol, NUP, WSP(bf16, WS_WUP) + (size_t)l * NUP * DM + (size_t)(32 * nb) * DM + 64 * kb, DM}; }
    r -= I_UP;
    { const int kb = r / 32, nb = r % 32;
        return TrItem{inp_ptr(I_ffn_w_down) + (size_t)l * DFF * DM + (size_t)(64 * kb) * DM + 32 * nb, DM, WSP(bf16, WS_WDOWN) + (size_t)l * DM * DFF + (size_t)(32 * nb) * DFF + 64 * kb, DFF}; }
}
__device__ __forceinline__ void tr_load(const TrItem d, const int lane, f32x4 (&rg)[8]) {
#pragma unroll
    for (int i = 0; i < 8; ++i) { const int v = lane + 64 * i; rg[i] = *(const f32x4*)(d.W + (size_t)(v >> 3) * d.ldw + 4 * (v & 7)); }
}
__device__ __forceinline__ void p0a(Frame& F) {
    PH_IDS();
    {
        LAS float* sc = (LAS float*)F.lds; LAS float* red = (LAS float*)(F.lds + 20480);
        bool first = true;
        for (int unit = bid; unit < 192; unit += F.G) {
            if (first) { for (int i = tid; i < 5 * 1024; i += NTHR) { const int v = i >> 10, k = i & 1023; const float cv = v < 4 ? inp_ptr(I_c)[v * 1024 + k] : inp_ptr(I_c_ctx)[k]; sc[i] = cv / (1.f + expf(-cv)); } __syncthreads(); first = false; }
            const int l = unit / 96, jg = unit % 96;
            const float* w = inp_ptr(I_w_ada) + (size_t)l * 1024 * 6144 + jg * 64 + lane;
            float acc[5] = {0.f, 0.f, 0.f, 0.f, 0.f};
#pragma unroll 64
            for (int kk = 0; kk < 128; ++kk) { const int k = wave * 128 + kk; const float wv = w[(size_t)k * 6144];
#pragma unroll
                for (int v = 0; v < 5; ++v) acc[v] += sc[v * 1024 + k] * wv; }
#pragma unroll
            for (int v = 0; v < 5; ++v) red[(wave * 5 + v) * 64 + lane] = acc[v];
            __syncthreads();
            if (tid < 320) { const int v = tid >> 6, ln = tid & 63; float s = inp_ptr(I_b_ada)[l * 6144 + jg * 64 + ln];
#pragma unroll
                for (int w8 = 0; w8 < 8; ++w8) s += red[(w8 * 5 + v) * 64 + ln];
                WSP(float, WS_ADA)[(l * 5 + v) * 6144 + jg * 64 + ln] = s; }
            __syncthreads();
        }
        __syncthreads();
    }
    {
        LAS float* scr = (LAS float*)(F.lds + wave * 16384);
        const int gw = bid * NWAVES + wave, NGW = F.G * NWAVES;
        constexpr int NIT = NLAYER * (48 * 16 + 32 * 16 + 176 * 16 + 32 * 44);
        f32x4 rg[8];
        if (gw < NIT) tr_load(tr_decode(F, gw), lane, rg);
        for (int it = gw; it < NIT; it += NGW) {
            const TrItem d = tr_decode(F, it);
#pragma unroll
            for (int i = 0; i < 8; ++i) { const int v = lane + 64 * i; LAS float* s = scr + (v >> 3) * 33 + 4 * (v & 7); s[0] = rg[i].x; s[1] = rg[i].y; s[2] = rg[i].z; s[3] = rg[i].w; }
            LDS_WAIT(); asm volatile("" ::: "memory");
            if (it + NGW < NIT) tr_load(tr_decode(F, it + NGW), lane, rg);
            const int c = lane & 7;
#pragma unroll
            for (int j = 0; j < 4; ++j) { const int n = (lane >> 3) + 8 * j; const LAS float* s = scr + (8 * c) * 33 + n;
                v4u o; o.x = pk2(s[0 * 33], s[1 * 33]); o.y = pk2(s[2 * 33], s[3 * 33]); o.z = pk2(s[4 * 33], s[5 * 33]); o.w = pk2(s[6 * 33], s[7 * 33]);
                *(GAS v4u*)(d.WT + (size_t)n * d.ldt + 8 * c) = o; }
            LDS_WAIT(); asm volatile("" ::: "memory");
        }
    }
    {
        LAS float* tw = (LAS float*)F.lds;
        __syncthreads();
        if (tid < 64) { tw[tid] = cospif((float)tid * (1.f / 32.f)); tw[64 + tid] = sinpif((float)tid * (1.f / 32.f)); }
        __syncthreads();
        const int gt = bid * NTHR + tid, NGT = F.G * NTHR;
        for (int it = gt; it < NLAYER * 3 * 4 * 4096; it += NGT) {
            const int d = it & 63, c = (it >> 6) & 63, g = (it >> 12) & 3, wl = it >> 14, which = wl % 3, l = wl / 3;
            float s = 0.f;
            if (which == 2) s = inp_ptr(I_pool_w)[((size_t)(l * 4 + g) * 64 + c) * 64 + d] * inp_ptr(I_pool_scale)[l * 256 + g * 64 + d];
            else { const float* fw = inp_ptr(I_fnet_w) + (size_t)(l * 4 + g) * 4096 + d; const LAS float* tb = tw + (which == 0 ? 0 : 64);
#pragma unroll
                for (int m = 0; m < 64; ++m) s += tb[(c * m) & 63] * fw[m * 64];
                s *= 0.125f; }
            WSP(float, WS_F)[it] = s;
        }
        __syncthreads();
    }
    fft_tables(F, tid, bid);
    {
        const int gt2 = bid * NTHR + tid, NGT2 = F.G * NTHR;
        for (int it = gt2; it < NLAYER * 16 * 1024; it += NGT2) { const int o = it & 15, k = (it >> 4) & 1023, l = it >> 14;
            const float w = inp_ptr(I_w_in)[(size_t)l * DM * NIN_SRC + (size_t)k * NIN_SRC + SRC_DT + o]; const unsigned hi = f2bf(w); const float wl = w - bflo(hi);
            WSP(bf16, WS_WDT)[((size_t)(l * 2 + 0) * 16 + o) * 1024 + k] = (bf16)hi; WSP(bf16, WS_WDT)[((size_t)(l * 2 + 1) * 16 + o) * 1024 + k] = (bf16)f2bf(wl); }
    }
}

__device__ __forceinline__ void ln_normalize(f32x4 (&v)[4]) {
    float s = 0.f;
#pragma unroll
    for (int j = 0; j < 4; ++j) s += (v[j].x + v[j].y) + (v[j].z + v[j].w);
    const float mean = wave_sum(s) * (1.f / DM); float s2 = 0.f;
#pragma unroll
    for (int j = 0; j < 4; ++j) { v[j] = v[j] - mean; s2 += (v[j].x * v[j].x + v[j].y * v[j].y) + (v[j].z * v[j].z + v[j].w * v[j].w); }
    const float rstd = 1.f / sqrtf(wave_sum(s2) * (1.f / DM) + LN_EPS);
#pragma unroll
    for (int j = 0; j < 4; ++j) v[j] = v[j] * rstd;
}
__device__ __forceinline__ void mod_store_dt(Frame& F, const int lane, const f32x4 (&xn)[4], const f32x4 (&shv)[4], const f32x4 (&scv)[4], bf16* hrow, bool do_dt, float* dtrow, const LAS float* wdtT) {
    f32x4 h[4];
#pragma unroll
    for (int j = 0; j < 4; ++j) { h[j] = xn[j] * (scv[j] + 1.f) + shv[j];
        u32x2 w; w.x = pk2(h[j].x, h[j].y); w.y = pk2(h[j].z, h[j].w); *(u32x2*)(hrow + 256 * j + 4 * lane) = w; }
    if (do_dt) {
        float mine = 0.f;
#pragma unroll
        for (int o = 0; o < 16; ++o) { float a = 0.f;
#pragma unroll
            for (int j = 0; j < 4; ++j) { const f32x4 w = *(const LAS f32x4*)(wdtT + o * 1024 + 256 * j + 4 * lane); a += (h[j].x * w.x + h[j].y * w.y) + (h[j].z * w.z + h[j].w * w.w); }
            a = wave_sum(a); if (lane == o) mine = a; }
        if (lane < 16) dtrow[lane] = mine;
    }
}
__device__ __forceinline__ void load_vec4_nt(const float* p, const int lane, f32x4 (&v)[4]) {
#pragma unroll
    for (int j = 0; j < 4; ++j) v[j] = __builtin_nontemporal_load((const f32x4*)(p + 256 * j + 4 * lane));
}
__device__ __forceinline__ void load_vec4(const float* p, const int lane, f32x4 (&v)[4]) {
#pragma unroll
    for (int j = 0; j < 4; ++j) v[j] = *(const f32x4*)(p + 256 * j + 4 * lane);
}
__device__ __forceinline__ void stage_wdt(Frame& F, const int tid, int l, LAS float* wdtT) {
    for (int i = tid; i < 16384; i += NTHR) { const int k = i >> 4, o = i & 15; wdtT[o * 1024 + k] = inp_ptr(I_w_in)[(size_t)l * DM * NIN_SRC + (size_t)k * NIN_SRC + SRC_DT + o]; }
}
__device__ __forceinline__ void p0b(Frame& F) {
    PH_IDS();
    {
        LAS float* scr = (LAS float*)(F.lds + wave * 16384);
        const int gw = bid * NWAVES + wave, NGW = F.G * NWAVES;
        for (int it = gw; it < NLAYER * 3 * 4 * 16 * 2; it += NGW) {
            const int nb2 = it & 1, kb = (it >> 1) & 15, g = (it >> 5) & 3, wl = it >> 7, which = wl % 3, l = wl / 3;
            const int soff = (which == 2 ? SRC_POOL : SRC_FNET) + 64 * g, drow = (which == 0 ? UC_P : which == 1 ? UC_Q : UC_POOL) + 64 * g + 32 * nb2;
            const float* W = inp_ptr(I_w_in) + (size_t)l * DM * NIN_SRC + (size_t)(64 * kb) * NIN_SRC + soff;
#pragma unroll
            for (int i = 0; i < 16; ++i) { const int v = lane + 64 * i; *(LAS f32x4*)(scr + (v >> 4) * 64 + 4 * (v & 15)) = *(const f32x4*)(W + (size_t)(v >> 4) * NIN_SRC + 4 * (v & 15)); }
            LDS_WAIT(); asm volatile("" ::: "memory");
            const float* Fm = WSP(float, WS_F) + (size_t)((l * 3 + which) * 4 + g) * 4096 + 32 * nb2;
            const int d = lane & 31, kh = lane >> 5;
            bf16* orow = WSP(bf16, WS_WIN) + (size_t)l * NIN * DM + (size_t)(drow + d) * DM + 64 * kb + 32 * kh;
            float acc[4][8];
#pragma unroll
            for (int k8 = 0; k8 < 4; ++k8)
#pragma unroll
                for (int q = 0; q < 8; ++q) acc[k8][q] = 0.f;
#pragma unroll 1
            for (int ch = 0; ch < 4; ++ch) {
                float fc[16];
#pragma unroll
                for (int cc = 0; cc < 16; ++cc) fc[cc] = Fm[(16 * ch + cc) * 64 + d];
#pragma unroll
                for (int k8 = 0; k8 < 4; ++k8)
#pragma unroll
                    for (int q = 0; q < 8; ++q) { const LAS float* wr = scr + (32 * kh + 8 * k8 + q) * 64 + 16 * ch; float s = acc[k8][q];
#pragma unroll
                        for (int c4 = 0; c4 < 4; ++c4) { const f32x4 w = *(const LAS f32x4*)(wr + 4 * c4); s += (w.x * fc[4 * c4] + w.y * fc[4 * c4 + 1]) + (w.z * fc[4 * c4 + 2] + w.w * fc[4 * c4 + 3]); }
                        acc[k8][q] = s; }
            }
#pragma unroll
            for (int k8 = 0; k8 < 4; ++k8) *(GAS v4u*)(orow + 8 * k8) = pack8(acc[k8]);
            LDS_WAIT(); asm volatile("" ::: "memory");
        }
    }
    __syncthreads();
    LAS float* wdtT = (LAS float*)F.lds;
    const int gw = bid * NWAVES + wave, NGW = F.G * NWAVES;
    {
        f32x4 xnx[4], xny[4], xnz[4], shv[4], scv[4]; int cur_v = -1;
        constexpr int NFW = NLAYER * 3 * 4 * 16 * 2, R1 = NFW * 13;
        int rb0, rst, rend;
        if (NGW > NFW && R1 < RT) { if (gw < NFW) { rb0 = gw; rst = NFW; rend = R1; } else { rb0 = R1 + gw - NFW; rst = NGW - NFW; rend = RT; } }
        else { rb0 = gw; rst = NGW; rend = RT; }
        if (rb0 < rend) load_vec4_nt(input_row(F, rb0), lane, xnx);
        if (rb0 + rst < rend) load_vec4_nt(input_row(F, rb0 + rst), lane, xny);
        if (rb0 + 2 * rst < rend) load_vec4_nt(input_row(F, rb0 + 2 * rst), lane, xnz);
        for (int row = rb0; row < rend; row += rst) {
            const RowInfo ri = row_info(row);
            f32x4 v[4];
#pragma unroll
            for (int j = 0; j < 4; ++j) { v[j] = xnx[j]; xnx[j] = xny[j]; xny[j] = xnz[j]; }
            if (row + 3 * rst < rend) load_vec4_nt(input_row(F, row + 3 * rst), lane, xnz);
            if (ri.v != cur_v) { const float* ad = WSP(float, WS_ADA) + (size_t)(0 * 5 + ri.v) * 6144; load_vec4(ad, lane, shv); load_vec4(ad + 1024, lane, scv); cur_v = ri.v; }
            ln_normalize(v);
            mod_store_dt(F, lane, v, shv, scv, WSP(bf16, WS_H) + (size_t)row * DM, false, WSP(float, WS_DTRAW) + (size_t)row * 16, wdtT);
        }
    }
}
typedef _Float16 pn_h2 __attribute__((ext_vector_type(2)));
typedef float pn_f2 __attribute__((ext_vector_type(2)));
__device__ __forceinline__ unsigned pkh2(float a, float b) { return __builtin_bit_cast(unsigned, __builtin_convertvector((pn_f2){a, b}, pn_h2)); }
__device__ __forceinline__ float hlo(unsigned w) { return (float)__builtin_bit_cast(pn_h2, w).x; }
__device__ __forceinline__ float hhi(unsigned w) { return (float)__builtin_bit_cast(pn_h2, w).y; }
template <bool SRC_F32, bool DST_F32>
__device__ __forceinline__ void post_norm_pass(Frame& F, int l, int which, int nrows, const bf16* M) {
    PH_IDS();
    constexpr bool has_next = !DST_F32;
    const bool do_dt = false;
    LAS float* wdtT = (LAS float*)F.lds;
    const float* gam = (which == 0 ? inp_ptr(I_ln1_g) : inp_ptr(I_ln2_g)) + l * DM; const float* bet = (which == 0 ? inp_ptr(I_ln1_b) : inp_ptr(I_ln2_b)) + l * DM;
    const int gw = bid * NWAVES + wave, NGW = F.G * NWAVES;
    f32x4 xn[4], xn2[4]; u32x2 hn[4], hn2[4], mn[4], mn2[4];
    f32x4 gmv[4], btv[4], gtv[4], shv[4], scv[4]; int cur_v = -1;
    load_vec4(gam, lane, gmv); load_vec4(bet, lane, btv);
    const unsigned char* sbase = (const unsigned char*)F.out;
#define PN_LOAD(xd, hd, md, rr) do { const int r_ = (rr); if (r_ < nrows) { const bf16* mi = M + (size_t)r_ * DM; \
        if constexpr (SRC_F32) { const float* xi = input_row(F, r_); _Pragma("unroll") for (int j = 0; j < 4; ++j) xd[j] = __builtin_nontemporal_load((const f32x4*)(xi + 256 * j + 4 * lane)); } \
        else { const unsigned char* xi = sbase + (size_t)r_ * 4096; _Pragma("unroll") for (int j = 0; j < 4; ++j) hd[j] = __builtin_nontemporal_load((const u32x2*)(xi + 512 * j + 8 * lane)); } \
        _Pragma("unroll") for (int j = 0; j < 4; ++j) md[j] = __builtin_nontemporal_load((const u32x2*)(mi + 256 * j + 4 * lane)); } } while (0)
    PN_LOAD(xn, hn, mn, gw); PN_LOAD(xn2, hn2, mn2, gw + NGW);
    for (int row = gw; row < nrows; row += NGW) {
        const RowInfo ri = row_info(row);
        f32x4 xc[4]; u32x2 mc[4];
#pragma unroll
        for (int j = 0; j < 4; ++j) {
            if constexpr (SRC_F32) { xc[j] = xn[j]; xn[j] = xn2[j]; }
            else { const u32x2 hw = hn[j]; xc[j] = (f32x4){hlo(hw.x), hhi(hw.x), hlo(hw.y), hhi(hw.y)}; hn[j] = hn2[j]; }
            mc[j] = mn[j]; mn[j] = mn2[j]; }
        PN_LOAD(xn2, hn2, mn2, row + 2 * NGW);
        if (ri.v != cur_v) { const float* ad = WSP(float, WS_ADA) + (size_t)(l * 5 + ri.v) * 6144; load_vec4(ad + (which == 0 ? 2048 : 5120), lane, gtv);
            if (has_next) { const float* ad2 = (which == 0) ? ad + 3072 : WSP(float, WS_ADA) + (size_t)((l + 1) * 5 + ri.v) * 6144; load_vec4(ad2, lane, shv); load_vec4(ad2 + 1024, lane, scv); }
            cur_v = ri.v; }
        f32x4 v[4];
#pragma unroll
        for (int j = 0; j < 4; ++j) { const f32x4 xv = xc[j], gv = gtv[j]; const u32x2 mw = mc[j];
            v[j].x = ALPHA * xv.x + gv.x * bflo(mw.x); v[j].y = ALPHA * xv.y + gv.y * bfhi(mw.x); v[j].z = ALPHA * xv.z + gv.z * bflo(mw.y); v[j].w = ALPHA * xv.w + gv.w * bfhi(mw.y); }
        ln_normalize(v);
        if constexpr (DST_F32) { float* xout = F.out + (size_t)row * DM;
#pragma unroll
            for (int j = 0; j < 4; ++j) { v[j] = v[j] * gmv[j] + btv[j]; __builtin_nontemporal_store(v[j], (f32x4*)(xout + 256 * j + 4 * lane)); } }
        else { unsigned char* xout = (unsigned char*)F.out + (size_t)row * 4096;
#pragma unroll
            for (int j = 0; j < 4; ++j) { v[j] = v[j] * gmv[j] + btv[j]; u32x2 w; w.x = pkh2(v[j].x, v[j].y); w.y = pkh2(v[j].z, v[j].w); __builtin_nontemporal_store(w, (u32x2*)(xout + 512 * j + 8 * lane)); } }
        if (has_next) {
            ln_normalize(v);
            mod_store_dt(F, lane, v, shv, scv, WSP(bf16, WS_H) + (size_t)row * DM, do_dt, WSP(float, WS_DTRAW) + (size_t)row * 16, wdtT);
        }
    }
#undef PN_LOAD
}

__device__ __forceinline__ void ctx_post_norm(Frame& F, int l, int which, int nsl, const bool wdt_staged) {
    PH_IDS();
    const bool do_dt = false; (void)wdt_staged;
    LAS float* wdtT = (LAS float*)F.lds;
    const float* gam = (which == 0 ? inp_ptr(I_ln1_g) : inp_ptr(I_ln2_g)) + l * DM; const float* bet = (which == 0 ? inp_ptr(I_ln1_b) : inp_ptr(I_ln2_b)) + l * DM;
    const float* ad = WSP(float, WS_ADA) + (size_t)(l * 5 + 4) * 6144;
    const float* ad2 = (which == 0) ? ad + 3072 : WSP(float, WS_ADA) + (size_t)((l + 1) * 5 + 4) * 6144;
    const int gw = bid * NWAVES + wave, NGW = F.G * NWAVES;
    for (int row = RL + gw; row < RT; row += NGW) {
        int ln = lane; asm volatile("" : "+v"(ln));
        const float* xin = (which == 0) ? input_row(F, row) : stream_row(F, row); float* xout = stream_row(F, row);
        const float* sl = WSP(float, WS_SLAB) + (size_t)(row - RL) * DM;
        f32x4 m[4], m1[4], gtv[4], xv[4], gmv[4], btv[4], shv[4], scv[4];
        load_vec4(sl, ln, m); load_vec4(sl + (size_t)RC * DM, ln, m1); load_vec4(ad + (which == 0 ? 2048 : 5120), ln, gtv); load_vec4(xin, ln, xv);
        load_vec4(gam, ln, gmv); load_vec4(bet, ln, btv); load_vec4(ad2, ln, shv); load_vec4(ad2 + 1024, ln, scv);
#pragma unroll 1
        for (int s0 = 2; s0 < nsl; s0 += 3) {
            f32x4 t0[4], t1[4], t2[4]; const bool h1 = s0 + 1 < nsl, h2 = s0 + 2 < nsl;
            load_vec4(sl + (size_t)s0 * RC * DM, ln, t0); load_vec4(sl + (size_t)(h1 ? s0 + 1 : s0) * RC * DM, ln, t1); load_vec4(sl + (size_t)(h2 ? s0 + 2 : s0) * RC * DM, ln, t2);
#pragma unroll
            for (int j = 0; j < 4; ++j) { m[j] += t0[j]; if (h1) m[j] += t1[j]; if (h2) m[j] += t2[j]; } }
        f32x4 v[4];
#pragma unroll
        for (int j = 0; j < 4; ++j) v[j] = xv[j] * ALPHA + gtv[j] * (m[j] + m1[j]);
        ln_normalize(v);
#pragma unroll
        for (int j = 0; j < 4; ++j) { v[j] = v[j] * gmv[j] + btv[j]; *(f32x4*)(xout + 256 * j + 4 * ln) = v[j]; }
        ln_normalize(v);
        mod_store_dt(F, ln, v, shv, scv, WSP(bf16, WS_H) + (size_t)row * DM, do_dt, WSP(float, WS_DTRAW) + (size_t)row * 16, wdtT);
    }
}

typedef short dt_bf16x8 __attribute__((ext_vector_type(8)));
__device__ __forceinline__ void dt_mfma(Frame& F, int l, int first_block) {
    PH_IDS();
    if (bid < first_block) return;
    constexpr int DW_RS = 2064;
    for (int i = tid; i < 2 * 16 * 128; i += NTHR) { const int ro = i >> 7, k8 = i & 127; *(LAS v4u*)(F.lds + ro * DW_RS + k8 * 16) = *(const v4u*)(WSP(bf16, WS_WDT) + (size_t)(l * 2) * 16 * 1024 + (size_t)ro * 1024 + k8 * 8); }
    __syncthreads();
    const int c = lane & 15, q = lane >> 4;
    const LAS unsigned char* Wh = F.lds + c * DW_RS + q * 16; const LAS unsigned char* Wl = Wh + 16 * DW_RS;
    for (int t = (bid - first_block) * NWAVES + wave; t < RT / 16; t += (F.G - first_block) * NWAVES) {
        const bf16* Hr = WSP(bf16, WS_H) + (size_t)(16 * t + c) * DM + 8 * q;
        f32x4 acc = (f32x4){0.f, 0.f, 0.f, 0.f};
#pragma unroll 1
        for (int hb = 0; hb < 2; ++hb) {
            dt_bf16x8 av[16];
#pragma unroll
            for (int j = 0; j < 16; ++j) av[j] = *(const dt_bf16x8*)(Hr + 32 * (16 * hb + j));
#pragma unroll
            for (int j = 0; j < 16; ++j) { const int ks = 16 * hb + j; const dt_bf16x8 bh = *(const LAS dt_bf16x8*)(Wh + ks * 64), bl = *(const LAS dt_bf16x8*)(Wl + ks * 64);
                acc = __builtin_amdgcn_mfma_f32_16x16x32_bf16(av[j], bh, acc, 0, 0, 0); acc = __builtin_amdgcn_mfma_f32_16x16x32_bf16(av[j], bl, acc, 0, 0, 0); }
        }
        float* dr = WSP(float, WS_DTRAW) + (size_t)(16 * t + 4 * q) * 16 + c;
        dr[0] = acc.x; dr[16] = acc.y; dr[32] = acc.z; dr[48] = acc.w;
    }
    __syncthreads();
}
__device__ __forceinline__ void p2_rest(Frame& F, int l, int first_block) {
    PH_IDS();
    if (bid < first_block) return;
    const int gt = (bid - first_block) * NTHR + tid, NGT = (F.G - first_block) * NTHR;
    const bf16* U = WSP(bf16, WS_U);
    {
        constexpr int PL_PS = 528;
        const int prows = (l == 0 ? RT : RL), nun = prows >> 6, ustep = F.G - first_block;
        v4u pf[5];
#define POOL_LOAD(u) do { const RowInfo ri_ = row_info(64 * (u)); const bf16* Ub_ = U + (size_t)ri_.base * NIN + UC_POOL; \
            _Pragma("unroll") for (int i = 0; i < 5; ++i) { const int p = tid + 512 * i, rowi = p >> 5, c16 = p & 31, tt = ri_.pos - 8 + rowi; \
                pf[i] = (tt >= 0 && tt < ri_.L) ? *(const v4u*)(Ub_ + (size_t)tt * NIN + 8 * c16) : (v4u){0u, 0u, 0u, 0u}; } } while (0)
        int unit = bid - first_block;
        if (unit < nun) POOL_LOAD(unit);
        for (; unit < nun; unit += ustep) {
            __syncthreads();
#pragma unroll
            for (int i = 0; i < 5; ++i) { const int p = tid + 512 * i; *(LAS v4u*)(F.lds + (p >> 5) * PL_PS + (p & 31) * 16) = pf[i]; }
            __syncthreads();
            if (unit + ustep < nun) POOL_LOAD(unit + ustep);
            const RowInfo ri = row_info(64 * unit);
            const int gi = wave & 3, k8 = lane & 7, rq = (wave >> 2) * 8 + (lane >> 3), c8 = gi * 64 + k8 * 8, row0 = 64 * unit + 4 * rq;
            const int win = 2 << gi, left = win >> 1, right = win - 1 - left;
            const LAS unsigned char* lb = F.lds + (8 + 4 * rq) * PL_PS + c8 * 2;
            float s[4][8], self[4][8];
#pragma unroll
            for (int i = 0; i < 4; ++i)
#pragma unroll
                for (int q = 0; q < 8; ++q) s[i][q] = 0.f;
#define POOL_WIN(W) do { _Pragma("unroll") for (int j = 0; j < W + 3; ++j) { float uf[8]; unpack8(*(const LAS v4u*)(lb + (j - (W / 2)) * PL_PS), uf); \
                    _Pragma("unroll") for (int i = 0; i < 4; ++i) { if (j >= i && j <= i + W - 1) { _Pragma("unroll") for (int q = 0; q < 8; ++q) s[i][q] += uf[q]; } \
                        if (j == (W / 2) + i) { _Pragma("unroll") for (int q = 0; q < 8; ++q) self[i][q] = uf[q]; } } } } while (0)
            if (gi == 0) POOL_WIN(2); else if (gi == 1) POOL_WIN(4); else if (gi == 2) POOL_WIN(8); else POOL_WIN(16);
#undef POOL_WIN
#pragma unroll
            for (int i = 0; i < 4; ++i) { const int pos = ri.pos + 4 * rq + i, lo = max(pos - left, 0), hi = min(pos + right + 1, ri.L); const float inv = 1.f / (float)(hi - lo);
#pragma unroll
                for (int q = 0; q < 8; ++q) s[i][q] = s[i][q] * inv - self[i][q];
                *(v4u*)(WSP(bf16, WS_CONCAT) + (size_t)(row0 + i) * DM + 768 + c8) = pack8(s[i]); }
        }
#undef POOL_LOAD
        __syncthreads();
    }
    if (l == 0) {
        LAS float* st = (LAS float*)F.lds;
        for (int unit = bid - first_block; unit < NB * 64; unit += F.G - first_block) {
            const int b = unit >> 6, c4 = (unit & 63) * 4;
            __syncthreads();
            { const int t = tid & 255, part = tid >> 8; const u32x2 w = *(const u32x2*)(U + (size_t)(RL + b * CTXL + t) * NIN + (part ? UC_Q : UC_P) + c4);
              *(LAS f32x4*)(st + t * 8 + 4 * part) = (f32x4){bflo(w.x), bfhi(w.x), bflo(w.y), bfhi(w.y)}; }
            __syncthreads();
            const int k = tid & 255, half = tid >> 8;
            const float cr = cospif((float)k * (1.f / 128.f)), ci = sinpif((float)k * (1.f / 128.f));
            float wr = 1.f, wi = 0.f, y0 = 0.f, y1 = 0.f;
            const LAS float* sp = st + 2 * half;
#pragma unroll 8
            for (int t = 0; t < 256; ++t) { const float p0 = sp[t * 8], p1 = sp[t * 8 + 1], q0 = sp[t * 8 + 4], q1 = sp[t * 8 + 5];
                y0 += wr * p0 - wi * q0; y1 += wr * p1 - wi * q1;
                const float nwr = wr * cr - wi * ci; wi = wr * ci + wi * cr; wr = nwr; }
            *(unsigned*)(WSP(bf16, WS_CONCAT) + (size_t)(RL + b * CTXL + k) * DM + 512 + c4 + 2 * half) = pk2(y0 * 0.0625f, y1 * 0.0625f);
        }
        __syncthreads();
    }
}
typedef _Float16 h2v __attribute__((ext_vector_type(2)));
__device__ __forceinline__ h2v as_h2(unsigned w) { return __builtin_bit_cast(h2v, w); }
__device__ __forceinline__ h2v f2h2(float a, float b) { return __builtin_convertvector((pn_f2){a, b}, h2v); }
__device__ __forceinline__ void unpack8h(const v4u w, float (&f)[8]) { f[0] = hlo(w.x); f[1] = hhi(w.x); f[2] = hlo(w.y); f[3] = hhi(w.y); f[4] = hlo(w.z); f[5] = hhi(w.z); f[6] = hlo(w.w); f[7] = hhi(w.w); }
__device__ __forceinline__ void p7_conv_geglu_rows(Frame& F, const int tid, const int bid, int l, int t0, int ntiles, int nrows, int row_lo, int row_hi) {
    const int gt = bid * NTHR + tid, NGT = F.G * NTHR;
    const bf16* A = WSP(bf16, WS_AH);
    const float* cw = inp_ptr(I_ffn_conv_w) + (size_t)l * 9 * NUP; const float* cb = inp_ptr(I_ffn_conv_b) + (size_t)l * NUP;
    const int per_row = 16 * ntiles;
    for (int it = gt; it < (row_hi - row_lo) * per_row; it += NGT) {
        const int row = row_lo + it / per_row, c8 = (it % per_row) * 8; const int j = 128 * t0 + c8;
        const bf16* Ac = A + (size_t)(c8 >> 6) * nrows * 128 + (c8 & 63);
        const int pos = (row - RL) & (CTXL - 1);
        const bool okl = pos > 0, okr = pos < CTXL - 1;
        const bf16* ap = Ac + (size_t)row * 128;
        v4u av[3], ag[3]; f32x4 wv[3][2], wg[3][2], bv[2], bg[2];
        av[0] = *(const v4u*)(ap - (okl ? 128 : 0)); ag[0] = *(const v4u*)(ap - (okl ? 128 : 0) + 64);
        av[1] = *(const v4u*)ap; ag[1] = *(const v4u*)(ap + 64);
        av[2] = *(const v4u*)(ap + (okr ? 128 : 0)); ag[2] = *(const v4u*)(ap + (okr ? 128 : 0) + 64);
#pragma unroll
        for (int k = 0; k < 3; ++k) { const float* w = cw + (size_t)(3 + k) * NUP + j; wv[k][0] = *(const f32x4*)w; wv[k][1] = *(const f32x4*)(w + 4); wg[k][0] = *(const f32x4*)(w + DFF); wg[k][1] = *(const f32x4*)(w + DFF + 4); }
        bv[0] = *(const f32x4*)(cb + j); bv[1] = *(const f32x4*)(cb + j + 4); bg[0] = *(const f32x4*)(cb + DFF + j); bg[1] = *(const f32x4*)(cb + DFF + j + 4);
        float va[8] = {bv[0].x, bv[0].y, bv[0].z, bv[0].w, bv[1].x, bv[1].y, bv[1].z, bv[1].w}, ga[8] = {bg[0].x, bg[0].y, bg[0].z, bg[0].w, bg[1].x, bg[1].y, bg[1].z, bg[1].w};
#pragma unroll
        for (int k = 0; k < 3; ++k) { float vf[8], gf[8]; unpack8h(av[k], vf); unpack8h(ag[k], gf);
            const float msk = (k == 0 && !okl) || (k == 2 && !okr) ? 0.f : 1.f;
            const float wvv[8] = {wv[k][0].x, wv[k][0].y, wv[k][0].z, wv[k][0].w, wv[k][1].x, wv[k][1].y, wv[k][1].z, wv[k][1].w}, wgg[8] = {wg[k][0].x, wg[k][0].y, wg[k][0].z, wg[k][0].w, wg[k][1].x, wg[k][1].y, wg[k][1].z, wg[k][1].w};
#pragma unroll
            for (int q = 0; q < 8; ++q) { va[q] += wvv[q] * (vf[q] * msk); ga[q] += wgg[q] * (gf[q] * msk); } }
        float o[8];
#pragma unroll
        for (int q = 0; q < 8; ++q) o[q] = gelu_tanh_f(ga[q]) * va[q];
        *(v4u*)(WSP(bf16, WS_G) + ((size_t)(j >> 6) * RT + row) * 64 + (j & 63)) = pack8(o);
    }
}

constexpr int CT_PS = 272;
constexpr int CT2_PS = 288, CT2_TILE = 180 * CT2_PS;
__device__ __forceinline__ void p7_conv_geglu(Frame& F, int l, int t0, int ntiles, int nrows) {
    PH_IDS();
    const bf16* A = WSP(bf16, WS_AH); bf16* Gb = WSP(bf16, WS_G);
    const float* cw = inp_ptr(I_ffn_conv_w) + (size_t)l * 9 * NUP; const float* cb = inp_ptr(I_ffn_conv_b) + (size_t)l * NUP;
    const int NUNIT = NB * 8 * 8 * 2 * ntiles;
#define CT_DECODE(u, cch, tx, ty, bb) const int cch = (u) >> 8, tx = (u) & 7, ty = ((u) >> 3) & 7, bb = ((u) >> 6) & 3
    int tab[6];
#pragma unroll
    for (int i = 0; i < 6; ++i) { const int x = tid + 512 * i, pos = x >> 4, k16 = x & 15, hr = pos / 10, hc = pos - 10 * hr;
        tab[i] = (((hr * 64 + hc) * 256 + k16 * 16) << 5) | (hr == 0 ? 1 : 0) | (hr == 17 ? 2 : 0) | (hc == 0 ? 4 : 0) | (hc == 9 ? 8 : 0) | (x >= 180 * 16 ? 16 : 0); }
    const int dmy = 65 * 256 + (tid & 15) * 16;
#define CT_EDGES(ty_, tx_) (16 | ((ty_) == 0 ? 1 : 0) | ((ty_) == 7 ? 2 : 0) | ((tx_) == 0 ? 4 : 0) | ((tx_) == 7 ? 8 : 0))
#define CT_PREFETCH(P, u) do { CT_DECODE(u, cch_, tx_, ty_, bb_); const int em_ = CT_EDGES(ty_, tx_); \
        const unsigned char* tb_ = (const unsigned char*)(A + (size_t)cch_ * nrows * 128) + ((ptrdiff_t)(bb_ * SEQ + (16 * ty_ - 1) * 64 + 8 * tx_ - 1)) * 256; \
        _Pragma("unroll") for (int i = 0; i < 6; ++i) { const bool ok = (tab[i] & em_) == 0; P[i] = *(const v4u*)(tb_ + (ok ? (tab[i] >> 5) : dmy)); } } while (0)
#define CT_TOLDS(P, u, bo) do { CT_DECODE(u, cch_, tx_, ty_, bb_); (void)cch_; (void)bb_; const int em_ = CT_EDGES(ty_, tx_); \
        _Pragma("unroll") for (int i = 0; i < 6; ++i) { const bool ok = (tab[i] & em_) == 0; const v4u v = ok ? P[i] : (v4u){0u, 0u, 0u, 0u}; \
            if (i < 5 || tid < 320) *(LAS v4u*)(F.lds + (bo) + ((tid >> 4) + 32 * i) * CT2_PS + ((tid & 15) >> 3) * 128 + (tid & 7) * 16) = v; } } while (0)
    const int per = (NUNIT + F.G - 1) / F.G, ustart = bid * per, uend = min(ustart + per, NUNIT);
    int wcch = -1;
    h2v wv[9][2], wg[9][2], bv[2], bg[2];
    v4u pre[2][6];
    if (ustart < uend) {
        CT_PREFETCH(pre[0], ustart);
        if (ustart + 1 < uend) CT_PREFETCH(pre[1], ustart + 1);
        __syncthreads();
        CT_TOLDS(pre[0], ustart, 0);
        if (ustart + 2 < uend) CT_PREFETCH(pre[0], ustart + 2);
        __syncthreads();
        for (int u0 = ustart; u0 < uend; u0 += 2) {
#pragma unroll
          for (int sel = 0; sel < 2; ++sel) {
            const int unit = u0 + sel;
            if (unit < uend) {
            if (wave < 4) { if (unit + 1 < uend) CT_TOLDS(pre[sel ^ 1], unit + 1, (sel ^ 1) * CT2_TILE); if (unit + 3 < uend) CT_PREFETCH(pre[sel ^ 1], unit + 3); }
            CT_DECODE(unit, cch, tx, ty, bb);
            const int cg = tid & 15, pg = tid >> 4, r = pg >> 1, hf = pg & 1, j = 128 * t0 + 64 * cch + 4 * cg;
            if (cch != wcch) {
#pragma unroll
                for (int k = 0; k < 9; ++k) { const f32x4 a = *(const f32x4*)(cw + (size_t)k * NUP + j), g = *(const f32x4*)(cw + (size_t)k * NUP + DFF + j);
                    wv[k][0] = f2h2(a.x, a.y); wv[k][1] = f2h2(a.z, a.w); wg[k][0] = f2h2(g.x, g.y); wg[k][1] = f2h2(g.z, g.w); }
                { const f32x4 a = *(const f32x4*)(cb + j), g = *(const f32x4*)(cb + DFF + j); bv[0] = f2h2(a.x, a.y); bv[1] = f2h2(a.z, a.w); bg[0] = f2h2(g.x, g.y); bg[1] = f2h2(g.z, g.w); }
                wcch = cch; }
            const LAS unsigned char* lp = F.lds + sel * CT2_TILE + (r * 10 + 4 * hf) * CT2_PS + cg * 8;
            bf16* Go = Gb + ((size_t)(j >> 6) * RT + (bb * SEQ + (16 * ty + r) * 64 + 8 * tx + 4 * hf)) * 64 + (j & 63);
            h2v pv[2] = {bv[0], bv[1]}, pg_[2] = {bg[0], bg[1]}, cv[2] = {bv[0], bv[1]}, cg_[2] = {bg[0], bg[1]};
            u32x2 dn[6], dc[6];
#define CT_LDCOL(dst, xx) do { dst[0] = *(const LAS u32x2*)(lp + (xx) * CT2_PS); dst[1] = *(const LAS u32x2*)(lp + (xx) * CT2_PS + 128); dst[2] = *(const LAS u32x2*)(lp + (10 + (xx)) * CT2_PS); \
                dst[3] = *(const LAS u32x2*)(lp + (10 + (xx)) * CT2_PS + 128); dst[4] = *(const LAS u32x2*)(lp + (20 + (xx)) * CT2_PS); dst[5] = *(const LAS u32x2*)(lp + (20 + (xx)) * CT2_PS + 128); } while (0)
            CT_LDCOL(dn, 0);
#pragma unroll
            for (int xi = 0; xi < 6; ++xi) {
#pragma unroll
                for (int k = 0; k < 6; ++k) dc[k] = dn[k];
                if (xi < 5) CT_LDCOL(dn, xi + 1);
                h2v nv[2] = {bv[0], bv[1]}, ng[2] = {bg[0], bg[1]};
#pragma unroll
                for (int e = 0; e < 2; ++e) {
                    const h2v v0 = as_h2(e ? dc[0].y : dc[0].x), g0 = as_h2(e ? dc[1].y : dc[1].x), v1 = as_h2(e ? dc[2].y : dc[2].x), g1 = as_h2(e ? dc[3].y : dc[3].x), v2 = as_h2(e ? dc[4].y : dc[4].x), g2 = as_h2(e ? dc[5].y : dc[5].x);
                    pv[e] = wv[2][e] * v0 + pv[e]; pv[e] = wv[5][e] * v1 + pv[e]; pv[e] = wv[8][e] * v2 + pv[e];   pg_[e] = wg[2][e] * g0 + pg_[e]; pg_[e] = wg[5][e] * g1 + pg_[e]; pg_[e] = wg[8][e] * g2 + pg_[e];
                    cv[e] = wv[1][e] * v0 + cv[e]; cv[e] = wv[4][e] * v1 + cv[e]; cv[e] = wv[7][e] * v2 + cv[e];   cg_[e] = wg[1][e] * g0 + cg_[e]; cg_[e] = wg[4][e] * g1 + cg_[e]; cg_[e] = wg[7][e] * g2 + cg_[e];
                    nv[e] = wv[0][e] * v0 + nv[e]; nv[e] = wv[3][e] * v1 + nv[e]; nv[e] = wv[6][e] * v2 + nv[e];   ng[e] = wg[0][e] * g0 + ng[e]; ng[e] = wg[3][e] * g1 + ng[e]; ng[e] = wg[6][e] * g2 + ng[e];
                }
                if (xi >= 2) { u32x2 w;
#pragma unroll
                    for (int e = 0; e < 2; ++e) { const h2v g = pg_[e]; const h2v z = (g * g * (h2v){(_Float16)-0.1029432f, (_Float16)-0.1029432f} + (h2v){(_Float16)-2.3022082f, (_Float16)-2.3022082f}) * g;
                        const h2v d = __builtin_elementwise_exp2(z) + (h2v){(_Float16)1.f, (_Float16)1.f}; h2v rr; rr.x = __builtin_amdgcn_rcph(d.x); rr.y = __builtin_amdgcn_rcph(d.y);
                        const h2v o = g * rr * pv[e]; const unsigned ow_ = pk2((float)o.x, (float)o.y); if (e) w.y = ow_; else w.x = ow_; }
                    *(u32x2*)(Go + (size_t)(xi - 2) * 64) = w; }
#pragma unroll
                for (int e = 0; e < 2; ++e) { pv[e] = cv[e]; pg_[e] = cg_[e]; cv[e] = nv[e]; cg_[e] = ng[e]; }
            }
#undef CT_LDCOL
            if (wave >= 4) { if (unit + 1 < uend) CT_TOLDS(pre[sel ^ 1], unit + 1, (sel ^ 1) * CT2_TILE); if (unit + 3 < uend) CT_PREFETCH(pre[sel ^ 1], unit + 3); }
            __syncthreads();
            }
          }
        }
    }
#undef CT_DECODE
#undef CT_PREFETCH
#undef CT_TOLDS
#undef CT_EDGES
    __syncthreads();
    if (nrows > RL) p7_conv_geglu_rows(F, tid, bid, l, t0, ntiles, nrows, RL, nrows);
}
typedef short s16x4 __attribute__((ext_vector_type(4)));
typedef short v4i16_t __attribute__((ext_vector_type(4)));
constexpr int XS = 544, TS = 288;
constexpr int SSD_X = 0, SSD_B = 128 * XS, SSD_C = SSD_B + 128 * TS, SSD_AUX = SSD_C + 128 * TS, SSD_TOT = SSD_AUX + 8192;
static_assert(SSD_TOT + 64 <= LDSCTL_OFF, "SSD LDS map");
constexpr int NCHUNK = 264;
__device__ __forceinline__ s16x4 tr_read(const LAS unsigned char* p) { return __builtin_bit_cast(s16x4, __builtin_amdgcn_ds_read_tr16_b64_v4i16((LAS v4i16_t*)p)); }
__device__ __forceinline__ f32x4 mfma16(bf16x8 a, bf16x8 b, f32x4 c) { return __builtin_amdgcn_mfma_f32_16x16x32_bf16(a, b, c, 0, 0, 0); }
__device__ __forceinline__ bf16x8 cat8(s16x4 lo, s16x4 hi) { bf16x8 r; r[0] = lo[0]; r[1] = lo[1]; r[2] = lo[2]; r[3] = lo[3]; r[4] = hi[0]; r[5] = hi[1]; r[6] = hi[2]; r[7] = hi[3]; return r; }
__device__ __forceinline__ float s2f(short s) { return __uint_as_float(((unsigned)(unsigned short)s) << 16); }
__device__ __forceinline__ short f2s(float f) { return (short)f2bf(f); }
struct ChunkInfo { int row0, pos0, L; };
__device__ __forceinline__ ChunkInfo chunk_info(int ck) {
    ChunkInfo ci;
    if (ck < 256) { ci.row0 = ck * 128; ci.pos0 = (ck & 63) * 128; ci.L = SEQ; }
    else { const int k = ck - 256; ci.row0 = RL + k * 128; ci.pos0 = (k & 1) * 128; ci.L = CTXL; }
    return ci;
}
__device__ __forceinline__ void ssd_dtcs(Frame& F, int l, int g, const ChunkInfo ci, const int wave, const int lane, const bool weights, float* keep = nullptr) {
    LAS float* arr = (LAS float*)(F.lds + SSD_AUX); LAS float* tot = (LAS float*)(F.lds + SSD_TOT);
    const int hp = wave >> 1, dir = wave & 1, hd = 4 * g + hp;
    const float Aneg = -expf(inp_ptr(I_ssd_a_log)[(l * 2 + dir) * 8 + hd]), dtb = inp_ptr(I_ssd_dt_bias)[(l * 2 + dir) * 8 + hd];
    const float* DTR = WSP(float, WS_DTRAW) + (size_t)(ci.row0 + 2 * lane) * 16 + dir * 8 + hd;
    const float dt0 = softplus_f(DTR[0] + dtb), dt1 = softplus_f(DTR[16] + dtb), a0 = dt0 * Aneg, a1 = dt1 * Aneg, s = a0 + a1;
    float incl = s;
#pragma unroll
    for (int o = 1; o < 64; o <<= 1) { const float t = __shfl_up(incl, o); if (lane >= o) incl += t; }
    const float excl = incl - s, total = __shfl(incl, 63);
    float c0, c1;
    if (dir == 0) { c0 = excl + a0; c1 = incl; } else { c0 = excl; c1 = excl + a0; }
    if (!weights) { arr[(hp * 4 + 2 * dir) * 128 + 2 * lane] = dt0; arr[(hp * 4 + 2 * dir) * 128 + 2 * lane + 1] = dt1; arr[(hp * 4 + 2 * dir + 1) * 128 + 2 * lane] = c0; arr[(hp * 4 + 2 * dir + 1) * 128 + 2 * lane + 1] = c1; }
    else {
        const float w0 = dir == 0 ? dt0 * __expf(fminf(total - c0, 0.f)) : dt0 * __expf(c0), w1 = dir == 0 ? dt1 * __expf(fminf(total - c1, 0.f)) : dt1 * __expf(c1);
        arr[(hp * 2 + dir) * 128 + 2 * lane] = w0; arr[(hp * 2 + dir) * 128 + 2 * lane + 1] = w1; }
    if (keep) {
        *(pn_f2*)(keep + (hp * 4 + 2 * dir) * 128 + 2 * lane) = (pn_f2){dt0, dt1}; *(pn_f2*)(keep + (hp * 4 + 2 * dir + 1) * 128 + 2 * lane) = (pn_f2){c0, c1}; if (lane == 0) keep[2048 + hp * 2 + dir] = total; }
    if (lane == 0) tot[hp * 2 + dir] = total;
}
template <bool WITH_C>
__device__ __forceinline__ void ssd_conv(Frame& F, int l, int g, const ChunkInfo ci, const int tid) {
    const int cc = tid & 63, rb = tid >> 6;
    if (cc < (WITH_C ? 64 : 48)) {
        const int wcol = cc < 32 ? 256 * g + 8 * cc : cc < 48 ? 512 + 128 * g + 8 * (cc - 32) : 768 + 128 * g + 8 * (cc - 48);
        const float* cw = inp_ptr(I_ssd_conv_w) + (size_t)l * 3 * 1024 + wcol; const float* cb = inp_ptr(I_ssd_conv_b) + l * 1024 + wcol;
        float w0[8], w1[8], w2[8], bs[8];
        { const f32x4 a = *(const f32x4*)cw, b = *(const f32x4*)(cw + 4); w0[0] = a.x; w0[1] = a.y; w0[2] = a.z; w0[3] = a.w; w0[4] = b.x; w0[5] = b.y; w0[6] = b.z; w0[7] = b.w; }
        { const f32x4 a = *(const f32x4*)(cw + 1024), b = *(const f32x4*)(cw + 1028); w1[0] = a.x; w1[1] = a.y; w1[2] = a.z; w1[3] = a.w; w1[4] = b.x; w1[5] = b.y; w1[6] = b.z; w1[7] = b.w; }
        { const f32x4 a = *(const f32x4*)(cw + 2048), b = *(const f32x4*)(cw + 2052); w2[0] = a.x; w2[1] = a.y; w2[2] = a.z; w2[3] = a.w; w2[4] = b.x; w2[5] = b.y; w2[6] = b.z; w2[7] = b.w; }
        { const f32x4 a = *(const f32x4*)cb, b = *(const f32x4*)(cb + 4); bs[0] = a.x; bs[1] = a.y; bs[2] = a.z; bs[3] = a.w; bs[4] = b.x; bs[5] = b.y; bs[6] = b.z; bs[7] = b.w; }
        const bf16* U = WSP(bf16, WS_U) + (size_t)ci.row0 * NIN + UC_XBC + wcol;
        const int l0 = 16 * rb;
        unsigned char* xb = (ci.row0 < RL) ? (unsigned char*)F.out + (size_t)ci.row0 * 4096 + 2048 + g * 768 + cc * 16 : WSP(unsigned char, WS_XBC) + (size_t)(ci.row0 - RL) * 1536 + g * 768 + cc * 16;
        const int xbs = (ci.row0 < RL) ? 4096 : 1536;
#define SSD_CONV_OUT(ll_, o_) do { int off; const int ll = (ll_); const v4u pk_ = pack8(o_); \
            if (cc < 32) off = SSD_X + ll * XS + cc * 16; else if (cc < 48) off = SSD_B + ll * TS + (cc - 32) * 16; else off = SSD_C + ll * TS + (cc - 48) * 16; \
            *(LAS v4u*)(F.lds + off) = pk_; if (!WITH_C) *(v4u*)(xb + (size_t)ll * xbs) = pk_; } while (0)
        float prev[8], cur[8], nxt[8];
        {
            v4u raw[12];
#pragma unroll
            for (int i = 0; i < 12; ++i) { const int ll = l0 - 1 + i; const bool ok = (ci.pos0 + ll >= 0) && (ci.pos0 + ll < ci.L); raw[i] = ok ? *(const v4u*)(U + (ptrdiff_t)ll * NIN) : (v4u){0u, 0u, 0u, 0u}; }
            unpack8(raw[0], prev); unpack8(raw[1], cur);
#pragma unroll
            for (int i = 0; i < 10; ++i) { unpack8(raw[i + 2], nxt); float o[8];
#pragma unroll
                for (int q = 0; q < 8; ++q) { o[q] = silu_f(bs[q] + w0[q] * prev[q] + w1[q] * cur[q] + w2[q] * nxt[q]); prev[q] = cur[q]; cur[q] = nxt[q]; }
                SSD_CONV_OUT(l0 + i, o); }
        }
        {
            v4u raw[6];
#pragma unroll
            for (int i = 0; i < 6; ++i) { const int ll = l0 + 11 + i; const bool ok = (ci.pos0 + ll < ci.L); raw[i] = ok ? *(const v4u*)(U + (ptrdiff_t)ll * NIN) : (v4u){0u, 0u, 0u, 0u}; }
#pragma unroll
            for (int i = 0; i < 6; ++i) { unpack8(raw[i], nxt); float o[8];
#pragma unroll
                for (int q = 0; q < 8; ++q) { o[q] = silu_f(bs[q] + w0[q] * prev[q] + w1[q] * cur[q] + w2[q] * nxt[q]); prev[q] = cur[q]; cur[q] = nxt[q]; }
                SSD_CONV_OUT(l0 + 10 + i, o); }
        }
#undef SSD_CONV_OUT
    }
}
__device__ __forceinline__ void ssd_xb_copy_conv_c(Frame& F, int l, int g, const ChunkInfo ci, const int tid) {
    const bool lat = ci.row0 < RL;
    const unsigned char* xb = lat ? (const unsigned char*)F.out + (size_t)ci.row0 * 4096 + 2048 + g * 768 : WSP(unsigned char, WS_XBC) + (size_t)(ci.row0 - RL) * 1536 + g * 768;
    const int xbs = lat ? 4096 : 1536;
    v4u cp[12];
#pragma unroll
    for (int i = 0; i < 12; ++i) { const int p = tid + 512 * i, row = p / 48, cc = p - 48 * row; cp[i] = *(const v4u*)(xb + (size_t)row * xbs + cc * 16); }
    {
        const int cq = tid & 15, l0 = 4 * (tid >> 4), wcol = 768 + 128 * g + 8 * cq;
        const float* cw = inp_ptr(I_ssd_conv_w) + (size_t)l * 3 * 1024 + wcol; const float* cb = inp_ptr(I_ssd_conv_b) + l * 1024 + wcol;
        float w0[8], w1[8], w2[8], bs[8];
        { const f32x4 a = *(const f32x4*)cw, b = *(const f32x4*)(cw + 4); w0[0] = a.x; w0[1] = a.y; w0[2] = a.z; w0[3] = a.w; w0[4] = b.x; w0[5] = b.y; w0[6] = b.z; w0[7] = b.w; }
        { const f32x4 a = *(const f32x4*)(cw + 1024), b = *(const f32x4*)(cw + 1028); w1[0] = a.x; w1[1] = a.y; w1[2] = a.z; w1[3] = a.w; w1[4] = b.x; w1[5] = b.y; w1[6] = b.z; w1[7] = b.w; }
        { const f32x4 a = *(const f32x4*)(cw + 2048), b = *(const f32x4*)(cw + 2052); w2[0] = a.x; w2[1] = a.y; w2[2] = a.z; w2[3] = a.w; w2[4] = b.x; w2[5] = b.y; w2[6] = b.z; w2[7] = b.w; }
        { const f32x4 a = *(const f32x4*)cb, b = *(const f32x4*)(cb + 4); bs[0] = a.x; bs[1] = a.y; bs[2] = a.z; bs[3] = a.w; bs[4] = b.x; bs[5] = b.y; bs[6] = b.z; bs[7] = b.w; }
        const bf16* U = WSP(bf16, WS_U) + (size_t)ci.row0 * NIN + UC_XBC + wcol;
        v4u raw[6];
#pragma unroll
        for (int i = 0; i < 6; ++i) { const int ll = l0 - 1 + i; const bool ok = (ci.pos0 + ll >= 0) && (ci.pos0 + ll < ci.L); raw[i] = ok ? *(const v4u*)(U + (ptrdiff_t)ll * NIN) : (v4u){0u, 0u, 0u, 0u}; }
        float prev[8], cur[8], nxt[8];
        unpack8(raw[0], prev); unpack8(raw[1], cur);
#pragma unroll
        for (int i = 0; i < 4; ++i) { unpack8(raw[i + 2], nxt); float o[8];
#pragma unroll
            for (int q = 0; q < 8; ++q) { o[q] = silu_f(bs[q] + w0[q] * prev[q] + w1[q] * cur[q] + w2[q] * nxt[q]); prev[q] = cur[q]; cur[q] = nxt[q]; }
            *(LAS v4u*)(F.lds + SSD_C + (l0 + i) * TS + cq * 16) = pack8(o); }
    }
#pragma unroll
    for (int i = 0; i < 12; ++i) { const int p = tid + 512 * i, row = p / 48, cc = p - 48 * row; const int off = cc < 32 ? SSD_X + row * XS + cc * 16 : SSD_B + row * TS + (cc - 32) * 16; *(LAS v4u*)(F.lds + off) = cp[i]; }
}
__device__ __forceinline__ int trx_off(int row, int col) { return row * XS + col * 2; }
__device__ __forceinline__ int trb_off(int row, int col) { return row * TS + col * 2; }
__device__ __forceinline__ void ssd_states(Frame& F, int l) {
    PH_IDS();
    for (int unit = bid; unit < NCHUNK * 2; unit += F.G) {
        int lane_ = lane; asm volatile("" : "+v"(lane_));
        int tid_ = tid; asm volatile("" : "+v"(tid_));
        const int c = lane_ & 15, q = lane_ >> 4;
        const int ck = unit >> 1, g = unit & 1; const ChunkInfo ci = chunk_info(ck);
        __syncthreads();
        ssd_dtcs(F, l, g, ci, wave, lane_, true, WSP(float, WS_DTCS) + (size_t)unit * 2056);
        ssd_conv<false>(F, l, g, ci, tid_);
        __syncthreads();
        const LAS float* arr = (const LAS float*)(F.lds + SSD_AUX); const LAS float* tot = (const LAS float*)(F.lds + SSD_TOT);
        if (tid < 8) WSP(float, WS_DEC)[(ck * 8 + 4 * g + (tid >> 1)) * 2 + (tid & 1)] = __expf(tot[tid]);
        s16x4 blo[4], bhi[4];
#pragma unroll
        for (int ks = 0; ks < 4; ++ks) { const int r0 = 32 * ks + 4 * q + (c >> 2), n0 = 16 * wave + 4 * (c & 3);
            blo[ks] = tr_read(F.lds + SSD_B + trb_off(r0, n0)); bhi[ks] = tr_read(F.lds + SSD_B + trb_off(r0 + 16, n0)); }
#pragma unroll 1
        for (int hp = 0; hp < 4; ++hp) {
            bf16x8 xf[4][4];
#pragma unroll
            for (int pt = 0; pt < 4; ++pt)
#pragma unroll
                for (int ks = 0; ks < 4; ++ks) { const int r0 = 32 * ks + 4 * q + (c >> 2), ch = 64 * hp + 16 * pt + 4 * (c & 3);
                    xf[pt][ks] = cat8(tr_read(F.lds + SSD_X + trx_off(r0, ch)), tr_read(F.lds + SSD_X + trx_off(r0 + 16, ch))); }
#pragma unroll
            for (int dir = 0; dir < 2; ++dir) {
                f32x4 acc[4];
#pragma unroll
                for (int pt = 0; pt < 4; ++pt) acc[pt] = (f32x4){0.f, 0.f, 0.f, 0.f};
#pragma unroll
                for (int ks = 0; ks < 4; ++ks) {
                    const f32x4 wl = *(const LAS f32x4*)(arr + (hp * 2 + dir) * 128 + 32 * ks + 4 * q), wh = *(const LAS f32x4*)(arr + (hp * 2 + dir) * 128 + 32 * ks + 16 + 4 * q);
                    v4u aw; aw.x = pk2(s2f(blo[ks][0]) * wl.x, s2f(blo[ks][1]) * wl.y); aw.y = pk2(s2f(blo[ks][2]) * wl.z, s2f(blo[ks][3]) * wl.w);
                    aw.z = pk2(s2f(bhi[ks][0]) * wh.x, s2f(bhi[ks][1]) * wh.y); aw.w = pk2(s2f(bhi[ks][2]) * wh.z, s2f(bhi[ks][3]) * wh.w);
                    const bf16x8 a = __builtin_bit_cast(bf16x8, aw);
#pragma unroll
                    for (int pt = 0; pt < 4; ++pt) acc[pt] = mfma16(a, xf[pt][ks], acc[pt]);
                }
                bf16* So = WSP(bf16, WS_SST) + ((size_t)((ck * 8 + 4 * g + hp) * 2 + dir)) * 8192 + 16 * wave + 4 * q;
#pragma unroll
                for (int pt = 0; pt < 4; ++pt) { u32x2 w; w.x = pk2(acc[pt].x, acc[pt].y); w.y = pk2(acc[pt].z, acc[pt].w); *(u32x2*)(So + (size_t)(16 * pt + c) * 128) = w; }
            }
        }
    }
    __syncthreads();
}
__device__ __forceinline__ void ssd_scan(Frame& F) {
    PH_IDS();
    const bf16* S = WSP(bf16, WS_SST); bf16* HI = WSP(bf16, WS_HIN); const float* DEC = WSP(float, WS_DEC);
    for (int item = bid * NTHR + tid; item < NB * 8 * 2 * 2048; item += F.G * NTHR) {
        const int quad = item & 2047, dir = (item >> 11) & 1, hd = (item >> 12) & 7, b = item >> 15;
        float h0 = 0.f, h1 = 0.f, h2 = 0.f, h3 = 0.f;
#pragma unroll 1
        for (int blk = 0; blk < 3; ++blk) {
            u32x2 sv[22]; float dv[22]; unsigned offs[22];
#pragma unroll
            for (int j = 0; j < 22; ++j) { const int i = blk * 22 + j;
                const int ck = i < 2 ? 256 + 2 * b + (dir == 0 ? i : 1 - i) : 64 * b + (dir == 0 ? i - 2 : 65 - i);
                offs[j] = (unsigned)((ck * 8 + hd) * 2 + dir) * 8192u + quad * 4; sv[j] = *(const u32x2*)(S + offs[j]); dv[j] = DEC[(ck * 8 + hd) * 2 + dir]; }
#pragma unroll
            for (int j = 0; j < 22; ++j) { u32x2 w; w.x = pk2(h0, h1); w.y = pk2(h2, h3); *(u32x2*)(HI + offs[j]) = w;
                h0 = dv[j] * h0 + bflo(sv[j].x); h1 = dv[j] * h1 + bfhi(sv[j].x); h2 = dv[j] * h2 + bflo(sv[j].y); h3 = dv[j] * h3 + bfhi(sv[j].y); }
        }
    }
}
__device__ __forceinline__ void ssd_out(Frame& F, int l, int nchunks) {
    PH_IDS();
    for (int unit = bid; unit < nchunks * 2; unit += F.G) {
        int lane_ = lane; asm volatile("" : "+v"(lane_));
        int tid_ = tid; asm volatile("" : "+v"(tid_));
        const int c = lane_ & 15, q = lane_ >> 4;
        const int ck = unit >> 1, g = unit & 1; const ChunkInfo ci = chunk_info(ck);
        v4u hreg[4], zreg[2];
#define SSD_HLOAD(hh) do { const bf16* Hg_ = WSP(bf16, WS_HIN) + ((size_t)(ck * 8 + 4 * g + (hh)) * 2) * 8192; \
            _Pragma("unroll") for (int j = 0; j < 4; ++j) { const int x = tid_ + 512 * j, dir = x >> 10, p = (x >> 4) & 63, k16 = x & 15; hreg[j] = *(const v4u*)(Hg_ + (size_t)dir * 8192 + p * 128 + k16 * 8); } \
            _Pragma("unroll") for (int j = 0; j < 2; ++j) { const int x = lane_ + 64 * j, row = x >> 3, k16 = x & 7; zreg[j] = *(const v4u*)(WSP(bf16, WS_U) + (size_t)(ci.row0 + 16 * wave + row) * NIN + UC_Z + 256 * g + 64 * (hh) + 8 * k16); } } while (0)
        SSD_HLOAD(0);
        __syncthreads();
        { const float* kp = WSP(float, WS_DTCS) + (size_t)unit * 2056; const f32x4 kv = *(const f32x4*)(kp + 4 * tid_); const float kt = tid_ < 8 ? kp[2048 + tid_] : 0.f;
          *(LAS f32x4*)(F.lds + SSD_AUX + 16 * tid_) = kv; if (tid_ < 8) ((LAS float*)(F.lds + SSD_TOT))[tid_] = kt; }
        ssd_xb_copy_conv_c(F, l, g, ci, tid_);
        __syncthreads();
        const LAS float* arr = (const LAS float*)(F.lds + SSD_AUX); const LAS float* tot = (const LAS float*)(F.lds + SSD_TOT);
        const int myl = 16 * wave + c;
        bf16x8 cfr[4];
#pragma unroll
        for (int ks = 0; ks < 4; ++ks) cfr[ks] = *(const LAS bf16x8*)(F.lds + SSD_C + myl * TS + (4 * ks + q) * 16);
        unsigned gtp[8][2];
#pragma unroll
        for (int i = 0; i < 8; ++i) { f32x4 gacc = (f32x4){0.f, 0.f, 0.f, 0.f};
#pragma unroll
            for (int ks = 0; ks < 4; ++ks) { const int row = 16 * i + c; const bf16x8 a = *(const LAS bf16x8*)(F.lds + SSD_B + row * TS + (4 * ks + q) * 16); gacc = mfma16(a, cfr[ks], gacc); }
            gtp[i][0] = pk2(gacc.x, gacc.y); gtp[i][1] = pk2(gacc.z, gacc.w); }
        float ssl = 0.f;
        bf16* Co = WSP(bf16, WS_CONCAT) + (size_t)(ci.row0 + 16 * wave) * DM + 256 * g;
        constexpr int ZS = 144;
        LAS unsigned char* zst = F.lds + SSD_C + wave * (16 * ZS);
        const f32x4 dsk4 = *(const f32x4*)(inp_ptr(I_ssd_d) + l * 8 + 4 * g);
#pragma unroll 1
        for (int hp = 0; hp < 4; ++hp) {
            const int hd = 4 * g + hp;
            __syncthreads();
#pragma unroll
            for (int j = 0; j < 4; ++j) { const int x = tid_ + 512 * j, dir = x >> 10, p = (x >> 4) & 63, k16 = x & 15; *(LAS v4u*)(F.lds + SSD_B + dir * (64 * TS) + p * TS + k16 * 16) = hreg[j]; }
#pragma unroll
            for (int j = 0; j < 2; ++j) { const int x = lane_ + 64 * j, row = x >> 3, k16 = x & 7; *(LAS v4u*)(zst + row * ZS + k16 * 16) = zreg[j]; }
            __syncthreads();
            if (hp < 3) SSD_HLOAD(hp + 1);
            const float csf_l = arr[(hp * 4 + 1) * 128 + myl], csb_l = arr[(hp * 4 + 3) * 128 + myl];
            f32x4 acc[4];
#pragma unroll
            for (int pt = 0; pt < 4; ++pt) acc[pt] = (f32x4){0.f, 0.f, 0.f, 0.f};
#pragma unroll
            for (int ks = 0; ks < 4; ++ks) {
                unsigned aw[4];
#pragma unroll
                for (int hf = 0; hf < 2; ++hf) { const int i = 2 * ks + hf, s0 = 16 * i + 4 * q; float m[4];
                    if (i < wave) { const f32x4 dtf = *(const LAS f32x4*)(arr + (hp * 4 + 0) * 128 + s0), csf = *(const LAS f32x4*)(arr + (hp * 4 + 1) * 128 + s0);
#pragma unroll
                        for (int r = 0; r < 4; ++r) m[r] = __expf(fminf(csf_l - csf[r], 0.f)) * dtf[r]; }
                    else if (i > wave) { const f32x4 dtb = *(const LAS f32x4*)(arr + (hp * 4 + 2) * 128 + s0), csb = *(const LAS f32x4*)(arr + (hp * 4 + 3) * 128 + s0);
#pragma unroll
                        for (int r = 0; r < 4; ++r) m[r] = __expf(fminf(csb[r] - csb_l, 0.f)) * dtb[r]; }
                    else { const f32x4 dtf = *(const LAS f32x4*)(arr + (hp * 4 + 0) * 128 + s0), csf = *(const LAS f32x4*)(arr + (hp * 4 + 1) * 128 + s0);
                        const f32x4 dtb = *(const LAS f32x4*)(arr + (hp * 4 + 2) * 128 + s0), csb = *(const LAS f32x4*)(arr + (hp * 4 + 3) * 128 + s0);
#pragma unroll
                        for (int r = 0; r < 4; ++r) { const int sl = 4 * q + r;
                            const float mf = (sl <= c) ? __expf(fminf(csf_l - csf[r], 0.f)) * dtf[r] : 0.f, mb = (sl >= c) ? __expf(fminf(csb[r] - csb_l, 0.f)) * dtb[r] : 0.f; m[r] = mf + mb; } }
                    aw[2 * hf] = pk2(bflo(gtp[i][0]) * m[0], bfhi(gtp[i][0]) * m[1]); aw[2 * hf + 1] = pk2(bflo(gtp[i][1]) * m[2], bfhi(gtp[i][1]) * m[3]); }
                const bf16x8 a = __builtin_bit_cast(bf16x8, (v4u){aw[0], aw[1], aw[2], aw[3]});
#pragma unroll
                for (int pt = 0; pt < 4; ++pt) { const int r0 = 32 * ks + 4 * q + (c >> 2), ch = 64 * hp + 16 * pt + 4 * (c & 3);
                    const bf16x8 b = cat8(tr_read(F.lds + SSD_X + trx_off(r0, ch)), tr_read(F.lds + SSD_X + trx_off(r0 + 16, ch)));
                    acc[pt] = mfma16(b, a, acc[pt]); }
            }
#pragma unroll
            for (int dir = 0; dir < 2; ++dir) {
                f32x4 ad[4];
#pragma unroll
                for (int pt = 0; pt < 4; ++pt) ad[pt] = (f32x4){0.f, 0.f, 0.f, 0.f};
#pragma unroll
                for (int ks = 0; ks < 4; ++ks) {
#pragma unroll
                    for (int pt = 0; pt < 4; ++pt) { const int p = 16 * pt + c; const bf16x8 b = *(const LAS bf16x8*)(F.lds + SSD_B + dir * (64 * TS) + p * TS + (4 * ks + q) * 16); ad[pt] = mfma16(b, cfr[ks], ad[pt]); } }
                const float e = dir == 0 ? __expf(csf_l) : __expf(fminf(tot[hp * 2 + 1] - csb_l, 0.f));
#pragma unroll
                for (int pt = 0; pt < 4; ++pt) acc[pt] += ad[pt] * e;
            }
            const float dsk = hp == 0 ? dsk4.x : hp == 1 ? dsk4.y : hp == 2 ? dsk4.z : dsk4.w;
            {
                LAS unsigned char* zrow = zst + c * ZS; const LAS unsigned char* xrow = F.lds + SSD_X + (16 * wave + c) * XS + (64 * hp) * 2;
#pragma unroll
                for (int pt = 0; pt < 4; ++pt) { const int ch = 16 * pt + 4 * q;
                    const u32x2 zw = *(const LAS u32x2*)(zrow + ch * 2), xw = *(const LAS u32x2*)(xrow + ch * 2);
                    const float y0 = (acc[pt][0] + bflo(xw.x) * dsk) * silu_f(bflo(zw.x)), y1 = (acc[pt][1] + bfhi(xw.x) * dsk) * silu_f(bfhi(zw.x));
                    const float y2 = (acc[pt][2] + bflo(xw.y) * dsk) * silu_f(bflo(zw.y)), y3 = (acc[pt][3] + bfhi(xw.y) * dsk) * silu_f(bfhi(zw.y));
                    ssl += (y0 * y0 + y1 * y1) + (y2 * y2 + y3 * y3);
                    u32x2 yw; yw.x = pk2(y0, y1); yw.y = pk2(y2, y3); *(LAS u32x2*)(zrow + ch * 2) = yw; }
            }
            asm volatile("s_waitcnt lgkmcnt(0)" ::: "memory");
#pragma unroll
            for (int j = 0; j < 2; ++j) { const int x = lane_ + 64 * j, row = x >> 3, k16 = x & 7; *(v4u*)(Co + (size_t)row * DM + 64 * hp + 8 * k16) = *(const LAS v4u*)(zst + row * ZS + k16 * 16); }
        }
#undef SSD_HLOAD
        { float s = ssl; s += __shfl_xor(s, 16); s += __shfl_xor(s, 32); ssl = 1.f / sqrtf(s * (1.f / 256.f) + LN_EPS); }
        LAS float* rs = (LAS float*)(zst);
        if (q == 0) rs[c] = ssl;
        asm volatile("s_waitcnt vmcnt(0) lgkmcnt(0)" ::: "memory");
        const float* nw = inp_ptr(I_ssd_norm_w) + l * 512 + 256 * g;
        const f32x4 n0 = *(const f32x4*)(nw + 8 * (lane_ & 31)), n1 = *(const f32x4*)(nw + 8 * (lane_ & 31) + 4);
        v4u yv[8];
#pragma unroll
        for (int j = 0; j < 8; ++j) { const int x = lane_ + 64 * j, row = x >> 5, k16 = x & 31; yv[j] = *(const v4u*)(Co + (size_t)row * DM + 8 * k16); }
#pragma unroll
        for (int j = 0; j < 8; ++j) { const int x = lane_ + 64 * j, row = x >> 5, k16 = x & 31; float yf[8];
            unpack8(yv[j], yf);
            const float rr = rs[row];
            yf[0] *= rr * n0.x; yf[1] *= rr * n0.y; yf[2] *= rr * n0.z; yf[3] *= rr * n0.w; yf[4] *= rr * n1.x; yf[5] *= rr * n1.y; yf[6] *= rr * n1.z; yf[7] *= rr * n1.w;
            *(v4u*)(Co + (size_t)row * DM + 8 * k16) = pack8(yf); }
    }
    __syncthreads();
}
__device__ __forceinline__ int kperm_inv(int pos) { const int ks = pos >> 5, q = (pos >> 3) & 3, j = pos & 7; return 32 * ks + (j < 4 ? 4 * q + j : 16 + 4 * q + (j - 4)); }
__device__ __forceinline__ void fft_tables(Frame& F, const int tid, const int bid) {
    const int gt = bid * NTHR + tid, NGT = F.G * NTHR;
    for (int it = gt; it < 128 * 128; it += NGT) {
        const int m = it >> 7, k = kperm_inv(it & 127), po = m >> 6, k1 = m & 63, pi = k >> 6, l1 = k & 63;
        const float a = (float)((k1 * l1) & 63) * (1.f / 32.f), wr = cospif(a), wi = sinpif(a);
        const float v = po == 0 ? (pi == 0 ? wr : -wi) : (pi == 0 ? wi : wr);
        WSP(bf16, WS_WA)[it] = (bf16)f2bf(v); }
    for (int it = gt; it < 128 * 256; it += NGT) {
        const int k2 = it >> 8, k = kperm_inv(it & 255), l2 = k >> 1, pi = k & 1;
        const float a = (float)((k2 * l2) & 127) * (1.f / 64.f);
        WSP(bf16, WS_WB)[it] = (bf16)f2bf(pi == 0 ? cospif(a) : -sinpif(a)); }
    for (int it = gt; it < 64 * 128; it += NGT) {
        const int k1 = it >> 7, l2 = it & 127; const float a = (float)(k1 * l2) * (1.f / 4096.f);
        WSP(float, WS_TW)[2 * it] = cospif(a); WSP(float, WS_TW)[2 * it + 1] = sinpif(a); }
}
__device__ __forceinline__ void fft_a(Frame& F, int first_block) {
    PH_IDS();
    const bf16* U = WSP(bf16, WS_U);
    if (bid < first_block) return;
    const int c = lane & 15, q = lane >> 4, kt = wave & 3, half = wave >> 2;
    bf16x8 are[4], aim[4];
#pragma unroll
    for (int ks = 0; ks < 4; ++ks) { are[ks] = *(const bf16x8*)(WSP(bf16, WS_WA) + (size_t)(16 * kt + c) * 128 + 32 * ks + 8 * q); aim[ks] = *(const bf16x8*)(WSP(bf16, WS_WA) + (size_t)(64 + 16 * kt + c) * 128 + 32 * ks + 8 * q); }
    const int ustep = F.G - first_block;
    v4u pf[8];
#define FA_LOAD(u) do { const int b_ = (u) >> 7, l2_ = (u) & 127; _Pragma("unroll") for (int j = 0; j < 8; ++j) { const int x = tid + 512 * j, tok = x >> 6, k16 = x & 63; \
        pf[j] = *(const v4u*)(U + (size_t)(b_ * SEQ + 128 * tok + l2_) * NIN + UC_P + 8 * k16); } } while (0)
    int unit = bid - first_block;
    if (unit < NB * 128) FA_LOAD(unit);
    for (; unit < NB * 128; unit += ustep) {
        const int b = unit >> 7, l2 = unit & 127;
        float tr[4], ti[4];
#pragma unroll
        for (int r = 0; r < 4; ++r) { const int k1 = 16 * kt + 4 * q + r; tr[r] = WSP(float, WS_TW)[2 * (k1 * 128 + l2)]; ti[r] = WSP(float, WS_TW)[2 * (k1 * 128 + l2) + 1]; }
        __syncthreads();
#pragma unroll
        for (int j = 0; j < 8; ++j) { const int x = tid + 512 * j, tok = x >> 6, k16 = x & 63; *(LAS v4u*)(F.lds + ((k16 >> 5) * 64 + tok) * XS + (k16 & 31) * 16) = pf[j]; }
        __syncthreads();
        if (unit + ustep < NB * 128) FA_LOAD(unit + ustep);
        f32x4 acc[2][8];
#pragma unroll
        for (int i = 0; i < 2; ++i)
#pragma unroll
            for (int ct = 0; ct < 8; ++ct) acc[i][ct] = (f32x4){0.f, 0.f, 0.f, 0.f};
#pragma unroll
        for (int ks = 0; ks < 4; ++ks) {
#pragma unroll
            for (int ct = 0; ct < 8; ++ct) { const int r0 = 32 * ks + 4 * q + (c >> 2), ch = 128 * half + 16 * ct + 4 * (c & 3);
                const bf16x8 bfr = cat8(tr_read(F.lds + trx_off(r0, ch)), tr_read(F.lds + trx_off(r0 + 16, ch)));
                acc[0][ct] = mfma16(are[ks], bfr, acc[0][ct]); acc[1][ct] = mfma16(aim[ks], bfr, acc[1][ct]); }
        }
        __syncthreads();
#pragma unroll
        for (int ct = 0; ct < 8; ++ct)
#pragma unroll
            for (int r = 0; r < 4; ++r) { const int k1 = 16 * kt + 4 * q + r, ch = 128 * half + 16 * ct + c; const float yr = acc[0][ct][r], yi = acc[1][ct][r];
                *(LAS unsigned short*)(F.lds + k1 * XS + ch * 2) = (unsigned short)f2bf(yr * tr[r] - yi * ti[r]);
                *(LAS unsigned short*)(F.lds + (64 + k1) * XS + ch * 2) = (unsigned short)f2bf(yr * ti[r] + yi * tr[r]); }
        __syncthreads();
#pragma unroll
        for (int j = 0; j < 8; ++j) { const int x = tid + 512 * j, row = x >> 5, k16 = x & 31, part = row >> 6, k1 = row & 63;
            *(v4u*)(WSP(bf16, WS_YFFT) + ((size_t)((b * 64 + k1) * 128 + l2) * 2 + part) * 256 + 8 * k16) = *(const LAS v4u*)(F.lds + row * XS + k16 * 16); }
    }
#undef FA_LOAD
    __syncthreads();
}
__device__ __forceinline__ void fft_b(Frame& F) {
    PH_IDS();
    for (int unit = bid; unit < NB * 64; unit += F.G) {
        int lane_ = lane; asm volatile("" : "+v"(lane_));
        const int c = lane_ & 15, q = lane_ >> 4, b = unit >> 6, k1 = unit & 63, mt0 = 2 * (wave & 3), half = wave >> 2;
        __syncthreads();
        const bf16* Yg = WSP(bf16, WS_YFFT) + (size_t)(b * 64 + k1) * 256 * 256;
#pragma unroll
        for (int j = 0; j < 16; ++j) { const int x = tid + 512 * j, row = x >> 5, k16 = x & 31; *(LAS v4u*)(F.lds + row * XS + k16 * 16) = *(const v4u*)(Yg + (size_t)row * 256 + 8 * k16); }
        __syncthreads();
        f32x4 acc[2][8];
#pragma unroll
        for (int i = 0; i < 2; ++i)
#pragma unroll
            for (int ct = 0; ct < 8; ++ct) acc[i][ct] = (f32x4){0.f, 0.f, 0.f, 0.f};
#pragma unroll 2
        for (int ks = 0; ks < 8; ++ks) {
            const bf16x8 a0 = *(const bf16x8*)(WSP(bf16, WS_WB) + (size_t)(16 * mt0 + c) * 256 + 32 * ks + 8 * q), a1 = *(const bf16x8*)(WSP(bf16, WS_WB) + (size_t)(16 * mt0 + 16 + c) * 256 + 32 * ks + 8 * q);
#pragma unroll
            for (int ct = 0; ct < 8; ++ct) { const int r0 = 32 * ks + 4 * q + (c >> 2), ch = 128 * half + 16 * ct + 4 * (c & 3);
                const bf16x8 bfr = cat8(tr_read(F.lds + trx_off(r0, ch)), tr_read(F.lds + trx_off(r0 + 16, ch)));
                acc[0][ct] = mfma16(a0, bfr, acc[0][ct]); acc[1][ct] = mfma16(a1, bfr, acc[1][ct]); }
        }
        __syncthreads();
        const float nrm = 0.011048543456039806f;
#pragma unroll
        for (int i = 0; i < 2; ++i)
#pragma unroll
            for (int ct = 0; ct < 8; ++ct)
#pragma unroll
                for (int r = 0; r < 4; ++r) *(LAS unsigned short*)(F.lds + (16 * (mt0 + i) + 4 * q + r) * XS + (128 * half + 16 * ct + c) * 2) = (unsigned short)f2bf(acc[i][ct][r] * nrm);
        __syncthreads();
#pragma unroll
        for (int j = 0; j < 8; ++j) { const int x = tid + 512 * j, k2 = x >> 5, k16 = x & 31;
            *(v4u*)(WSP(bf16, WS_CONCAT) + (size_t)(b * SEQ + k1 + 64 * k2) * DM + 512 + 8 * k16) = *(const LAS v4u*)(F.lds + k2 * XS + k16 * 16); }
    }
    __syncthreads();
}
#ifndef DBL_MASK
#define DBL_MASK 0
#endif
#ifndef MK_PER_PHASE
#define MK_PER_PHASE 0
#endif
constexpr int N_PHASES = 2 + 12 * NLAYER;
struct Args { const float* in[25]; float* out; unsigned char* ws; int ph_lo, ph_hi, li, pad; };
__global__ void __launch_bounds__(NTHR, 2) skel_fwd(Args args) {
    extern __shared__ __attribute__((aligned(16))) unsigned char lds[];
    Frame F;
    F.lds = (LAS unsigned char*)lds; F.MISC = (volatile LAS unsigned*)(F.lds + MISC_OFF);
    F.G = gridDim.x;
    F.ws = args.ws; F.ctl = (gu32*)(F.ws + WS_CTL); F.out = args.out;
    for (int u = threadIdx.x; u < (LDS_BYTES - LDSCTL_OFF) / 4; u += NTHR) ((LAS unsigned*)(F.lds + LDSCTL_OFF))[u] = 0u;
    __syncthreads();
    XcdBarrier bar; bar.bar = (unsigned*)(F.ctl + CW_BAR); bar.x = 0; bar.st = nullptr;
    const int lo = args.ph_lo, hi = args.ph_hi;
    if (hi - lo > 1) bar = xcd_barrier_post((unsigned*)(F.ctl + CW_BAR) + args.li * XCD_BAR_WORDS, F.MISC + 8);

    for (int ph = lo; ph < hi; ++ph) {
        if (ph == 0) {
#ifndef SKIP_P0A
 p0a(F); if (DBL_MASK & 8192) p0a(F);
#endif
 }
        else if (ph == 1) {
#ifndef SKIP_P0B
 p0b(F); if (DBL_MASK & 16384) p0b(F);
#endif
 }
        else {
            const int l = (ph - 2) / 12, s = (ph - 2) % 12;
            const int nrows = (l == 0) ? RT : RL;
            const int up_na = (l == 0 || F.G != 256) ? 11 : 10;
            if (s == 0) dt_mfma(F, l, (F.G == 256) ? 164 : 0);
            if (s == 0 || s == 4 || s == 6 || s == 8 || s == 10) {
                pg8::Gemm g; bf16* O; int ldc; size_t cstr = 0;
                if (s == 0) { g = pg8::Gemm{WSP(bf16, WS_H), WSP(bf16, WS_WIN) + (size_t)l * NIN * DM, RT, NIN, DM}; O = WSP(bf16, WS_U); ldc = NIN; }
                else if (s == 4) { g = pg8::Gemm{WSP(bf16, WS_CONCAT), WSP(bf16, WS_WOUT) + (size_t)l * DM * DM, RL, DM, DM}; O = WSP(bf16, WS_MIX); ldc = DM; }
                else if (s == 10) { g = pg8::Gemm{WSP(bf16, WS_G), WSP(bf16, WS_WDOWN) + (size_t)l * DM * DFF, RL, DM, DFF, 0, 64, (size_t)RT * 128}; O = WSP(bf16, WS_FFNO); ldc = DM; }
                else { const int t0 = (s == 8) ? up_na : 0, ntl = (s == 8) ? 22 - up_na : up_na; g = pg8::Gemm{WSP(bf16, WS_H), WSP(bf16, WS_WUP) + (size_t)l * NUP * DM + (size_t)t0 * 256 * DM, nrows, ntl * 256, DM}; O = WSP(bf16, WS_AH); ldc = 128; cstr = (size_t)nrows * 128; }
                int bid = blockIdx.x; asm volatile("" : "+s"(bid)); pg8::StaticOrder S; S.init(g.M, g.N, F.G, bid);
                pg8::EpiBf16<0> E{O, ldc, nullptr, 0, 0, 1.f, cstr, (s == 6 || s == 8)};
#ifndef SKIP_GEMM
                pg8::gemm_phase<pg8::EpiBf16<0>, pg8::StaticOrder, true, true>(F.lds, g, S, E);
                if (DBL_MASK & 1) pg8::gemm_phase<pg8::EpiBf16<0>, pg8::StaticOrder, true, true>(F.lds, g, S, E);
#endif
                if ((s == 4 || s == 10) && l == 0) {
                    const int Kt = (s == 4) ? DM : DFF;
                    const int ksl = 256, nsl = Kt / ksl;
                    pg8::Gemm gc{(s == 4 ? WSP(bf16, WS_CONCAT) + (size_t)RL * DM : WSP(bf16, WS_G) + (size_t)RL * 64), g.Bt, RC, DM, ksl, Kt, (s == 4 ? 0 : 64), (s == 4 ? (size_t)0 : (size_t)RT * 128)};
                    pg8::SliceOrder SO{RC / 256, DM / 256, nsl, ksl, F.G, bid};
                    pg8::EpiF32Slab ES{WSP(float, WS_SLAB), DM, ksl, (size_t)RC * DM};
                    pg8::gemm_phase<pg8::EpiF32Slab, pg8::SliceOrder, false, false>(F.lds, gc, SO, ES);
                }
            }
            else if (s == 1) { ssd_states(F, l); if (DBL_MASK & 2) ssd_states(F, l); fft_a(F, F.G > 32 ? 16 : 0); if (DBL_MASK & 4) fft_a(F, F.G > 32 ? 16 : 0); }
            else if (s == 2) { ssd_scan(F); if (DBL_MASK & 16) ssd_scan(F); fft_b(F); if (DBL_MASK & 4) fft_b(F); }
            else if (s == 3) { ssd_out(F, l, l == 0 ? NCHUNK : 256); if (DBL_MASK & 256) ssd_out(F, l, l == 0 ? NCHUNK : 256); p2_rest(F, l, (l == 0 && F.G > 32) ? 16 : 0); if (DBL_MASK & 32) p2_rest(F, l, (l == 0 && F.G > 32) ? 16 : 0); }
            else if (s == 5) {
#ifndef SKIP_PN
 if (l == 0) post_norm_pass<true, false>(F, l, 0, RL, WSP(bf16, WS_MIX)); else post_norm_pass<false, false>(F, l, 0, RL, WSP(bf16, WS_MIX)); if (l == 0) ctx_post_norm(F, l, 0, DM / 256, false);
#endif
 }
            else if (s == 7 || s == 9) {
#ifndef SKIP_P7
 p7_conv_geglu(F, l, s == 9 ? up_na : 0, s == 9 ? 22 - up_na : up_na, nrows); if (DBL_MASK & 8) p7_conv_geglu(F, l, s == 9 ? up_na : 0, s == 9 ? 22 - up_na : up_na, nrows);
#endif
 }
            else {
#ifndef SKIP_PN
 if (l + 1 < NLAYER) post_norm_pass<false, false>(F, l, 1, RL, WSP(bf16, WS_FFNO)); else post_norm_pass<false, true>(F, l, 1, RL, WSP(bf16, WS_FFNO)); if (l == 0) ctx_post_norm(F, l, 1, DFF / 256, true);
#endif
 }
        }
        if (ph + 1 < hi) xcd_barrier(bar);
    }
}

extern "C" void kernel_launch(void* const* d_in, const int* in_sizes, int n_in, void* d_out, int out_size, void* d_ws, size_t ws_size, hipStream_t stream) {
    static int grid = 0;
    if (grid == 0) {
        if (n_in != 25 || in_sizes[0] != RL * DM || out_size != RL * DM || ws_size < WS_END) { fprintf(stderr, "kernel_launch: unexpected shapes: n_in %d in0 %d out %d ws %zu (need %zu)\n", n_in, n_in > 0 ? in_sizes[0] : -1, out_size, ws_size, (size_t)WS_END); grid = -1; return; }
        int dev = 0, cus = 0, per_cu = 0;
        if (hipGetDevice(&dev) != hipSuccess || hipDeviceGetAttribute(&cus, hipDeviceAttributeMultiprocessorCount, dev) != hipSuccess) { grid = -1; return; }
        if (hipFuncSetAttribute((const void*)skel_fwd, hipFuncAttributeMaxDynamicSharedMemorySize, LDS_BYTES) != hipSuccess) { fprintf(stderr, "kernel_launch: hipFuncSetAttribute failed\n"); grid = -1; return; }
        if (hipOccupancyMaxActiveBlocksPerMultiprocessor(&per_cu, (const void*)skel_fwd, NTHR, LDS_BYTES) != hipSuccess || per_cu < 1) fprintf(stderr, "kernel_launch: occupancy query reports %d blocks per CU\n", per_cu);
        (void)hipGetLastError();
        grid = cus;
    }
    if (grid < 0) return;
    (void)hipMemsetAsync((char*)d_ws + WS_CTL, 0, CTL_ZERO_BYTES, stream);
    Args a{};
    for (int i = 0; i < 25; ++i) a.in[i] = (const float*)d_in[i];
    a.out = (float*)d_out; a.ws = (unsigned char*)d_ws;
#if MK_PER_PHASE
    for (int ph = 0; ph < N_PHASES; ++ph) { a.ph_lo = ph; a.ph_hi = ph + 1; a.li = 0; hipLaunchKernelGGL(skel_fwd, dim3(grid), dim3(NTHR), LDS_BYTES, stream, a); }
#else
    a.ph_lo = 0; a.ph_hi = N_PHASES; a.li = 0;
    hipLaunchKernelGGL(skel_fwd, dim3(grid), dim3(NTHR), LDS_BYTES, stream, a);
#endif
}
```
